# Optimizing an MI355X kernel written in HIP

```python
import jax, jax.numpy as jnp
from jax import lax
import numpy as np

D_MODEL = 1024
BATCH = 4
SEQ = 8192
DEPTH = 1

CONV_W = D_MODEL // 2
N_HEADS = 8
HEAD_DIM = (D_MODEL - CONV_W) // N_HEADS
ATTN_W = N_HEADS * HEAD_DIM
IN_COLS = 3 * CONV_W + 3 * ATTN_W
CONV_K = 3
D_FF = 2816
PLE_DIM = 256
DILATED_PAIRS = ((128, 1), (512, 4), (2048, 16))
BLOCK = 128
EPS = 1e-6

kernel_name = 'hybrid_conv_dilated_attn_convffn_ple'


def rmsnorm(a, g):
    af = a.astype(jnp.float32)
    af = af * lax.rsqrt(jnp.mean(af * af, axis=-1, keepdims=True) + EPS)
    return (af * g.astype(jnp.float32)).astype(a.dtype)


def causal_dwconv3(u, w, b):
    up = jnp.pad(u, ((0, 0), (CONV_K - 1, 0), (0, 0)))
    t = u.shape[1]
    return up[:, 0:t] * w[0] + up[:, 1:t + 1] * w[1] + up[:, 2:t + 2] * w[2] + b


def alibi_slopes(n):
    return jnp.exp2(-8.0 * jnp.arange(1, n + 1, dtype=jnp.float32) / n)


def dilated_branch(q, k, v, slopes, window, dilation):
    b, t, h, hd = q.shape
    steps = window // dilation
    L = t // dilation
    nb = -(-L // BLOCK)
    lp = nb * BLOCK

    def to_blocks(a):
        a = a.reshape(b, L, dilation, h, hd).transpose(0, 2, 3, 1, 4)
        a = jnp.pad(a, ((0, 0), (0, 0), (0, 0), (0, lp - L), (0, 0)))
        return a.reshape(b, dilation, h, nb, BLOCK, hd)

    def with_prev(a):
        prev = jnp.pad(a[:, :, :, :-1], ((0, 0), (0, 0), (0, 0), (1, 0), (0, 0), (0, 0)))
        return jnp.concatenate([prev, a], axis=4)

    qb = to_blocks(q)
    kk = with_prev(to_blocks(k))
    vv = with_prev(to_blocks(v))

    s = jnp.einsum('brhnqd,brhnkd->brhnqk', qb, kk) * (hd ** -0.5)
    qi = jnp.arange(BLOCK)[:, None] + BLOCK
    kj = jnp.arange(2 * BLOCK)[None, :]
    step = qi - kj
    band = (step >= 0) & (step <= steps)
    first = (jnp.arange(nb)[:, None, None] == 0) & (kj < BLOCK)[None]
    mask = band[None] & ~first
    dist = (step * dilation).astype(jnp.float32)
    bias = -slopes[:, None, None] * dist[None]
    s = jnp.where(mask, s + bias[:, None], -jnp.inf)
    m = jnp.max(s, axis=-1, keepdims=True)
    e = jnp.exp(s - m)
    den = jnp.sum(e, axis=-1, keepdims=True)
    o = jnp.einsum('brhnqk,brhnkd->brhnqd', e, vv) / den
    lse = (m + jnp.log(den))[..., 0]

    o = o.reshape(b, dilation, h, lp, hd)[:, :, :, :L]
    o = o.transpose(0, 3, 1, 2, 4).reshape(b, t, h, hd)
    lse = lse.reshape(b, dilation, h, lp)[:, :, :, :L]
    lse = lse.transpose(0, 3, 1, 2).reshape(b, t, h)
    return o, lse


def dilated_attention(q, k, v):
    slopes = alibi_slopes(q.shape[2])
    outs, lses = [], []
    for window, dilation in DILATED_PAIRS:
        o, lse = dilated_branch(q, k, v, slopes, window, dilation)
        outs.append(o)
        lses.append(lse)
    wts = jax.nn.softmax(jnp.stack(lses, axis=0), axis=0)
    o = jnp.sum(wts[..., None] * jnp.stack(outs, axis=0), axis=0)
    return o


def setup_inputs(seed: int = 0) -> dict:
    key = jax.random.key(seed)
    ks = jax.random.split(key, 24)
    f32 = jnp.float32

    def nrm(k, shape, fan):
        return jax.random.normal(k, shape, f32) * (fan ** -0.5)

    def gain(k, shape):
        return 1.0 + 0.05 * jax.random.normal(k, shape, f32)

    def bias(k, shape):
        return 0.01 * jax.random.normal(k, shape, f32)

    return {
        'x': jax.random.normal(ks[0], (BATCH, SEQ, D_MODEL), f32),
        'p': jax.random.normal(ks[1], (DEPTH, BATCH, SEQ, PLE_DIM), f32),
        'g_mix': gain(ks[2], (DEPTH, D_MODEL)),
        'w_in': nrm(ks[3], (DEPTH, D_MODEL, IN_COLS), D_MODEL),
        'conv_w': nrm(ks[4], (DEPTH, CONV_K, CONV_W), CONV_K),
        'conv_b': bias(ks[5], (DEPTH, CONV_W)),
        'q_norm_g': gain(ks[6], (DEPTH, HEAD_DIM)),
        'k_norm_g': gain(ks[7], (DEPTH, HEAD_DIM)),
        'g_out_conv': gain(ks[8], (DEPTH, CONV_W)),
        'g_out_attn': gain(ks[9], (DEPTH, ATTN_W)),
        'w_out': nrm(ks[10], (DEPTH, CONV_W + ATTN_W, D_MODEL), CONV_W + ATTN_W),
        'g_ffn': gain(ks[11], (DEPTH, D_MODEL)),
        'w_gate': nrm(ks[12], (DEPTH, D_MODEL, D_FF), D_MODEL),
        'w_up': nrm(ks[13], (DEPTH, D_MODEL, D_FF), D_MODEL),
        'ffn_conv_w': nrm(ks[14], (DEPTH, CONV_K, D_FF), CONV_K),
        'ffn_conv_b': bias(ks[15], (DEPTH, D_FF)),
        'w_down': nrm(ks[16], (DEPTH, D_FF, D_MODEL), D_FF),
        'g_ple': gain(ks[17], (DEPTH, D_MODEL)),
        'w_ple_gate': nrm(ks[18], (DEPTH, D_MODEL, D_MODEL), D_MODEL),
        'w_ple_proj': nrm(ks[19], (DEPTH, PLE_DIM, D_MODEL), PLE_DIM),
    }


def reference(x, p, g_mix, w_in, conv_w, conv_b, q_norm_g, k_norm_g, g_out_conv,
              g_out_attn, w_out, g_ffn, w_gate, w_up, ffn_conv_w, ffn_conv_b, w_down,
              g_ple, w_ple_gate, w_ple_proj):
    b, t, _ = x.shape
    for i in range(DEPTH):
        h = rmsnorm(x, g_mix[i])
        z = h @ w_in[i]
        zb, zc, zx, zq, zk, zv = jnp.split(
            z, np.cumsum([CONV_W, CONV_W, CONV_W, ATTN_W, ATTN_W]), axis=-1)
        y_c = zb * causal_dwconv3(zc * zx, conv_w[i], conv_b[i])
        q = rmsnorm(zq.reshape(b, t, N_HEADS, HEAD_DIM), q_norm_g[i]).astype(jnp.float32)
        k = rmsnorm(zk.reshape(b, t, N_HEADS, HEAD_DIM), k_norm_g[i]).astype(jnp.float32)
        v = zv.reshape(b, t, N_HEADS, HEAD_DIM).astype(jnp.float32)
        y_a = dilated_attention(q, k, v).reshape(b, t, ATTN_W).astype(x.dtype)
        y = jnp.concatenate([rmsnorm(y_c, g_out_conv[i]), rmsnorm(y_a, g_out_attn[i])], axis=-1)
        x = x + y @ w_out[i]
        h = rmsnorm(x, g_ffn[i])
        gate = causal_dwconv3(h @ w_gate[i], ffn_conv_w[i], ffn_conv_b[i])
        x = x + (jax.nn.silu(gate) * (h @ w_up[i])) @ w_down[i]
        ple_gate = jax.nn.sigmoid(rmsnorm(x, g_ple[i]) @ w_ple_gate[i])
        x = x + ple_gate * (p[i].astype(x.dtype) @ w_ple_proj[i])
    return x
```

```cpp
#include <hip/hip_runtime.h>
#include <cstdio>
#include <cstdint>
namespace pg8 {
#define PG8_LAS __attribute__((address_space(3)))
typedef unsigned short bf16_t;
typedef short bf16x8 __attribute__((ext_vector_type(8)));
typedef float f32x4 __attribute__((ext_vector_type(4)));
typedef unsigned u32x4 __attribute__((ext_vector_type(4)));
constexpr int BM = 256, BK = 64, HALF = 128, HTB = HALF * BK * 2  , STAGE_BYTES = 8 * HTB, NXCD = 8, WGM = 8;

__host__ __device__ __forceinline__ int lds_byte(int r, int c) { const int st = (r >> 4) * 2 + (c >> 5), rr = r & 15, cc = c & 31, ob = rr * 64 + cc * 2; return st * 1024 + (ob ^ (((ob >> 9) & 1) << 5)); }
__host__ __device__ __forceinline__ void stage_rc(int b, int& R, int& C) { const int st = b / 1024, sb = b % 1024, swz = sb ^ (((sb >> 9) & 1) << 5); R = (st >> 1) * 16 + swz / 64; C = (st & 1) * 32 + (swz % 64) / 2; }
__host__ __device__ __forceinline__ int perm32(int rho) { const int n = rho >> 4, i = rho & 15; return 8 * (i >> 2) + 4 * n + (i & 3); }

struct Unit { int pm, pn; };
struct Gemm { const bf16_t* A; const bf16_t* Bt; int M, N, K; };

struct StaticOrder {
    int nM, nN, nwg, G, c;
    __host__ __device__ void init(int M, int N, int G_, int c_) { nM = M / BM; nN = N / BM; nwg = nM * nN; G = G_; c = c_; }
    __host__ __device__ bool next(int i, Unit& u) const {
        const long L = (long)i * G + c; if (L >= nwg) return false;
        int wgid = (int)L; { const int q = nwg / NXCD, r = nwg % NXCD, xcd = wgid % NXCD, off = wgid / NXCD; wgid = (xcd < r ? xcd * (q + 1) : r * (q + 1) + (xcd - r) * q) + off; }
        const int nig = WGM * nN, gid = wgid / nig, fm = gid * WGM, gsz = (nM - fm) < WGM ? (nM - fm) : WGM;
        u.pm = fm + ((wgid % nig) % gsz); u.pn = (wgid % nig) / gsz; return true;
    }
    __device__ __forceinline__ void a_ready(const Unit&) const {}
    __device__ __forceinline__ void done(const Unit&) const {}
};

__device__ __forceinline__ unsigned cvt_pk_bf16(float lo, float hi) { unsigned r; asm volatile("v_cvt_pk_bf16_f32 %0, %1, %2" : "=v"(r) : "v"(lo), "v"(hi)); return r; }
__device__ __forceinline__ u32x4 pack8(const f32x4& v0, const f32x4& v1) { u32x4 w; w.x = cvt_pk_bf16(v0[0], v0[1]); w.y = cvt_pk_bf16(v0[2], v0[3]); w.z = cvt_pk_bf16(v1[0], v1[1]); w.w = cvt_pk_bf16(v1[2], v1[3]); return w; }
__device__ __forceinline__ float bf2f(unsigned short h) { return __builtin_bit_cast(float, (unsigned)h << 16); }

struct EpiBf16 {
    static constexpr bool PERM = true, AFTER_DRAIN = false;
    bf16_t* O; int ldc;
    __device__ __forceinline__ void operator()(const f32x4 (&acc)[2][2][4][2], const Unit& u, int wr, int wc, int fr, int fq) const {
        const int row0 = u.pm * BM + wr * 64 + fr, col0 = u.pn * BM + wc * 32 + 8 * fq;
#pragma unroll
        for (int ai = 0; ai < 2; ++ai)
#pragma unroll
            for (int m = 0; m < 4; ++m) { bf16_t* rowp = O + (size_t)(row0 + ai * HALF + m * 16) * ldc + col0;
#pragma unroll
                for (int bj = 0; bj < 2; ++bj) *(u32x4*)(rowp + bj * HALF) = pack8(acc[ai][bj][m][0], acc[ai][bj][m][1]); }
    }
};
struct EpiGU {
    static constexpr bool PERM = true, AFTER_DRAIN = false;
    bf16_t* G; bf16_t* U; int ldc;
    __device__ __forceinline__ void operator()(const f32x4 (&acc)[2][2][4][2], const Unit& u, int wr, int wc, int fr, int fq) const {
        const int row0 = u.pm * BM + wr * 64 + fr, col0 = u.pn * HALF + wc * 32 + 8 * fq;
#pragma unroll
        for (int ai = 0; ai < 2; ++ai)
#pragma unroll
            for (int m = 0; m < 4; ++m) { const size_t off = (size_t)(row0 + ai * HALF + m * 16) * ldc + col0;
                *(u32x4*)(G + off) = pack8(acc[ai][0][m][0], acc[ai][0][m][1]);
                *(u32x4*)(U + off) = pack8(acc[ai][1][m][0], acc[ai][1][m][1]); }
    }
};
struct EpiInProj {
    static constexpr bool PERM = true, AFTER_DRAIN = false;
    bf16_t* ZC; bf16_t* Q; bf16_t* Kk; bf16_t* V; const float* gq; const float* gk; float qscale; float eps;
    __device__ __forceinline__ void operator()(const f32x4 (&acc)[2][2][4][2], const Unit& u, int wr, int wc, int fr, int fq) const {
        if (u.pn < 6) {
            const int row0 = u.pm * BM + wr * 64 + fr, col0 = u.pn * BM + wc * 32 + 8 * fq;
#pragma unroll
            for (int ai = 0; ai < 2; ++ai)
#pragma unroll
                for (int m = 0; m < 4; ++m) { bf16_t* rowp = ZC + (size_t)(row0 + ai * HALF + m * 16) * 1536 + col0;
#pragma unroll
                    for (int bj = 0; bj < 2; ++bj) *(u32x4*)(rowp + bj * HALF) = pack8(acc[ai][bj][m][0], acc[ai][bj][m][1]); }
        } else {
            const int sec = u.pn - 6, which = sec >> 1, head = 4 * (sec & 1) + wc;
            if (which < 2) {
                bf16_t* base = which == 0 ? Q : Kk;
                const float* g = which == 0 ? gq : gk;
                const float sc = which == 0 ? qscale : 1.f;
                const f32x4 g00 = *(const f32x4*)(g + 8 * fq), g01 = *(const f32x4*)(g + 8 * fq + 4), g10 = *(const f32x4*)(g + 32 + 8 * fq), g11 = *(const f32x4*)(g + 32 + 8 * fq + 4);
#pragma unroll
                for (int ai = 0; ai < 2; ++ai)
#pragma unroll
                    for (int m = 0; m < 4; ++m) {
                        const int row = u.pm * BM + ai * HALF + wr * 64 + m * 16 + fr, b = row >> 13, t = row & 8191;
                        float ss = 0.f;
#pragma unroll
                        for (int bj = 0; bj < 2; ++bj)
#pragma unroll
                            for (int n = 0; n < 2; ++n) { const f32x4 x = acc[ai][bj][m][n]; ss += (x[0] * x[0] + x[1] * x[1]) + (x[2] * x[2] + x[3] * x[3]); }
                        ss += __shfl_xor(ss, 16); ss += __shfl_xor(ss, 32);
                        const float rs = sc * __builtin_amdgcn_rsqf(ss * (1.0f / 64.0f) + eps);
                        bf16_t* dst = base + ((size_t)((b * 8 + head) * 8192 + t)) * 64 + 8 * fq;
                        *(u32x4*)(dst) = pack8(acc[ai][0][m][0] * rs * g00, acc[ai][0][m][1] * rs * g01);
                        *(u32x4*)(dst + 32) = pack8(acc[ai][1][m][0] * rs * g10, acc[ai][1][m][1] * rs * g11);
                    }
            } else {
#pragma unroll
                for (int ai = 0; ai < 2; ++ai)
#pragma unroll
                    for (int m = 0; m < 4; ++m) {
                        const int row = u.pm * BM + ai * HALF + wr * 64 + m * 16 + fr, b = row >> 13, t = row & 8191;
                        bf16_t* dst = V + ((size_t)((b * 8 + head) * 8192 + t)) * 64 + 8 * fq;
                        *(u32x4*)(dst) = pack8(acc[ai][0][m][0], acc[ai][0][m][1]);
                        *(u32x4*)(dst + 32) = pack8(acc[ai][1][m][0], acc[ai][1][m][1]);
                    }
            }
        }
    }
};
struct EpiResF32 {
    static constexpr bool PERM = false, AFTER_DRAIN = false;
    const float* base; float* out; int ldc;
    __device__ __forceinline__ void operator()(const f32x4 (&acc)[2][2][4][2], const Unit& u, int wr, int wc, int fr, int fq) const {
        const int row0 = u.pm * BM + wr * 64 + fr, col0 = u.pn * BM + wc * 32 + 4 * fq;
#pragma unroll
        for (int ai = 0; ai < 2; ++ai)
#pragma unroll
            for (int m = 0; m < 4; ++m) { const size_t off = (size_t)(row0 + ai * HALF + m * 16) * ldc + col0;
#pragma unroll
                for (int bj = 0; bj < 2; ++bj)
#pragma unroll
                    for (int n = 0; n < 2; ++n) { const f32x4 b = *(const f32x4*)(base + off + bj * HALF + n * 16); *(f32x4*)(out + off + bj * HALF + n * 16) = b + acc[ai][bj][m][n]; } }
    }
};
struct EpiPle {
    static constexpr bool PERM = false, AFTER_DRAIN = false;
    const float* base; float* out; const bf16_t* pp; int ldc;
    __device__ __forceinline__ void operator()(const f32x4 (&acc)[2][2][4][2], const Unit& u, int wr, int wc, int fr, int fq) const {
        typedef unsigned u32x2v __attribute__((ext_vector_type(2)));
        const int row0 = u.pm * BM + wr * 64 + fr, col0 = u.pn * BM + wc * 32 + 4 * fq;
#pragma unroll
        for (int ai = 0; ai < 2; ++ai)
#pragma unroll
            for (int m = 0; m < 4; ++m) { const size_t off = (size_t)(row0 + ai * HALF + m * 16) * ldc + col0;
#pragma unroll
                for (int bj = 0; bj < 2; ++bj)
#pragma unroll
                    for (int n = 0; n < 2; ++n) { const size_t o2 = off + bj * HALF + n * 16; const f32x4 b = *(const f32x4*)(base + o2); const u32x2v pw = *(const u32x2v*)(pp + o2);
                        const f32x4 a = acc[ai][bj][m][n]; f32x4 pj; pj[0] = __builtin_bit_cast(float, pw.x << 16); pj[1] = __builtin_bit_cast(float, pw.x & 0xffff0000u); pj[2] = __builtin_bit_cast(float, pw.y << 16); pj[3] = __builtin_bit_cast(float, pw.y & 0xffff0000u);
                        f32x4 o;
#pragma unroll
                        for (int e = 0; e < 4; ++e) { const float sg = __builtin_amdgcn_rcpf(1.0f + __builtin_amdgcn_exp2f(-1.4426950408889634f * a[e])); o[e] = b[e] + sg * pj[e]; }
                        *(f32x4*)(out + o2) = o; } }
    }
};

template <class Epi, class Sched, bool ALIGN_EPI = false, bool SP2 = false>
__device__ __forceinline__ void gemm_phase(PG8_LAS unsigned char* lds, const Gemm g, const Sched& S, const Epi& E) {
    const int tid = threadIdx.x, wid = __builtin_amdgcn_readfirstlane(tid >> 6), lane = tid & 63, wr = wid >> 2, wc = wid & 3, fr = lane & 15, fq = lane >> 4;
    const int K = g.K, nt = K / BK;
    unsigned voffA[2], voffB[2];
#pragma unroll
    for (int i = 0; i < 2; ++i) { int R, C; stage_rc(tid * 16 + i * 8192, R, C); const int Rb = Epi::PERM ? ((R & ~31) + perm32(R & 31)) : R;
        voffA[i] = (unsigned)(R * K + C) * 2u; voffB[i] = (unsigned)(Rb * K + C) * 2u; }
    const size_t kstep = (size_t)(BK * 2);
    const size_t hstep = (size_t)HALF * K * 2;
    const size_t tstep = 2 * hstep;
    const unsigned ldsw = (unsigned)wid * 1024u;
    const int aoff = lds_byte(wr * 64 + fr, fq * 8), boff = lds_byte(wc * 32 + fr, fq * 8);
#define PG8_SA(b, h) (((b) * 2 + (h)) * HTB)
#define PG8_SB(b, h) ((4 + (b) * 2 + (h)) * HTB)
#define PG8_STAGE(bufoff, gbase, voff) do { _Pragma("unroll") for (int _i = 0; _i < 2; ++_i) \
        __builtin_amdgcn_global_load_lds((const unsigned*)((const char*)(gbase) + (voff)[_i]), (PG8_LAS unsigned*)(lds + (bufoff) + ldsw + _i * 8192), 16, 0, 0); } while (0)
#define PG8_LDA(dst, b, h) do { _Pragma("unroll") for (int m = 0; m < 4; ++m) _Pragma("unroll") for (int k = 0; k < 2; ++k) dst[m][k] = *(const PG8_LAS bf16x8*)(lds + PG8_SA(b, h) + aoff + m * 2048 + k * 1024); } while (0)
#define PG8_LDB(dst, b, h) do { _Pragma("unroll") for (int n = 0; n < 2; ++n) _Pragma("unroll") for (int k = 0; k < 2; ++k) dst[n][k] = *(const PG8_LAS bf16x8*)(lds + PG8_SB(b, h) + boff + n * 2048 + k * 1024); } while (0)
#define PG8_MMA(ai, bj, At, Bt) do { __builtin_amdgcn_s_setprio(1); _Pragma("unroll") for (int m = 0; m < 4; ++m) _Pragma("unroll") for (int n = 0; n < 2; ++n) _Pragma("unroll") for (int k = 0; k < 2; ++k) \
        acc[ai][bj][m][n] = __builtin_amdgcn_mfma_f32_16x16x32_bf16(Bt[n][k], At[m][k], acc[ai][bj][m][n], 0, 0, 0); __builtin_amdgcn_s_setprio(0); } while (0)
#define PG8_WAIT_V(n) asm volatile("s_waitcnt vmcnt(" #n ")" ::: "memory")
#define PG8_WAIT_L(n) asm volatile("s_waitcnt lgkmcnt(" #n ")" ::: "memory")
#define PG8_BAR __builtin_amdgcn_s_barrier()
#define PG8_SCHED __builtin_amdgcn_sched_barrier(0)
    Unit cur, nxt; int ui = 0;
    if (!S.next(0, cur)) return;
    f32x4 acc[2][2][4][2];
#pragma unroll
    for (int a = 0; a < 2; ++a)
#pragma unroll
        for (int b = 0; b < 2; ++b)
#pragma unroll
            for (int m = 0; m < 4; ++m)
#pragma unroll
                for (int n = 0; n < 2; ++n) acc[a][b][m][n] = (f32x4){0.f, 0.f, 0.f, 0.f};
    bf16x8 At[4][2], B0[2][2], B1[2][2];
    const char* cA = (const char*)g.A + (size_t)cur.pm * tstep; const char* cB = (const char*)g.Bt + (size_t)cur.pn * tstep;
    S.a_ready(cur);
    if constexpr (SP2) {
        PG8_STAGE(PG8_SB(0, 0), cB, voffB); PG8_STAGE(PG8_SB(0, 1), cB + hstep, voffB); PG8_STAGE(PG8_SA(0, 0), cA, voffA); PG8_STAGE(PG8_SA(0, 1), cA + hstep, voffA);
        if (wr == 1) PG8_BAR;
        PG8_WAIT_V(2); PG8_BAR;
        PG8_STAGE(PG8_SB(1, 0), cB + kstep, voffB); PG8_STAGE(PG8_SA(1, 0), cA + kstep, voffA); PG8_STAGE(PG8_SB(1, 1), cB + hstep + kstep, voffB);
        PG8_WAIT_V(6); PG8_BAR;
    } else {
        PG8_STAGE(PG8_SB(0, 0), cB, voffB); PG8_STAGE(PG8_SA(0, 0), cA, voffA); PG8_STAGE(PG8_SB(0, 1), cB + hstep, voffB); PG8_STAGE(PG8_SA(0, 1), cA + hstep, voffA);
        if (wr == 1) PG8_BAR;
        PG8_WAIT_V(4); PG8_BAR;
        PG8_STAGE(PG8_SB(1, 0), cB + kstep, voffB); PG8_STAGE(PG8_SA(1, 0), cA + kstep, voffA); PG8_STAGE(PG8_SB(1, 1), cB + hstep + kstep, voffB);
        PG8_WAIT_V(6); PG8_BAR;
    }
    for (;;) {
        const bool has_next = S.next(ui + 1, nxt);
        const char* nA = has_next ? (const char*)g.A + (size_t)nxt.pm * tstep : cA; const char* nB = has_next ? (const char*)g.Bt + (size_t)nxt.pn * tstep : cB;
        for (int t = 0; t < nt; t += 2) {
            const bool last = (t == nt - 2);
            const char* a1 = cA + (size_t)(t + 1) * kstep;
            const char* a2 = last ? nA : cA + (size_t)(t + 2) * kstep; const char* b2 = last ? nB : cB + (size_t)(t + 2) * kstep;
            const char* a3 = a2 + kstep; const char* b3 = b2 + kstep;
            if (last && has_next) S.a_ready(nxt);
            if constexpr (SP2) {
            PG8_LDB(B0, 0, 0); PG8_LDB(B1, 0, 1); PG8_SCHED; PG8_LDA(At, 0, 0); PG8_STAGE(PG8_SA(1, 1), a1 + hstep, voffA);
            PG8_WAIT_V(8); PG8_WAIT_L(0); PG8_BAR; PG8_MMA(0, 0, At, B0); PG8_MMA(0, 1, At, B1); PG8_BAR; PG8_SCHED;
            PG8_LDA(At, 0, 1); PG8_STAGE(PG8_SB(0, 0), b2, voffB); PG8_STAGE(PG8_SB(0, 1), b2 + hstep, voffB); PG8_STAGE(PG8_SA(0, 0), a2, voffA);
            PG8_WAIT_V(8); PG8_WAIT_L(0); PG8_BAR; PG8_MMA(1, 0, At, B0); PG8_MMA(1, 1, At, B1); PG8_BAR; PG8_SCHED;
            PG8_LDB(B0, 1, 0); PG8_LDB(B1, 1, 1); PG8_SCHED; PG8_LDA(At, 1, 0); PG8_STAGE(PG8_SA(0, 1), a2 + hstep, voffA);
            PG8_WAIT_V(8); PG8_WAIT_L(0); PG8_BAR; PG8_MMA(0, 0, At, B0); PG8_MMA(0, 1, At, B1); PG8_BAR; PG8_SCHED;
            PG8_LDA(At, 1, 1); PG8_STAGE(PG8_SB(1, 0), b3, voffB); PG8_STAGE(PG8_SB(1, 1), b3 + hstep, voffB); PG8_STAGE(PG8_SA(1, 0), a3, voffA);
            PG8_WAIT_V(8); PG8_WAIT_L(0); PG8_BAR; PG8_MMA(1, 0, At, B0); PG8_MMA(1, 1, At, B1); PG8_BAR; PG8_SCHED;
            } else {
            PG8_LDB(B0, 0, 0); PG8_SCHED; PG8_LDA(At, 0, 0); PG8_STAGE(PG8_SA(1, 1), a1 + hstep, voffA);
            PG8_WAIT_L(8); PG8_BAR; PG8_WAIT_L(0); PG8_MMA(0, 0, At, B0); PG8_BAR; PG8_SCHED;
            PG8_LDB(B1, 0, 1); PG8_STAGE(PG8_SB(0, 0), b2, voffB);
            PG8_BAR; PG8_WAIT_L(0); PG8_MMA(0, 1, At, B1); PG8_BAR;
            PG8_LDA(At, 0, 1); PG8_STAGE(PG8_SA(0, 0), a2, voffA);
            PG8_BAR; PG8_WAIT_L(0); PG8_MMA(1, 0, At, B0); PG8_BAR; PG8_SCHED;
            PG8_STAGE(PG8_SB(0, 1), b2 + hstep, voffB);
            PG8_WAIT_V(6); PG8_BAR; PG8_MMA(1, 1, At, B1); PG8_BAR;
            PG8_LDB(B0, 1, 0); PG8_SCHED; PG8_LDA(At, 1, 0); PG8_STAGE(PG8_SA(0, 1), a2 + hstep, voffA);
            PG8_WAIT_L(8); PG8_BAR; PG8_WAIT_L(0); PG8_MMA(0, 0, At, B0); PG8_BAR; PG8_SCHED;
            PG8_LDB(B1, 1, 1); PG8_STAGE(PG8_SB(1, 0), b3, voffB);
            PG8_BAR; PG8_WAIT_L(0); PG8_MMA(0, 1, At, B1); PG8_BAR;
            PG8_LDA(At, 1, 1); PG8_STAGE(PG8_SA(1, 0), a3, voffA);
            PG8_BAR; PG8_WAIT_L(0); PG8_MMA(1, 0, At, B0); PG8_BAR; PG8_SCHED;
            PG8_STAGE(PG8_SB(1, 1), b3 + hstep, voffB);
            PG8_WAIT_V(6); PG8_BAR; PG8_MMA(1, 1, At, B1); PG8_BAR;
            }
        }
        if constexpr (ALIGN_EPI) { if (wr == 0) PG8_BAR; }
        if constexpr (!Epi::AFTER_DRAIN) { E(acc, cur, wr, wc, fr, fq); S.done(cur); }
        if (!has_next) break;
#pragma unroll
        for (int a = 0; a < 2; ++a)
#pragma unroll
            for (int b = 0; b < 2; ++b)
#pragma unroll
                for (int m = 0; m < 4; ++m)
#pragma unroll
                    for (int n = 0; n < 2; ++n) acc[a][b][m][n] = (f32x4){0.f, 0.f, 0.f, 0.f};
        cur = nxt; cA = nA; cB = nB; ++ui;
        if constexpr (ALIGN_EPI) { if (wr == 1) PG8_BAR; }
    }
    PG8_WAIT_V(0);
    if constexpr (!ALIGN_EPI) { if (wr == 0) PG8_BAR; }
    PG8_BAR;
    if constexpr (Epi::AFTER_DRAIN) { E.fused(acc, cur, wr, wc, fr, fq, lds, wid, lane); S.done(cur); }
#undef PG8_SA
#undef PG8_SB
#undef PG8_STAGE
#undef PG8_LDA
#undef PG8_LDB
#undef PG8_MMA
#undef PG8_WAIT_V
#undef PG8_WAIT_L
#undef PG8_BAR
#undef PG8_SCHED
}
}
#define GAS __attribute__((address_space(1)))
#define LAS __attribute__((address_space(3)))
typedef unsigned short bf16;
typedef unsigned v4u __attribute__((ext_vector_type(4)));
typedef float f32x4 __attribute__((ext_vector_type(4)));
typedef short bf16x8 __attribute__((ext_vector_type(8)));
typedef GAS unsigned gu32;
typedef GAS unsigned long long gu64;
#define RLX_AGENT __ATOMIC_RELAXED, __HIP_MEMORY_SCOPE_AGENT
#define LDS_WAIT() asm volatile("s_waitcnt lgkmcnt(0)" ::: "memory")
#define VM_WAIT() asm volatile("s_waitcnt vmcnt(0)" ::: "memory")
__device__ __forceinline__ unsigned long long rt() { return __builtin_amdgcn_s_memrealtime(); }
__device__ __forceinline__ unsigned f2bf(float f) { unsigned u = __builtin_bit_cast(unsigned, f); return (u + 0x7fffu + ((u >> 16) & 1u)) >> 16; }
__device__ __forceinline__ unsigned pk2(float lo, float hi) { return f2bf(lo) | (f2bf(hi) << 16); }

#define XB_TMO      128
#define XB_XCNT(j)  (256  + 64 * (j))
#define XB_XSUB(j)  (1280 + 64 * (j))
#define XB_XGEN(j)  (2304 + 64 * (j))
#define XB_TOP      3328
#define XB_TOPGEN   3392
#define XCD_BAR_WORDS 3456
#define XB_SPIN_CAP (1u << 18)

__device__ __forceinline__ unsigned xb_ld(unsigned* p)              { return __hip_atomic_load(p, __ATOMIC_RELAXED, __HIP_MEMORY_SCOPE_AGENT); }
__device__ __forceinline__ unsigned xb_add(unsigned* p, unsigned v) { return __hip_atomic_fetch_add(p, v, __ATOMIC_RELAXED, __HIP_MEMORY_SCOPE_AGENT); }
__device__ __forceinline__ unsigned xb_xcc_id() { return (unsigned)__builtin_amdgcn_s_getreg((3 << 11) | 20) & 0xFu; }
#define XB_SPIN(cond, bar) do { unsigned _sp = 0; while (cond) { __builtin_amdgcn_s_sleep(1); \
    if ((++_sp & 255u) == 0u) { if (xb_ld(&(bar)[XB_TMO])) break; if (_sp > XB_SPIN_CAP) { atomicAdd(&(bar)[XB_TMO], 1u); break; } } } } while (0)

struct XcdBarrier {
    unsigned* bar; unsigned x;
    volatile LAS unsigned* st;
};

__device__ __forceinline__ XcdBarrier xcd_barrier_post(unsigned* bar, volatile LAS unsigned* st) {
    XcdBarrier b; b.bar = bar; b.x = xb_xcc_id(); b.st = st;
    if (threadIdx.x == 0) (void)xb_add(&bar[XB_XCNT(b.x)], 1u);
    return b;
}
__device__ __forceinline__ void xcd_barrier_complete(unsigned* bar, unsigned x, unsigned& nloc, unsigned& nx) {
    const unsigned G = gridDim.x * gridDim.y * gridDim.z;
    unsigned sum, cnt, mine, sp = 0u;
    for (;;) {
        sum = 0u; cnt = 0u; mine = 0u;
#pragma unroll
        for (unsigned j = 0; j < 16; ++j) { const unsigned c = xb_ld(&bar[XB_XCNT(j)]); sum += c; cnt += (c > 0u) ? 1u : 0u; mine = (j == x) ? c : mine; }
        if (sum == G) break;
        __builtin_amdgcn_s_sleep(1);
        if ((++sp & 255u) == 0u) { if (xb_ld(&bar[XB_TMO])) break; if (sp > XB_SPIN_CAP) { atomicAdd(&bar[XB_TMO], 1u); break; } }
    }
    nloc = mine > 0u ? mine : 1u; nx = cnt > 0u ? cnt : 1u;
}

__device__ __forceinline__ void xcd_barrier(const XcdBarrier& b) {
    asm volatile("s_waitcnt vmcnt(0)" ::: "memory");
    __syncthreads();
    if (threadIdx.x == 0) {
        unsigned* bar = b.bar;
        __builtin_amdgcn_s_waitcnt(0);
        unsigned nloc = b.st[0], nx = b.st[1];
        if (nloc == 0u) { xcd_barrier_complete(bar, b.x, nloc, nx); b.st[0] = nloc; b.st[1] = nx; }
        const unsigned old = xb_add(&bar[XB_XSUB(b.x)], 1u);
        const unsigned gen = old / nloc;
        if (old + 1u == (gen + 1u) * nloc) {
            __builtin_amdgcn_fence(__ATOMIC_RELEASE, "agent");
            asm volatile("s_waitcnt vmcnt(0)" ::: "memory");
            const unsigned og = xb_add(&bar[XB_TOP], 1u);
            const unsigned tg = og / nx;
            if (og + 1u == (tg + 1u) * nx) xb_add(&bar[XB_TOPGEN], 1u);
            else XB_SPIN(xb_ld(&bar[XB_TOPGEN]) == tg, bar);
            __builtin_amdgcn_fence(__ATOMIC_ACQUIRE, "agent");
            xb_add(&bar[XB_XGEN(b.x)], 1u);
            asm volatile("s_waitcnt vmcnt(0)" ::: "memory");
        } else {
            XB_SPIN(xb_ld(&bar[XB_XGEN(b.x)]) == gen, bar);
            __builtin_amdgcn_fence(__ATOMIC_ACQUIRE, "agent");
            asm volatile("s_waitcnt vmcnt(0)" ::: "memory");
        }
    }
    __syncthreads();
}

constexpr int NWAVES = 8;
constexpr int BATCH = 4, SEQ = 8192, DM = 1024, MROWS = BATCH * SEQ, CONVW = 512, NHEAD = 8, HD = 64, ATTW = 512, INCOLS = 3072, DFF = 2816, PLED = 256;
constexpr float EPS = 1e-6f;
constexpr float LOG2E = 1.4426950408889634f;
constexpr size_t MiB = 1u << 20;
constexpr size_t WS_CTL = 0, CTL_ZERO_BYTES = 1 * MiB;
constexpr size_t WS_WIN = 2 * MiB, WS_WOUT = 8 * MiB, WS_WGU = 10 * MiB, WS_WDN = 21 * MiB, WS_WPG = 27 * MiB, WS_WPP = 29 * MiB;
constexpr size_t WS_H = 32 * MiB;
constexpr size_t WS_PB = 96 * MiB;
constexpr size_t WS_ZC = 112 * MiB;
constexpr size_t WS_Q = 208 * MiB, WS_K = 240 * MiB, WS_V = 272 * MiB;
constexpr size_t WS_OP = 304 * MiB;
constexpr size_t WS_LP = 400 * MiB;
constexpr size_t WS_Y = 404 * MiB;
constexpr size_t WS_G = 112 * MiB, WS_U = 288 * MiB;
constexpr size_t WS_PP = 112 * MiB;
constexpr size_t WS_END = 468 * MiB;
constexpr int CW_BAR = 4096;
constexpr int RING_BYTES = 131072, LDSCTL_OFF = RING_BYTES, MISC_OFF = LDSCTL_OFF + 320, LDS_BYTES = 147456;

__device__ __forceinline__ float wave_sum(float v) {
#pragma unroll
    for (int o = 1; o < 64; o <<= 1) v += __shfl_xor(v, o);
    return v;
}
__device__ __forceinline__ float wave_max(float v) {
#pragma unroll
    for (int o = 1; o < 64; o <<= 1) v = fmaxf(v, __shfl_xor(v, o));
    return v;
}
__device__ __forceinline__ unsigned cvtpk(float lo, float hi) { unsigned r; asm volatile("v_cvt_pk_bf16_f32 %0, %1, %2" : "=v"(r) : "v"(lo), "v"(hi)); return r; }
__device__ __forceinline__ float bflo(unsigned w) { return __builtin_bit_cast(float, w << 16); }
__device__ __forceinline__ float bfhi(unsigned w) { return __builtin_bit_cast(float, w & 0xffff0000u); }
__device__ __forceinline__ void unpack8(const v4u w, float (&f)[8]) { f[0] = bflo(w.x); f[1] = bfhi(w.x); f[2] = bflo(w.y); f[3] = bfhi(w.y); f[4] = bflo(w.z); f[5] = bfhi(w.z); f[6] = bflo(w.w); f[7] = bfhi(w.w); }
__device__ __forceinline__ v4u pack8f(const float (&f)[8]) { v4u w; w.x = cvtpk(f[0], f[1]); w.y = cvtpk(f[2], f[3]); w.z = cvtpk(f[4], f[5]); w.w = cvtpk(f[6], f[7]); return w; }
__device__ __forceinline__ void load8f(const float* p, float (&f)[8]) { const f32x4 a = *(const f32x4*)p, b = *(const f32x4*)(p + 4); f[0] = a[0]; f[1] = a[1]; f[2] = a[2]; f[3] = a[3]; f[4] = b[0]; f[5] = b[1]; f[6] = b[2]; f[7] = b[3]; }

__device__ __forceinline__ void p0_transpose_item(const float* W, int K, int N, bf16* WT, int drow0, LAS float* scr, int k0, int n0, int lane) {
#pragma unroll 8
    for (int i = 0; i < 32; ++i) { const int kk = 2 * i + (lane >> 5); scr[kk * 33 + (lane & 31)] = W[(size_t)(k0 + kk) * N + n0 + (lane & 31)]; }
    LDS_WAIT(); asm volatile("" ::: "memory");
    const int c = lane & 7;
#pragma unroll
    for (int j = 0; j < 4; ++j) { const int n = (lane >> 3) + 8 * j; const LAS float* s = scr + (8 * c) * 33 + n;
        v4u o; o.x = pk2(s[0 * 33], s[1 * 33]); o.y = pk2(s[2 * 33], s[3 * 33]); o.z = pk2(s[4 * 33], s[5 * 33]); o.w = pk2(s[6 * 33], s[7 * 33]);
        *(GAS v4u*)(WT + (size_t)(drow0 + n) * K + k0 + 8 * c) = o; }
    LDS_WAIT(); asm volatile("" ::: "memory");
}
__device__ __forceinline__ int map_in_row(int n0) {
    if (n0 < 1536) return n0;
    const int w = n0 - 1536, sec = w >> 8, within = w & 255, hl = within >> 6, dim = within & 63;
    return 1536 + 256 * sec + 128 * (dim >> 5) + 32 * hl + (dim & 31);
}
__device__ __forceinline__ void rms_row(const float* srow, const float* g, bf16* drow, int lane) {
    const GAS f32x4* xr = (const GAS f32x4*)srow + lane;
    f32x4 v[4]; float s = 0.f;
#pragma unroll
    for (int j = 0; j < 4; ++j) { v[j] = xr[64 * j]; s += (v[j].x * v[j].x + v[j].y * v[j].y) + (v[j].z * v[j].z + v[j].w * v[j].w); }
    const float rstd = __builtin_amdgcn_rsqf(wave_sum(s) * (1.f / DM) + EPS);
    GAS unsigned long long* o8 = (GAS unsigned long long*)drow + lane;
#pragma unroll
    for (int j = 0; j < 4; ++j) { const f32x4 gg = ((const GAS f32x4*)g)[lane + 64 * j];
        o8[64 * j] = (unsigned long long)cvtpk(v[j].x * rstd * gg.x, v[j].y * rstd * gg.y) | ((unsigned long long)cvtpk(v[j].z * rstd * gg.z, v[j].w * rstd * gg.w) << 32); }
}
__device__ __forceinline__ void rms_rows(const float* src, const float* g, bf16* dst, int gw, int NGW, int lane) {
    for (int m = gw; m < MROWS; m += NGW) rms_row(src + (size_t)m * DM, g, dst + (size_t)m * DM, lane);
}

namespace att {
typedef float f32x16 __attribute__((ext_vector_type(16)));
typedef short s16x4 __attribute__((ext_vector_type(4)));
typedef short v4i16_t __attribute__((ext_vector_type(4)));
__device__ __forceinline__ constexpr int cr(int r) { return (r & 3) + 8 * (r >> 2); }
__device__ __forceinline__ s16x4 vtr(LAS const unsigned char* p) { return __builtin_bit_cast(s16x4, __builtin_amdgcn_ds_read_tr16_b64_v4i16((LAS v4i16_t*)p)); }

__device__ __forceinline__ void attn_tile(LAS unsigned char* wl, const bf16* Qg, const bf16* Kg, const bf16* Vg, bf16* OPb, float* LPb,
                                          int b, int h, int d, int r, int l0, float cb, float negM, int lane) {
    const int r32 = lane & 31, hi = lane >> 5;
    const size_t hb = (size_t)(b * NHEAD + h) * SEQ * HD;
    const bf16* Qh = Qg + hb; const bf16* Kh = Kg + hb; const bf16* Vh = Vg + hb;
    const int pq = r + d * (l0 + r32);
    bf16x8 qf[4];
#pragma unroll
    for (int s = 0; s < 4; ++s) qf[s] = *(const GAS bf16x8*)(Qh + (size_t)pq * HD + 16 * s + 8 * hi);
    const int kb0 = l0 >= 128 ? 0 : ((128 - l0) >> 5);
    bf16x8 kfn[4]; v4u vrn[4];
#define ATT_LOADKV(kb) do { const int lb_ = l0 - 128 + 32 * (kb); const size_t pk_ = (size_t)(r + d * (lb_ + r32)); \
        _Pragma("unroll") for (int s = 0; s < 4; ++s) kfn[s] = *(const GAS bf16x8*)(Kh + pk_ * HD + 16 * s + 8 * hi); \
        _Pragma("unroll") for (int it = 0; it < 4; ++it) { const int idx_ = lane + 64 * it, key_ = idx_ >> 3, c_ = idx_ & 7; \
            vrn[it] = *(const GAS v4u*)(Vh + (size_t)(r + d * (lb_ + key_)) * HD + 8 * c_); } } while (0)
    ATT_LOADKV(kb0);
    f32x16 o0, o1;
#pragma unroll
    for (int i = 0; i < 16; ++i) { o0[i] = 0.f; o1[i] = 0.f; }
    float lsum = 0.f;
    const int i4 = r32 - 4 * hi;
    const int laneoff = ((lane >> 4) & 1) * 32 + (lane & 3) * 8 + (4 * hi + ((lane & 15) >> 2)) * 64;
    for (int kb = kb0; kb < 5; ++kb) {
        bf16x8 kf[4]; v4u vr[4];
#pragma unroll
        for (int s = 0; s < 4; ++s) { kf[s] = kfn[s]; vr[s] = vrn[s]; }
#pragma unroll
        for (int it = 0; it < 4; ++it) { const int idx = lane + 64 * it, key = idx >> 3, c = idx & 7;
            *(LAS v4u*)(wl + (c >> 2) * 2048 + (key >> 4) * 1024 + (key & 15) * 64 + (c & 3) * 16) = vr[it]; }
        if (kb + 1 < 5) ATT_LOADKV(kb + 1);
        const float lt = negM - cb * (float)(128 + r32 - 32 * kb - 4 * hi);
        f32x16 sacc;
#pragma unroll
        for (int i = 0; i < 16; ++i) sacc[i] = __builtin_fmaf(cb, (float)cr(i), lt);
#pragma unroll
        for (int s = 0; s < 4; ++s) sacc = __builtin_amdgcn_mfma_f32_32x32x16_bf16(kf[s], qf[s], sacc, 0, 0, 0);
        float p[16];
#pragma unroll
        for (int i = 0; i < 16; ++i) p[i] = __builtin_amdgcn_exp2f(sacc[i]);
        if (kb == 0) {
#pragma unroll
            for (int i = 0; i < 16; ++i) p[i] = (cr(i) >= i4) ? p[i] : 0.f;
        }
        if (kb == 4) {
#pragma unroll
            for (int i = 0; i < 16; ++i) p[i] = (cr(i) <= i4) ? p[i] : 0.f;
        }
        float ps = 0.f;
#pragma unroll
        for (int i = 0; i < 16; ++i) ps += p[i];
        lsum += ps;
        v4u pw0, pw1;
        pw0.x = cvtpk(p[0], p[1]); pw0.y = cvtpk(p[2], p[3]); pw0.z = cvtpk(p[4], p[5]); pw0.w = cvtpk(p[6], p[7]);
        pw1.x = cvtpk(p[8], p[9]); pw1.y = cvtpk(p[10], p[11]); pw1.z = cvtpk(p[12], p[13]); pw1.w = cvtpk(p[14], p[15]);
        const bf16x8 pa0 = __builtin_bit_cast(bf16x8, pw0), pa1 = __builtin_bit_cast(bf16x8, pw1);
        LAS const unsigned char* vb = wl + laneoff;
#pragma unroll
        for (int d0 = 0; d0 < 2; ++d0) {
            const s16x4 a_lo = vtr(vb + d0 * 2048), a_hi = vtr(vb + d0 * 2048 + 512), b_lo = vtr(vb + d0 * 2048 + 1024), b_hi = vtr(vb + d0 * 2048 + 1024 + 512);
            const bf16x8 v0 = (bf16x8){a_lo[0], a_lo[1], a_lo[2], a_lo[3], a_hi[0], a_hi[1], a_hi[2], a_hi[3]};
            const bf16x8 v1 = (bf16x8){b_lo[0], b_lo[1], b_lo[2], b_lo[3], b_hi[0], b_hi[1], b_hi[2], b_hi[3]};
            if (d0 == 0) { o0 = __builtin_amdgcn_mfma_f32_32x32x16_bf16(pa0, v0, o0, 0, 0, 0); o0 = __builtin_amdgcn_mfma_f32_32x32x16_bf16(pa1, v1, o0, 0, 0, 0); }
            else         { o1 = __builtin_amdgcn_mfma_f32_32x32x16_bf16(pa0, v0, o1, 0, 0, 0); o1 = __builtin_amdgcn_mfma_f32_32x32x16_bf16(pa1, v1, o1, 0, 0, 0); }
        }
    }
#undef ATT_LOADKV
    lsum += __shfl_xor(lsum, 32);
    if (hi == 0) LPb[(size_t)(b * SEQ + pq) * NHEAD + h] = lsum;
    LAS unsigned short* stg = (LAS unsigned short*)(wl + 4096);
#pragma unroll
    for (int i = 0; i < 16; ++i) { const int q = cr(i) + 4 * hi;
        stg[q * 64 + r32] = (unsigned short)(cvtpk(o0[i], o0[i]) & 0xffffu); stg[q * 64 + 32 + r32] = (unsigned short)(cvtpk(o1[i], o1[i]) & 0xffffu); }
    LDS_WAIT(); asm volatile("" ::: "memory");
#pragma unroll
    for (int it = 0; it < 4; ++it) { const int row = it * 8 + (lane >> 3), ch = lane & 7;
        const v4u v = *(LAS const v4u*)(stg + row * 64 + ch * 8);
        *(GAS v4u*)(OPb + (size_t)(b * SEQ + r + d * (l0 + row)) * ATTW + h * HD + ch * 8) = v; }
    LDS_WAIT(); asm volatile("" ::: "memory");
}
}

struct Args { const float* in[20]; float* out; unsigned char* ws; };
enum { I_X = 0, I_P, I_GMIX, I_WIN, I_CONVW, I_CONVB, I_QG, I_KG, I_GOC, I_GOA, I_WOUT, I_GFFN, I_WGATE, I_WUP, I_FCW, I_FCB, I_WDOWN, I_GPLE, I_WPG, I_WPP };

#define PHASE_PTRS KARG_DECL unsigned char* const ws_ = ARG_WS(); float* const out = ARG_OUT(); (void)out; \
    bf16* const WIN = (bf16*)(ws_ + WS_WIN); bf16* const WOUT = (bf16*)(ws_ + WS_WOUT); bf16* const WGU = (bf16*)(ws_ + WS_WGU); bf16* const WDN = (bf16*)(ws_ + WS_WDN); bf16* const WPG = (bf16*)(ws_ + WS_WPG); bf16* const WPP = (bf16*)(ws_ + WS_WPP); \
    bf16* const HB = (bf16*)(ws_ + WS_H); bf16* const PB = (bf16*)(ws_ + WS_PB); bf16* const ZC = (bf16*)(ws_ + WS_ZC); bf16* const QB = (bf16*)(ws_ + WS_Q); bf16* const KB = (bf16*)(ws_ + WS_K); bf16* const VB = (bf16*)(ws_ + WS_V); \
    bf16* const OP = (bf16*)(ws_ + WS_OP); float* const LP = (float*)(ws_ + WS_LP); bf16* const YB = (bf16*)(ws_ + WS_Y); bf16* const GB = (bf16*)(ws_ + WS_G); bf16* const UB = (bf16*)(ws_ + WS_U); bf16* const PP = (bf16*)(ws_ + WS_PP); \
    (void)WIN; (void)WOUT; (void)WGU; (void)WDN; (void)WPG; (void)WPP; (void)HB; (void)PB; (void)ZC; (void)QB; (void)KB; (void)VB; (void)OP; (void)LP; (void)YB; (void)GB; (void)UB; (void)PP;
#define CAS __attribute__((address_space(4)))
#define ARG_IN(i) (*(const float* const CAS*)(ka_ + 8 * (i)))
#define ARG_OUT() (*(float* const CAS*)(ka_ + 8 * 20))
#define ARG_WS() (*(unsigned char* const CAS*)(ka_ + 8 * 21))
#define KARG_DECL const CAS unsigned char* ka_ = (const CAS unsigned char*)__builtin_amdgcn_kernarg_segment_ptr(); asm volatile("" : "+s"(ka_));
__global__ void __launch_bounds__(NWAVES * 64, 2) hybrid_fwd(Args args) {
    extern __shared__ __attribute__((aligned(16))) unsigned char lds[];
    LAS unsigned char* L = (LAS unsigned char*)lds;
    volatile LAS unsigned* MISC = (volatile LAS unsigned*)(L + MISC_OFF);
    const int tid = threadIdx.x, lane = tid & 63, wave = __builtin_amdgcn_readfirstlane(tid >> 6);
    const int G = gridDim.x; const int bx = blockIdx.x;
    const int vcu = (G % 8 == 0) ? (bx % 8) * (G / 8) + bx / 8 : bx;
    const int gw = vcu * NWAVES + wave, NGW = G * NWAVES;
    gu32* ctl; { KARG_DECL ctl = (gu32*)(ARG_WS() + WS_CTL); }
    for (int u = tid; u < (LDS_BYTES - LDSCTL_OFF) / 4; u += NWAVES * 64) ((LAS unsigned*)(L + LDSCTL_OFF))[u] = 0u;
    __syncthreads();
    XcdBarrier bar = xcd_barrier_post((unsigned*)(ctl + CW_BAR), MISC + 8);

#ifndef SKIP_P0
    { PHASE_PTRS
    {
        LAS float* scr = (LAS float*)(L + wave * 16384);
        constexpr int I_IN = 16 * 96, I_OUT = 16 * 32, I_GT = 16 * 88, I_DN = 44 * 32, I_PG = 16 * 32, I_PPJ = 4 * 32;
        constexpr int NITEMS = I_IN + I_OUT + 2 * I_GT + I_DN + I_PG + I_PPJ;
        for (int it = gw; it < NITEMS; it += NGW) {
            int r = it;
            if (r < I_IN) { const int kb = r / 96, n0 = 32 * (r % 96); p0_transpose_item(ARG_IN(I_WIN), DM, INCOLS, WIN, map_in_row(n0), scr, 64 * kb, n0, lane); continue; } r -= I_IN;
            if (r < I_OUT) { const int kb = r / 32, n0 = 32 * (r % 32); p0_transpose_item(ARG_IN(I_WOUT), DM, DM, WOUT, n0, scr, 64 * kb, n0, lane); continue; } r -= I_OUT;
            if (r < I_GT) { const int kb = r / 88, n0 = 32 * (r % 88); p0_transpose_item(ARG_IN(I_WGATE), DM, DFF, WGU, 256 * (n0 >> 7) + (n0 & 127), scr, 64 * kb, n0, lane); continue; } r -= I_GT;
            if (r < I_GT) { const int kb = r / 88, n0 = 32 * (r % 88); p0_transpose_item(ARG_IN(I_WUP), DM, DFF, WGU, 256 * (n0 >> 7) + 128 + (n0 & 127), scr, 64 * kb, n0, lane); continue; } r -= I_GT;
            if (r < I_DN) { const int kb = r / 32, n0 = 32 * (r % 32); p0_transpose_item(ARG_IN(I_WDOWN), DFF, DM, WDN, n0, scr, 64 * kb, n0, lane); continue; } r -= I_DN;
            if (r < I_PG) { const int kb = r / 32, n0 = 32 * (r % 32); p0_transpose_item(ARG_IN(I_WPG), DM, DM, WPG, n0, scr, 64 * kb, n0, lane); continue; } r -= I_PG;
            { const int kb = r / 32, n0 = 32 * (r % 32); p0_transpose_item(ARG_IN(I_WPP), PLED, DM, WPP, n0, scr, 64 * kb, n0, lane); }
        }
        rms_rows(ARG_IN(I_X), ARG_IN(I_GMIX), HB, gw, NGW, lane);
        for (int m = gw; m < MROWS; m += NGW) {
            const f32x4 v = ((const GAS f32x4*)(ARG_IN(I_P) + (size_t)m * PLED))[lane];
            ((GAS unsigned long long*)(PB + (size_t)m * PLED))[lane] = (unsigned long long)cvtpk(v.x, v.y) | ((unsigned long long)cvtpk(v.z, v.w) << 32);
        }
    }
    }
#endif
    xcd_barrier(bar);

#ifndef SKIP_P1
    { PHASE_PTRS
    {
        int kdim_ = DM; asm volatile("" : "+s"(kdim_)); pg8::Gemm g{HB, WIN, MROWS, INCOLS, kdim_}; pg8::StaticOrder S; S.init(MROWS, INCOLS, G, bx);
        pg8::EpiInProj E{ZC, QB, KB, VB, ARG_IN(I_QG), ARG_IN(I_KG), 0.125f * LOG2E, EPS};
        pg8::gemm_phase<pg8::EpiInProj, pg8::StaticOrder, true, true>(L, g, S, E);
    }
    }
#endif
    xcd_barrier(bar);

#ifndef SKIP_P2
    { PHASE_PTRS
    {
        const float mq = wave_max(fabsf(ARG_IN(I_QG)[lane])), mk = wave_max(fabsf(ARG_IN(I_KG)[lane]));
        const float negM = -8.0f * mq * mk * LOG2E;
        LAS unsigned char* wl = L + wave * 8192;
        const int nper = 3072 / G;
        for (int i = 0; i < nper; ++i) {
            const int u = vcu * nper + i, bh = u / 96, u96 = u % 96, branch = u96 >> 5, within = u96 & 31;
            const int d = 1 << (2 * branch), nblk = 32 >> (2 * branch), r = within / nblk, blk = within % nblk;
            const int b = bh >> 3, h = bh & 7;
            const float cb = __builtin_amdgcn_exp2f(-(float)(h + 1)) * (float)d * LOG2E;
            att::attn_tile(wl, QB, KB, VB, OP + (size_t)branch * MROWS * ATTW, LP + (size_t)branch * MROWS * NHEAD, b, h, d, r, blk * 256 + wave * 32, cb, negM, lane);
        }
    }
    }
#endif
    xcd_barrier(bar);

#ifndef SKIP_P3
    { PHASE_PTRS
    {
        const int c = 8 * lane;
        float cw0[8], cw1[8], cw2[8], cbv[8], gc[8], ga[8];
        load8f(ARG_IN(I_CONVW) + c, cw0); load8f(ARG_IN(I_CONVW) + CONVW + c, cw1); load8f(ARG_IN(I_CONVW) + 2 * CONVW + c, cw2);
        load8f(ARG_IN(I_CONVB) + c, cbv); load8f(ARG_IN(I_GOC) + c, gc); load8f(ARG_IN(I_GOA) + c, ga);
        for (int ch = gw; ch < MROWS / 16; ch += NGW) {
            const int m0 = ch * 16;
            float u1[8], u2[8];
            if ((m0 & (SEQ - 1)) == 0) {
#pragma unroll
                for (int j = 0; j < 8; ++j) { u1[j] = 0.f; u2[j] = 0.f; }
            } else {
                float a[8], bb[8];
                unpack8(*(const GAS v4u*)(ZC + (size_t)(m0 - 1) * 1536 + 512 + c), a); unpack8(*(const GAS v4u*)(ZC + (size_t)(m0 - 1) * 1536 + 1024 + c), bb);
#pragma unroll
                for (int j = 0; j < 8; ++j) u1[j] = a[j] * bb[j];
                unpack8(*(const GAS v4u*)(ZC + (size_t)(m0 - 2) * 1536 + 512 + c), a); unpack8(*(const GAS v4u*)(ZC + (size_t)(m0 - 2) * 1536 + 1024 + c), bb);
#pragma unroll
                for (int j = 0; j < 8; ++j) u2[j] = a[j] * bb[j];
            }
            for (int tt = 0; tt < 16; ++tt) {
                const size_t m = (size_t)(m0 + tt);
                float zb[8], zc[8], zx[8], y[8];
                unpack8(*(const GAS v4u*)(ZC + m * 1536 + c), zb); unpack8(*(const GAS v4u*)(ZC + m * 1536 + 512 + c), zc); unpack8(*(const GAS v4u*)(ZC + m * 1536 + 1024 + c), zx);
                float o1[8], o2[8], o3[8];
                unpack8(*(const GAS v4u*)(OP + m * ATTW + c), o1); unpack8(*(const GAS v4u*)(OP + ((size_t)MROWS + m) * ATTW + c), o2); unpack8(*(const GAS v4u*)(OP + ((size_t)2 * MROWS + m) * ATTW + c), o3);
                const float lt = LP[m * NHEAD + (lane >> 3)] + LP[((size_t)MROWS + m) * NHEAD + (lane >> 3)] + LP[((size_t)2 * MROWS + m) * NHEAD + (lane >> 3)];
                float ss = 0.f;
#pragma unroll
                for (int j = 0; j < 8; ++j) { const float u0 = zc[j] * zx[j]; y[j] = zb[j] * (cw0[j] * u2[j] + cw1[j] * u1[j] + cw2[j] * u0 + cbv[j]); ss += y[j] * y[j]; u2[j] = u1[j]; u1[j] = u0; }
                const float rc = __builtin_amdgcn_rsqf(wave_sum(ss) * (1.f / CONVW) + EPS);
#pragma unroll
                for (int j = 0; j < 8; ++j) y[j] = y[j] * rc * gc[j];
                *(GAS v4u*)(YB + m * DM + c) = pack8f(y);
                const float rl = 1.0f / lt; float sa = 0.f;
#pragma unroll
                for (int j = 0; j < 8; ++j) { y[j] = (o1[j] + o2[j] + o3[j]) * rl; sa += y[j] * y[j]; }
                const float ra = __builtin_amdgcn_rsqf(wave_sum(sa) * (1.f / ATTW) + EPS);
#pragma unroll
                for (int j = 0; j < 8; ++j) y[j] = y[j] * ra * ga[j];
                *(GAS v4u*)(YB + m * DM + CONVW + c) = pack8f(y);
            }
        }
    }
    }
#endif
    xcd_barrier(bar);

#ifndef SKIP_P4
    { PHASE_PTRS
    {
        int kdim_ = DM; asm volatile("" : "+s"(kdim_)); pg8::Gemm g{YB, WOUT, MROWS, DM, kdim_}; pg8::StaticOrder S; S.init(MROWS, DM, G, bx);
        pg8::EpiResF32 E{ARG_IN(I_X), out, DM};
        pg8::gemm_phase<pg8::EpiResF32, pg8::StaticOrder, true, true>(L, g, S, E);
    }
    }
#endif
    xcd_barrier(bar);

#ifndef SKIP_P5
    { PHASE_PTRS
    rms_rows(out, ARG_IN(I_GFFN), HB, gw, NGW, lane);
    }
#endif
    xcd_barrier(bar);

#ifndef SKIP_P6
    { PHASE_PTRS
    {
        int kdim_ = DM; asm volatile("" : "+s"(kdim_)); pg8::Gemm g{HB, WGU, MROWS, 2 * DFF, kdim_}; pg8::StaticOrder S; S.init(MROWS, 2 * DFF, G, bx);
        pg8::EpiGU E{GB, UB, DFF};
        pg8::gemm_phase<pg8::EpiGU, pg8::StaticOrder, true, true>(L, g, S, E);
    }
    }
#endif
    xcd_barrier(bar);

#ifndef SKIP_P7
    { PHASE_PTRS
    {
        for (int it = gw; it < (MROWS / 16) * 6; it += NGW) {
            const int ch = it / 6, cg = it % 6, c = cg * 512 + 8 * lane, m0 = ch * 16;
            if (c < DFF) {
                float w0[8], w1[8], w2[8], bv[8], g1[8], g2[8];
                load8f(ARG_IN(I_FCW) + c, w0); load8f(ARG_IN(I_FCW) + DFF + c, w1); load8f(ARG_IN(I_FCW) + 2 * DFF + c, w2); load8f(ARG_IN(I_FCB) + c, bv);
                if ((m0 & (SEQ - 1)) == 0) {
#pragma unroll
                    for (int j = 0; j < 8; ++j) { g1[j] = 0.f; g2[j] = 0.f; }
                } else { unpack8(*(const GAS v4u*)(GB + (size_t)(m0 - 1) * DFF + c), g1); unpack8(*(const GAS v4u*)(GB + (size_t)(m0 - 2) * DFF + c), g2); }
                for (int tt = 0; tt < 16; ++tt) {
                    const size_t m = (size_t)(m0 + tt);
                    float g0[8], uu[8], a[8];
                    unpack8(*(const GAS v4u*)(GB + m * DFF + c), g0); unpack8(*(const GAS v4u*)(UB + m * DFF + c), uu);
#pragma unroll
                    for (int j = 0; j < 8; ++j) { const float pre = w0[j] * g2[j] + w1[j] * g1[j] + w2[j] * g0[j] + bv[j];
                        a[j] = pre * __builtin_amdgcn_rcpf(1.0f + __builtin_amdgcn_exp2f(-LOG2E * pre)) * uu[j]; g2[j] = g1[j]; g1[j] = g0[j]; }
                    *(GAS v4u*)(UB + m * DFF + c) = pack8f(a);
                }
            }
        }
    }
    }
#endif
    xcd_barrier(bar);

#ifndef SKIP_P8
    { PHASE_PTRS
    {
        int kdim_ = DFF; asm volatile("" : "+s"(kdim_)); pg8::Gemm g{UB, WDN, MROWS, DM, kdim_}; pg8::StaticOrder S; S.init(MROWS, DM, G, bx);
        pg8::EpiResF32 E{out, out, DM};
        pg8::gemm_phase<pg8::EpiResF32, pg8::StaticOrder, true, true>(L, g, S, E);
    }
    }
#endif
    xcd_barrier(bar);

#ifndef SKIP_P9
    { PHASE_PTRS
    rms_rows(out, ARG_IN(I_GPLE), HB, gw, NGW, lane);
    {
        int kdim_ = PLED; asm volatile("" : "+s"(kdim_)); pg8::Gemm g{PB, WPP, MROWS, DM, kdim_}; pg8::StaticOrder S; S.init(MROWS, DM, G, bx);
        pg8::EpiBf16 E{PP, DM};
        pg8::gemm_phase<pg8::EpiBf16, pg8::StaticOrder, true, true>(L, g, S, E);
    }
    }
#endif
    xcd_barrier(bar);

#ifndef SKIP_P10
    { PHASE_PTRS
    {
        int kdim_ = DM; asm volatile("" : "+s"(kdim_)); pg8::Gemm g{HB, WPG, MROWS, DM, kdim_}; pg8::StaticOrder S; S.init(MROWS, DM, G, bx);
        pg8::EpiPle E{out, out, PP, DM};
        pg8::gemm_phase<pg8::EpiPle, pg8::StaticOrder, true, true>(L, g, S, E);
    }
    }
#endif
}

extern "C" void kernel_launch(void* const* d_in, const int* in_sizes, int n_in, void* d_out, int out_size, void* d_ws, size_t ws_size, hipStream_t stream) {
    static int grid = 0;
    if (grid == 0) {
        if (n_in != 20 || out_size != MROWS * DM || ws_size < WS_END) { fprintf(stderr, "kernel_launch: unexpected shapes (n_in %d, out %d, ws %zu); nothing launched\n", n_in, out_size, ws_size); grid = -1; return; }
        int dev = 0, cus = 0, per_cu = 0;
        if (hipGetDevice(&dev) != hipSuccess || hipDeviceGetAttribute(&cus, hipDeviceAttributeMultiprocessorCount, dev) != hipSuccess) { grid = -1; return; }
        if (hipFuncSetAttribute((const void*)hybrid_fwd, hipFuncAttributeMaxDynamicSharedMemorySize, LDS_BYTES) != hipSuccess) { fprintf(stderr, "kernel_launch: hipFuncSetAttribute failed\n"); grid = -1; return; }
        if (hipOccupancyMaxActiveBlocksPerMultiprocessor(&per_cu, (const void*)hybrid_fwd, NWAVES * 64, LDS_BYTES) != hipSuccess || per_cu < 1)
            fprintf(stderr, "kernel_launch: note: occupancy query reports %d workgroups per CU\n", per_cu);
        (void)hipGetLastError();
        grid = cus;
        if (grid != 256) fprintf(stderr, "kernel_launch: %d CUs (built for 256)\n", grid);
    }
    if (grid < 0) return;
    if (hipMemsetAsync((char*)d_ws + WS_CTL, 0, CTL_ZERO_BYTES, stream) != hipSuccess) { fprintf(stderr, "kernel_launch: hipMemsetAsync failed\n"); return; }
    Args a{};
    for (int i = 0; i < 20; ++i) a.in[i] = (const float*)d_in[i];
    a.out = (float*)d_out; a.ws = (unsigned char*)d_ws;
    hipLaunchKernelGGL(hybrid_fwd, dim3(grid), dim3(NWAVES * 64), LDS_BYTES, stream, a);
    const hipError_t le = hipPeekAtLastError();
    if (le != hipSuccess) fprintf(stderr, "kernel_launch: launch failed: %s\n", hipGetErrorName(le));
}
```

```cpp
#define DUP_MASK 0x400
#include <hip/hip_runtime.h>
#include <cstdio>
#include <cstdint>
namespace pg8 {
#define PG8_LAS __attribute__((address_space(3)))
typedef unsigned short bf16_t;
typedef short bf16x8 __attribute__((ext_vector_type(8)));
typedef float f32x4 __attribute__((ext_vector_type(4)));
typedef unsigned u32x4 __attribute__((ext_vector_type(4)));
constexpr int BM = 256, BK = 64, HALF = 128, HTB = HALF * BK * 2  , STAGE_BYTES = 8 * HTB, NXCD = 8, WGM = 8;

__host__ __device__ __forceinline__ int lds_byte(int r, int c) { const int st = (r >> 4) * 2 + (c >> 5), rr = r & 15, cc = c & 31, ob = rr * 64 + cc * 2; return st * 1024 + (ob ^ (((ob >> 9) & 1) << 5)); }
__host__ __device__ __forceinline__ void stage_rc(int b, int& R, int& C) { const int st = b / 1024, sb = b % 1024, swz = sb ^ (((sb >> 9) & 1) << 5); R = (st >> 1) * 16 + swz / 64; C = (st & 1) * 32 + (swz % 64) / 2; }
__host__ __device__ __forceinline__ int perm32(int rho) { const int n = rho >> 4, i = rho & 15; return 8 * (i >> 2) + 4 * n + (i & 3); }

struct Unit { int pm, pn; };
struct Gemm { const bf16_t* A; const bf16_t* Bt; int M, N, K; };

struct StaticOrder {
    int nM, nN, nwg, G, c;
    __host__ __device__ void init(int M, int N, int G_, int c_) { nM = M / BM; nN = N / BM; nwg = nM * nN; G = G_; c = c_; }
    __host__ __device__ bool next(int i, Unit& u) const {
        const long L = (long)i * G + c; if (L >= nwg) return false;
        int wgid = (int)L; { const int q = nwg / NXCD, r = nwg % NXCD, xcd = wgid % NXCD, off = wgid / NXCD; wgid = (xcd < r ? xcd * (q + 1) : r * (q + 1) + (xcd - r) * q) + off; }
        const int nig = WGM * nN, gid = wgid / nig, fm = gid * WGM, gsz = (nM - fm) < WGM ? (nM - fm) : WGM;
        u.pm = fm + ((wgid % nig) % gsz); u.pn = (wgid % nig) / gsz; return true;
    }
    __device__ __forceinline__ void a_ready(const Unit&) const {}
    __device__ __forceinline__ void done(const Unit&) const {}
};

__device__ __forceinline__ unsigned cvt_pk_bf16(float lo, float hi) { unsigned r; asm volatile("v_cvt_pk_bf16_f32 %0, %1, %2" : "=v"(r) : "v"(lo), "v"(hi)); return r; }
__device__ __forceinline__ u32x4 pack8(const f32x4& v0, const f32x4& v1) { u32x4 w; w.x = cvt_pk_bf16(v0[0], v0[1]); w.y = cvt_pk_bf16(v0[2], v0[3]); w.z = cvt_pk_bf16(v1[0], v1[1]); w.w = cvt_pk_bf16(v1[2], v1[3]); return w; }
__device__ __forceinline__ float bf2f(unsigned short h) { return __builtin_bit_cast(float, (unsigned)h << 16); }

struct EpiBf16 {
    static constexpr bool PERM = true, AFTER_DRAIN = false;
    bf16_t* O; int ldc;
    __device__ __forceinline__ void operator()(const f32x4 (&acc)[2][2][4][2], const Unit& u, int wr, int wc, int fr, int fq) const {
        const int row0 = u.pm * BM + wr * 64 + fr, col0 = u.pn * BM + wc * 32 + 8 * fq;
#pragma unroll
        for (int ai = 0; ai < 2; ++ai)
#pragma unroll
            for (int m = 0; m < 4; ++m) { bf16_t* rowp = O + (size_t)(row0 + ai * HALF + m * 16) * ldc + col0;
#pragma unroll
                for (int bj = 0; bj < 2; ++bj) *(u32x4*)(rowp + bj * HALF) = pack8(acc[ai][bj][m][0], acc[ai][bj][m][1]); }
    }
};
__device__ __forceinline__ float rstd4(const f32x4 a, float eps) { return __builtin_amdgcn_rsqf(((a[0] + a[1]) + (a[2] + a[3])) * (1.0f / 1024.0f) + eps); }
struct EpiGU {
    static constexpr bool PERM = true, AFTER_DRAIN = false;
    bf16_t* G; bf16_t* U; int ldc; const float* SS; float eps;
    __device__ __forceinline__ void operator()(const f32x4 (&acc)[2][2][4][2], const Unit& u, int wr, int wc, int fr, int fq) const {
        const int row0 = u.pm * BM + wr * 64 + fr, col0 = u.pn * HALF + wc * 32 + 8 * fq;
        f32x4 sp[2][4];
#pragma unroll
        for (int ai = 0; ai < 2; ++ai)
#pragma unroll
            for (int m = 0; m < 4; ++m) sp[ai][m] = *(const f32x4*)(SS + (size_t)(row0 + ai * HALF + m * 16) * 4);
#pragma unroll
        for (int ai = 0; ai < 2; ++ai)
#pragma unroll
            for (int m = 0; m < 4; ++m) { const int row = row0 + ai * HALF + m * 16; const float rs = rstd4(sp[ai][m], eps); const size_t off = (size_t)row * ldc + col0;
                *(u32x4*)(G + off) = pack8(acc[ai][0][m][0] * rs, acc[ai][0][m][1] * rs);
                *(u32x4*)(U + off) = pack8(acc[ai][1][m][0] * rs, acc[ai][1][m][1] * rs); }
    }
};
__device__ __forceinline__ float dpp_ror1(float v) { return __builtin_bit_cast(float, __builtin_amdgcn_mov_dpp(__builtin_bit_cast(int, v), 0x121, 0xf, 0xf, false)); }
__device__ __forceinline__ float dpp_ror2(float v) { return __builtin_bit_cast(float, __builtin_amdgcn_mov_dpp(__builtin_bit_cast(int, v), 0x122, 0xf, 0xf, false)); }
struct EpiGUAct {
    static constexpr bool PERM = true, AFTER_DRAIN = false;
    bf16_t* ACT; int ldc; const float* SS; float eps; const float* cw; const float* cbias; float* TOPG; float* BOTG; float* TOPU; PG8_LAS float* xch;
    __device__ __forceinline__ void operator()(const f32x4 (&acc_)[2][2][4][2], const Unit& u, int wr, int wc, int fr, int fq) const {
        f32x4 (&acc)[2][2][4][2] = const_cast<f32x4 (&)[2][2][4][2]>(acc_);
        const int row0 = u.pm * BM + wr * 64 + fr, colh = wc * 32 + 8 * fq, col0 = u.pn * HALF + colh;
        {
            f32x4 sp[2][4];
#pragma unroll
            for (int ai = 0; ai < 2; ++ai)
#pragma unroll
                for (int m = 0; m < 4; ++m) sp[ai][m] = *(const f32x4*)(SS + (size_t)(row0 + ai * HALF + m * 16) * 4);
#pragma unroll
            for (int ai = 0; ai < 2; ++ai)
#pragma unroll
                for (int m = 0; m < 4; ++m) { const float rs = rstd4(sp[ai][m], eps);
#pragma unroll
                    for (int bj = 0; bj < 2; ++bj)
#pragma unroll
                        for (int n = 0; n < 2; ++n) acc[ai][bj][m][n] = acc[ai][bj][m][n] * rs; }
        }
        if (fr >= 14) {
#pragma unroll
            for (int ai = 0; ai < 2; ++ai)
#pragma unroll
                for (int n = 0; n < 2; ++n) *(PG8_LAS f32x4*)(xch + (((wr * 2 + ai) * 2 + (fr - 14)) * 128 + colh + 4 * n)) = acc[ai][0][3][n];
            if (wr == 1) {
#pragma unroll
                for (int n = 0; n < 2; ++n) *(f32x4*)(BOTG + (size_t)(u.pm * 2 + fr - 14) * ldc + col0 + 4 * n) = acc[1][0][3][n];
            }
        }
        if (wr == 0 && fr < 2) {
#pragma unroll
            for (int n = 0; n < 2; ++n) { *(f32x4*)(TOPG + (size_t)(u.pm * 2 + fr) * ldc + col0 + 4 * n) = acc[0][0][0][n]; *(f32x4*)(TOPU + (size_t)(u.pm * 2 + fr) * ldc + col0 + 4 * n) = acc[0][1][0][n]; }
        }
        asm volatile("s_waitcnt lgkmcnt(0)" ::: "memory"); __builtin_amdgcn_s_barrier(); asm volatile("" ::: "memory");
        typedef unsigned u32x2v __attribute__((ext_vector_type(2)));
#pragma unroll
        for (int n = 0; n < 2; ++n) {
            const f32x4 w0 = *(const f32x4*)(cw + col0 + 4 * n), w1 = *(const f32x4*)(cw + ldc + col0 + 4 * n), w2 = *(const f32x4*)(cw + 2 * ldc + col0 + 4 * n), bb = *(const f32x4*)(cbias + col0 + 4 * n);
#pragma unroll
            for (int ai = 0; ai < 2; ++ai) {
                f32x4 r1p, r2p;
                if (wr == 0 && ai == 0) { r1p = (f32x4){0.f, 0.f, 0.f, 0.f}; r2p = (f32x4){0.f, 0.f, 0.f, 0.f}; }
                else {
                    const int pw = wr ^ 1, pai = (wr == 1) ? ai : ai - 1;
                    const PG8_LAS float* xb = xch + ((pw * 2 + pai) * 2) * 128 + colh + 4 * n;
                    const f32x4 e2 = *(const PG8_LAS f32x4*)(xb), e1 = *(const PG8_LAS f32x4*)(xb + 128); r1p = e1; r2p = (fr == 0) ? e2 : e1;
                }
#pragma unroll
                for (int m = 0; m < 4; ++m) {
                    const f32x4 g = acc[ai][0][m][n], uu = acc[ai][1][m][n];
                    f32x4 r1, r2, a4;
#pragma unroll
                    for (int j = 0; j < 4; ++j) { r1[j] = dpp_ror1(g[j]); r2[j] = dpp_ror2(g[j]); }
#pragma unroll
                    for (int j = 0; j < 4; ++j) {
                        const float p1 = (fr == 0) ? r1p[j] : r1[j], p2 = (fr < 2) ? r2p[j] : r2[j];
                        const float pre = w0[j] * p2 + w1[j] * p1 + w2[j] * g[j] + bb[j];
                        a4[j] = pre * __builtin_amdgcn_rcpf(1.0f + __builtin_amdgcn_exp2f(-1.4426950408889634f * pre)) * uu[j];
                    }
                    r1p = r1; r2p = r2;
                    u32x2v w; w.x = cvt_pk_bf16(a4[0], a4[1]); w.y = cvt_pk_bf16(a4[2], a4[3]);
                    *(u32x2v*)(ACT + (size_t)(row0 + ai * HALF + m * 16) * ldc + col0 + 4 * n) = w;
                    asm volatile("" ::: "memory");
                }
            }
        }
    }
};
struct EpiInProj {
    static constexpr bool PERM = true, AFTER_DRAIN = false;
    bf16_t* ZC; bf16_t* Q; bf16_t* Kk; bf16_t* V; const float* gq; const float* gk; float qscale; float eps;
    __device__ __forceinline__ void operator()(const f32x4 (&acc)[2][2][4][2], const Unit& u, int wr, int wc, int fr, int fq) const {
        if (u.pn < 6) {
            const int row0 = u.pm * BM + wr * 64 + fr, col0 = u.pn * BM + wc * 32 + 8 * fq;
#pragma unroll
            for (int ai = 0; ai < 2; ++ai)
#pragma unroll
                for (int m = 0; m < 4; ++m) { bf16_t* rowp = ZC + (size_t)(row0 + ai * HALF + m * 16) * 1536 + col0;
#pragma unroll
                    for (int bj = 0; bj < 2; ++bj) *(u32x4*)(rowp + bj * HALF) = pack8(acc[ai][bj][m][0], acc[ai][bj][m][1]); }
        } else {
            const int sec = u.pn - 6, which = sec >> 1, head = 4 * (sec & 1) + wc;
            if (which < 2) {
                bf16_t* base = which == 0 ? Q : Kk;
                const float* g = which == 0 ? gq : gk;
                const float sc = which == 0 ? qscale : 1.f;
                const f32x4 g00 = *(const f32x4*)(g + 8 * fq), g01 = *(const f32x4*)(g + 8 * fq + 4), g10 = *(const f32x4*)(g + 32 + 8 * fq), g11 = *(const f32x4*)(g + 32 + 8 * fq + 4);
#pragma unroll
                for (int ai = 0; ai < 2; ++ai)
#pragma unroll
                    for (int m = 0; m < 4; ++m) {
                        const int row = u.pm * BM + ai * HALF + wr * 64 + m * 16 + fr, b = row >> 13, t = row & 8191;
                        float ss = 0.f;
#pragma unroll
                        for (int bj = 0; bj < 2; ++bj)
#pragma unroll
                            for (int n = 0; n < 2; ++n) { const f32x4 x = acc[ai][bj][m][n]; ss += (x[0] * x[0] + x[1] * x[1]) + (x[2] * x[2] + x[3] * x[3]); }
                        ss += __shfl_xor(ss, 16); ss += __shfl_xor(ss, 32);
                        const float rs = sc * __builtin_amdgcn_rsqf(ss * (1.0f / 64.0f) + eps);
                        bf16_t* dst = base + ((size_t)((b * 8 + head) * 8192 + t)) * 64 + 8 * fq;
                        *(u32x4*)(dst) = pack8(acc[ai][0][m][0] * rs * g00, acc[ai][0][m][1] * rs * g01);
                        *(u32x4*)(dst + 32) = pack8(acc[ai][1][m][0] * rs * g10, acc[ai][1][m][1] * rs * g11);
                    }
            } else {
#pragma unroll
                for (int ai = 0; ai < 2; ++ai)
#pragma unroll
                    for (int m = 0; m < 4; ++m) {
                        const int row = u.pm * BM + ai * HALF + wr * 64 + m * 16 + fr, b = row >> 13, t = row & 8191;
                        bf16_t* dst = V + ((size_t)((b * 8 + head) * 8192 + t)) * 64 + 8 * fq;
                        *(u32x4*)(dst) = pack8(acc[ai][0][m][0], acc[ai][0][m][1]);
                        *(u32x4*)(dst + 32) = pack8(acc[ai][1][m][0], acc[ai][1][m][1]);
                    }
            }
        }
    }
};
template <bool BASE_BF16> struct EpiResNorm {
    static constexpr bool PERM = true, AFTER_DRAIN = false;
    const void* base; bf16_t* XB; float* SS; int ldc; PG8_LAS float* red;
    __device__ __forceinline__ void operator()(const f32x4 (&acc)[2][2][4][2], const Unit& u, int wr, int wc, int fr, int fq) const {
        const int row0 = u.pm * BM + wr * 64 + fr, col0 = u.pn * BM + wc * 32 + 8 * fq;
#pragma unroll
        for (int ai = 0; ai < 2; ++ai)
#pragma unroll
            for (int m = 0; m < 4; ++m) { const int row = row0 + ai * HALF + m * 16; const size_t off = (size_t)row * ldc + col0; float ss = 0.f;
#pragma unroll
                for (int bj = 0; bj < 2; ++bj) {
                    f32x4 b0, b1;
                    if constexpr (BASE_BF16) { const u32x4 w = *(const u32x4*)((const bf16_t*)base + off + bj * HALF);
                        b0[0] = __builtin_bit_cast(float, w.x << 16); b0[1] = __builtin_bit_cast(float, w.x & 0xffff0000u); b0[2] = __builtin_bit_cast(float, w.y << 16); b0[3] = __builtin_bit_cast(float, w.y & 0xffff0000u);
                        b1[0] = __builtin_bit_cast(float, w.z << 16); b1[1] = __builtin_bit_cast(float, w.z & 0xffff0000u); b1[2] = __builtin_bit_cast(float, w.w << 16); b1[3] = __builtin_bit_cast(float, w.w & 0xffff0000u); }
                    else { b0 = *(const f32x4*)((const float*)base + off + bj * HALF); b1 = *(const f32x4*)((const float*)base + off + bj * HALF + 4); }
                    const f32x4 x0 = b0 + acc[ai][bj][m][0], x1 = b1 + acc[ai][bj][m][1];
                    *(u32x4*)(XB + off + bj * HALF) = pack8(x0, x1);
                    ss += ((x0[0] * x0[0] + x0[1] * x0[1]) + (x0[2] * x0[2] + x0[3] * x0[3])) + ((x1[0] * x1[0] + x1[1] * x1[1]) + (x1[2] * x1[2] + x1[3] * x1[3]));
                }
                ss += __shfl_xor(ss, 16); ss += __shfl_xor(ss, 32);
                if (fq == 0) red[(ai * HALF + wr * 64 + m * 16 + fr) * 4 + wc] = ss; }
        asm volatile("s_waitcnt lgkmcnt(0)" ::: "memory"); __builtin_amdgcn_s_barrier(); asm volatile("" ::: "memory");
        { const int t = threadIdx.x; if (t < 256) { const f32x4 v = *(const PG8_LAS f32x4*)(red + t * 4); SS[(size_t)(u.pm * BM + t) * 4 + u.pn] = (v[0] + v[1]) + (v[2] + v[3]); } }
        asm volatile("s_waitcnt lgkmcnt(0)" ::: "memory"); __builtin_amdgcn_s_barrier(); asm volatile("" ::: "memory");
    }
};
struct EpiPle {
    static constexpr bool PERM = true, AFTER_DRAIN = false;
    const bf16_t* xb; float* out; const bf16_t* pp; int ldc; const float* SS; float eps;
    __device__ __forceinline__ void operator()(const f32x4 (&acc)[2][2][4][2], const Unit& u, int wr, int wc, int fr, int fq) const {
        const int row0 = u.pm * BM + wr * 64 + fr, col0 = u.pn * BM + wc * 32 + 8 * fq;
        f32x4 sp[2][4];
#pragma unroll
        for (int ai = 0; ai < 2; ++ai)
#pragma unroll
            for (int m = 0; m < 4; ++m) sp[ai][m] = *(const f32x4*)(SS + (size_t)(row0 + ai * HALF + m * 16) * 4);
#pragma unroll
        for (int ai = 0; ai < 2; ++ai)
#pragma unroll
            for (int m = 0; m < 4; ++m) { const size_t off = (size_t)(row0 + ai * HALF + m * 16) * ldc + col0; const float rs = -1.4426950408889634f * rstd4(sp[ai][m], eps);
#pragma unroll
                for (int bj = 0; bj < 2; ++bj) { const size_t o2 = off + bj * HALF; const u32x4 bw = *(const u32x4*)(xb + o2), pw = *(const u32x4*)(pp + o2);
                    const unsigned bws[4] = {bw.x, bw.y, bw.z, bw.w}, pws[4] = {pw.x, pw.y, pw.z, pw.w};
                    f32x4 o[2];
#pragma unroll
                    for (int n = 0; n < 2; ++n)
#pragma unroll
                        for (int e = 0; e < 4; ++e) { const unsigned bb = bws[2 * n + (e >> 1)], pq = pws[2 * n + (e >> 1)];
                            const float bv = (e & 1) ? __builtin_bit_cast(float, bb & 0xffff0000u) : __builtin_bit_cast(float, bb << 16), pv = (e & 1) ? __builtin_bit_cast(float, pq & 0xffff0000u) : __builtin_bit_cast(float, pq << 16);
                            const float sg = __builtin_amdgcn_rcpf(1.0f + __builtin_amdgcn_exp2f(rs * acc[ai][bj][m][n][e])); o[n][e] = bv + sg * pv; }
                    *(f32x4*)(out + o2) = o[0]; *(f32x4*)(out + o2 + 4) = o[1]; } }
    }
};

template <class Epi, class Sched, bool ALIGN_EPI = false, bool SP2 = false>
__device__ __forceinline__ void gemm_phase(PG8_LAS unsigned char* lds, const Gemm g, const Sched& S, const Epi& E) {
    const int tid = threadIdx.x, wid = __builtin_amdgcn_readfirstlane(tid >> 6), lane = tid & 63, wr = wid >> 2, wc = wid & 3, fr = lane & 15, fq = lane >> 4;
    const int K = g.K, nt = K / BK;
    unsigned voffA[2], voffB[2];
#pragma unroll
    for (int i = 0; i < 2; ++i) { int R, C; stage_rc(tid * 16 + i * 8192, R, C); const int Rb = Epi::PERM ? ((R & ~31) + perm32(R & 31)) : R;
        voffA[i] = (unsigned)(R * K + C) * 2u; voffB[i] = (unsigned)(Rb * K + C) * 2u; }
    const size_t kstep = (size_t)(BK * 2);
    const size_t hstep = (size_t)HALF * K * 2;
    const size_t tstep = 2 * hstep;
    const unsigned ldsw = (unsigned)wid * 1024u;
    const int aoff = lds_byte(wr * 64 + fr, fq * 8), boff = lds_byte(wc * 32 + fr, fq * 8);
#define PG8_SA(b, h) (((b) * 2 + (h)) * HTB)
#define PG8_SB(b, h) ((4 + (b) * 2 + (h)) * HTB)
#define PG8_STAGE(bufoff, gbase, voff) do { _Pragma("unroll") for (int _i = 0; _i < 2; ++_i) \
        __builtin_amdgcn_global_load_lds((const unsigned*)((const char*)(gbase) + (voff)[_i]), (PG8_LAS unsigned*)(lds + (bufoff) + ldsw + _i * 8192), 16, 0, 0); } while (0)
#define PG8_LDA(dst, b, h) do { _Pragma("unroll") for (int m = 0; m < 4; ++m) _Pragma("unroll") for (int k = 0; k < 2; ++k) dst[m][k] = *(const PG8_LAS bf16x8*)(lds + PG8_SA(b, h) + aoff + m * 2048 + k * 1024); } while (0)
#define PG8_LDB(dst, b, h) do { _Pragma("unroll") for (int n = 0; n < 2; ++n) _Pragma("unroll") for (int k = 0; k < 2; ++k) dst[n][k] = *(const PG8_LAS bf16x8*)(lds + PG8_SB(b, h) + boff + n * 2048 + k * 1024); } while (0)
#define PG8_MMA(ai, bj, At, Bt) do { __builtin_amdgcn_s_setprio(1); _Pragma("unroll") for (int m = 0; m < 4; ++m) _Pragma("unroll") for (int n = 0; n < 2; ++n) _Pragma("unroll") for (int k = 0; k < 2; ++k) \
        acc[ai][bj][m][n] = __builtin_amdgcn_mfma_f32_16x16x32_bf16(Bt[n][k], At[m][k], acc[ai][bj][m][n], 0, 0, 0); __builtin_amdgcn_s_setprio(0); } while (0)
#define PG8_WAIT_V(n) asm volatile("s_waitcnt vmcnt(" #n ")" ::: "memory")
#define PG8_WAIT_L(n) asm volatile("s_waitcnt lgkmcnt(" #n ")" ::: "memory")
#define PG8_BAR __builtin_amdgcn_s_barrier()
#define PG8_SCHED __builtin_amdgcn_sched_barrier(0)
    Unit cur, nxt; int ui = 0;
    if (!S.next(0, cur)) return;
    f32x4 acc[2][2][4][2];
#pragma unroll
    for (int a = 0; a < 2; ++a)
#pragma unroll
        for (int b = 0; b < 2; ++b)
#pragma unroll
            for (int m = 0; m < 4; ++m)
#pragma unroll
                for (int n = 0; n < 2; ++n) acc[a][b][m][n] = (f32x4){0.f, 0.f, 0.f, 0.f};
    bf16x8 At[4][2], B0[2][2], B1[2][2];
    const char* cA = (const char*)g.A + (size_t)cur.pm * tstep; const char* cB = (const char*)g.Bt + (size_t)cur.pn * tstep;
    S.a_ready(cur);
    if constexpr (SP2) {
        PG8_STAGE(PG8_SB(0, 0), cB, voffB); PG8_STAGE(PG8_SB(0, 1), cB + hstep, voffB); PG8_STAGE(PG8_SA(0, 0), cA, voffA); PG8_STAGE(PG8_SA(0, 1), cA + hstep, voffA);
        if (wr == 1) PG8_BAR;
        PG8_WAIT_V(2); PG8_BAR;
        PG8_STAGE(PG8_SB(1, 0), cB + kstep, voffB); PG8_STAGE(PG8_SA(1, 0), cA + kstep, voffA); PG8_STAGE(PG8_SB(1, 1), cB + hstep + kstep, voffB);
        PG8_WAIT_V(6); PG8_BAR;
    } else {
        PG8_STAGE(PG8_SB(0, 0), cB, voffB); PG8_STAGE(PG8_SA(0, 0), cA, voffA); PG8_STAGE(PG8_SB(0, 1), cB + hstep, voffB); PG8_STAGE(PG8_SA(0, 1), cA + hstep, voffA);
        if (wr == 1) PG8_BAR;
        PG8_WAIT_V(4); PG8_BAR;
        PG8_STAGE(PG8_SB(1, 0), cB + kstep, voffB); PG8_STAGE(PG8_SA(1, 0), cA + kstep, voffA); PG8_STAGE(PG8_SB(1, 1), cB + hstep + kstep, voffB);
        PG8_WAIT_V(6); PG8_BAR;
    }
    for (;;) {
        const bool has_next = S.next(ui + 1, nxt);
        const char* nA = has_next ? (const char*)g.A + (size_t)nxt.pm * tstep : cA; const char* nB = has_next ? (const char*)g.Bt + (size_t)nxt.pn * tstep : cB;
        for (int t = 0; t < nt; t += 2) {
            const bool last = (t == nt - 2);
            const char* a1 = cA + (size_t)(t + 1) * kstep;
            const char* a2 = last ? nA : cA + (size_t)(t + 2) * kstep; const char* b2 = last ? nB : cB + (size_t)(t + 2) * kstep;
            const char* a3 = a2 + kstep; const char* b3 = b2 + kstep;
            if (last && has_next) S.a_ready(nxt);
            if constexpr (SP2) {
            PG8_LDB(B0, 0, 0); PG8_LDB(B1, 0, 1); PG8_SCHED; PG8_LDA(At, 0, 0); PG8_STAGE(PG8_SA(1, 1), a1 + hstep, voffA);
            PG8_WAIT_V(8); PG8_WAIT_L(0); PG8_BAR; PG8_MMA(0, 0, At, B0); PG8_MMA(0, 1, At, B1); PG8_BAR; PG8_SCHED;
            PG8_LDA(At, 0, 1); PG8_STAGE(PG8_SB(0, 0), b2, voffB); PG8_STAGE(PG8_SB(0, 1), b2 + hstep, voffB); PG8_STAGE(PG8_SA(0, 0), a2, voffA);
            PG8_WAIT_V(8); PG8_WAIT_L(0); PG8_BAR; PG8_MMA(1, 0, At, B0); PG8_MMA(1, 1, At, B1); PG8_BAR; PG8_SCHED;
            PG8_LDB(B0, 1, 0); PG8_LDB(B1, 1, 1); PG8_SCHED; PG8_LDA(At, 1, 0); PG8_STAGE(PG8_SA(0, 1), a2 + hstep, voffA);
            PG8_WAIT_V(8); PG8_WAIT_L(0); PG8_BAR; PG8_MMA(0, 0, At, B0); PG8_MMA(0, 1, At, B1); PG8_BAR; PG8_SCHED;
            PG8_LDA(At, 1, 1); PG8_STAGE(PG8_SB(1, 0), b3, voffB); PG8_STAGE(PG8_SB(1, 1), b3 + hstep, voffB); PG8_STAGE(PG8_SA(1, 0), a3, voffA);
            PG8_WAIT_V(8); PG8_WAIT_L(0); PG8_BAR; PG8_MMA(1, 0, At, B0); PG8_MMA(1, 1, At, B1); PG8_BAR; PG8_SCHED;
            } else {
            PG8_LDB(B0, 0, 0); PG8_SCHED; PG8_LDA(At, 0, 0); PG8_STAGE(PG8_SA(1, 1), a1 + hstep, voffA);
            PG8_WAIT_L(8); PG8_BAR; PG8_WAIT_L(0); PG8_MMA(0, 0, At, B0); PG8_BAR; PG8_SCHED;
            PG8_LDB(B1, 0, 1); PG8_STAGE(PG8_SB(0, 0), b2, voffB);
            PG8_BAR; PG8_WAIT_L(0); PG8_MMA(0, 1, At, B1); PG8_BAR;
            PG8_LDA(At, 0, 1); PG8_STAGE(PG8_SA(0, 0), a2, voffA);
            PG8_BAR; PG8_WAIT_L(0); PG8_MMA(1, 0, At, B0); PG8_BAR; PG8_SCHED;
            PG8_STAGE(PG8_SB(0, 1), b2 + hstep, voffB);
            PG8_WAIT_V(6); PG8_BAR; PG8_MMA(1, 1, At, B1); PG8_BAR;
            PG8_LDB(B0, 1, 0); PG8_SCHED; PG8_LDA(At, 1, 0); PG8_STAGE(PG8_SA(0, 1), a2 + hstep, voffA);
            PG8_WAIT_L(8); PG8_BAR; PG8_WAIT_L(0); PG8_MMA(0, 0, At, B0); PG8_BAR; PG8_SCHED;
            PG8_LDB(B1, 1, 1); PG8_STAGE(PG8_SB(1, 0), b3, voffB);
            PG8_BAR; PG8_WAIT_L(0); PG8_MMA(0, 1, At, B1); PG8_BAR;
            PG8_LDA(At, 1, 1); PG8_STAGE(PG8_SA(1, 0), a3, voffA);
            PG8_BAR; PG8_WAIT_L(0); PG8_MMA(1, 0, At, B0); PG8_BAR; PG8_SCHED;
            PG8_STAGE(PG8_SB(1, 1), b3 + hstep, voffB);
            PG8_WAIT_V(6); PG8_BAR; PG8_MMA(1, 1, At, B1); PG8_BAR;
            }
        }
        if constexpr (ALIGN_EPI) { if (wr == 0) PG8_BAR; }
        if constexpr (!Epi::AFTER_DRAIN) { E(acc, cur, wr, wc, fr, fq); S.done(cur); }
        if (!has_next) break;
#pragma unroll
        for (int a = 0; a < 2; ++a)
#pragma unroll
            for (int b = 0; b < 2; ++b)
#pragma unroll
                for (int m = 0; m < 4; ++m)
#pragma unroll
                    for (int n = 0; n < 2; ++n) acc[a][b][m][n] = (f32x4){0.f, 0.f, 0.f, 0.f};
        cur = nxt; cA = nA; cB = nB; ++ui;
        if constexpr (ALIGN_EPI) { if (wr == 1) PG8_BAR; }
    }
    PG8_WAIT_V(0);
    if constexpr (!ALIGN_EPI) { if (wr == 0) PG8_BAR; }
    PG8_BAR;
    if constexpr (Epi::AFTER_DRAIN) { E.fused(acc, cur, wr, wc, fr, fq, lds, wid, lane); S.done(cur); }
#undef PG8_SA
#undef PG8_SB
#undef PG8_STAGE
#undef PG8_LDA
#undef PG8_LDB
#undef PG8_MMA
#undef PG8_WAIT_V
#undef PG8_WAIT_L
#undef PG8_BAR
#undef PG8_SCHED
}
}
#define GAS __attribute__((address_space(1)))
#define LAS __attribute__((address_space(3)))
typedef unsigned short bf16;
typedef unsigned v4u __attribute__((ext_vector_type(4)));
typedef float f32x4 __attribute__((ext_vector_type(4)));
typedef short bf16x8 __attribute__((ext_vector_type(8)));
typedef GAS unsigned gu32;
typedef GAS unsigned long long gu64;
#define RLX_AGENT __ATOMIC_RELAXED, __HIP_MEMORY_SCOPE_AGENT
#define LDS_WAIT() asm volatile("s_waitcnt lgkmcnt(0)" ::: "memory")
#define VM_WAIT() asm volatile("s_waitcnt vmcnt(0)" ::: "memory")
__device__ __forceinline__ unsigned long long rt() { return __builtin_amdgcn_s_memrealtime(); }
__device__ __forceinline__ unsigned f2bf(float f) { unsigned u = __builtin_bit_cast(unsigned, f); return (u + 0x7fffu + ((u >> 16) & 1u)) >> 16; }
__device__ __forceinline__ unsigned pk2(float lo, float hi) { return f2bf(lo) | (f2bf(hi) << 16); }

#define XB_TMO      128
#define XB_XCNT(j)  (256  + 64 * (j))
#define XB_XSUB(j)  (1280 + 64 * (j))
#define XB_XGEN(j)  (2304 + 64 * (j))
#define XB_TOP      3328
#define XB_TOPGEN   3392
#define XCD_BAR_WORDS 3456
#define XB_SPIN_CAP (1u << 18)

__device__ __forceinline__ unsigned xb_ld(unsigned* p)              { return __hip_atomic_load(p, __ATOMIC_RELAXED, __HIP_MEMORY_SCOPE_AGENT); }
__device__ __forceinline__ unsigned xb_add(unsigned* p, unsigned v) { return __hip_atomic_fetch_add(p, v, __ATOMIC_RELAXED, __HIP_MEMORY_SCOPE_AGENT); }
__device__ __forceinline__ unsigned xb_xcc_id() { return (unsigned)__builtin_amdgcn_s_getreg((3 << 11) | 20) & 0xFu; }
#define XB_SPIN(cond, bar) do { unsigned _sp = 0; while (cond) { __builtin_amdgcn_s_sleep(1); \
    if ((++_sp & 255u) == 0u) { if (xb_ld(&(bar)[XB_TMO])) break; if (_sp > XB_SPIN_CAP) { atomicAdd(&(bar)[XB_TMO], 1u); break; } } } } while (0)

struct XcdBarrier {
    unsigned* bar; unsigned x;
    volatile LAS unsigned* st;
};

__device__ __forceinline__ XcdBarrier xcd_barrier_post(unsigned* bar, volatile LAS unsigned* st) {
    XcdBarrier b; b.bar = bar; b.x = xb_xcc_id(); b.st = st;
    if (threadIdx.x == 0) (void)xb_add(&bar[XB_XCNT(b.x)], 1u);
    return b;
}
__device__ __forceinline__ void xcd_barrier_complete(unsigned* bar, unsigned x, unsigned& nloc, unsigned& nx) {
    const unsigned G = gridDim.x * gridDim.y * gridDim.z;
    unsigned sum, cnt, mine, sp = 0u;
    for (;;) {
        sum = 0u; cnt = 0u; mine = 0u;
#pragma unroll
        for (unsigned j = 0; j < 16; ++j) { const unsigned c = xb_ld(&bar[XB_XCNT(j)]); sum += c; cnt += (c > 0u) ? 1u : 0u; mine = (j == x) ? c : mine; }
        if (sum == G) break;
        __builtin_amdgcn_s_sleep(1);
        if ((++sp & 255u) == 0u) { if (xb_ld(&bar[XB_TMO])) break; if (sp > XB_SPIN_CAP) { atomicAdd(&bar[XB_TMO], 1u); break; } }
    }
    nloc = mine > 0u ? mine : 1u; nx = cnt > 0u ? cnt : 1u;
}

__device__ __forceinline__ void xcd_barrier(const XcdBarrier& b) {
    asm volatile("s_waitcnt vmcnt(0)" ::: "memory");
    __syncthreads();
    if (threadIdx.x == 0) {
        unsigned* bar = b.bar;
        __builtin_amdgcn_s_waitcnt(0);
        unsigned nloc = b.st[0], nx = b.st[1];
        if (nloc == 0u) { xcd_barrier_complete(bar, b.x, nloc, nx); b.st[0] = nloc; b.st[1] = nx; }
        const unsigned old = xb_add(&bar[XB_XSUB(b.x)], 1u);
        const unsigned gen = old / nloc;
        if (old + 1u == (gen + 1u) * nloc) {
            __builtin_amdgcn_fence(__ATOMIC_RELEASE, "agent");
            asm volatile("s_waitcnt vmcnt(0)" ::: "memory");
            const unsigned og = xb_add(&bar[XB_TOP], 1u);
            const unsigned tg = og / nx;
            if (og + 1u == (tg + 1u) * nx) xb_add(&bar[XB_TOPGEN], 1u);
            else XB_SPIN(xb_ld(&bar[XB_TOPGEN]) == tg, bar);
            __builtin_amdgcn_fence(__ATOMIC_ACQUIRE, "agent");
            xb_add(&bar[XB_XGEN(b.x)], 1u);
            asm volatile("s_waitcnt vmcnt(0)" ::: "memory");
        } else {
            XB_SPIN(xb_ld(&bar[XB_XGEN(b.x)]) == gen, bar);
            __builtin_amdgcn_fence(__ATOMIC_ACQUIRE, "agent");
            asm volatile("s_waitcnt vmcnt(0)" ::: "memory");
        }
    }
    __syncthreads();
}

constexpr int NWAVES = 8;
constexpr int BATCH = 4, SEQ = 8192, DM = 1024, MROWS = BATCH * SEQ, CONVW = 512, NHEAD = 8, HD = 64, ATTW = 512, INCOLS = 3072, DFF = 2816, PLED = 256;
constexpr float EPS = 1e-6f;
constexpr float LOG2E = 1.4426950408889634f;
constexpr size_t MiB = 1u << 20;
constexpr size_t WS_CTL = 0, CTL_ZERO_BYTES = 1 * MiB;
constexpr size_t WS_WIN = 2 * MiB, WS_WOUT = 8 * MiB, WS_WGU = 10 * MiB, WS_WDN = 21 * MiB, WS_WPG = 27 * MiB, WS_WPP = 29 * MiB;
constexpr size_t WS_H = 32 * MiB;
constexpr size_t WS_PB = 96 * MiB;
constexpr size_t WS_ZC = 112 * MiB;
constexpr size_t WS_Q = 208 * MiB, WS_K = 240 * MiB, WS_V = 272 * MiB;
constexpr size_t WS_OP = 304 * MiB;
constexpr size_t WS_LP = 400 * MiB;
constexpr size_t WS_Y = 404 * MiB;
constexpr size_t WS_U = 112 * MiB;
constexpr size_t WS_TOPG = 288 * MiB, WS_BOTG = 291 * MiB, WS_TOPU = 294 * MiB;
constexpr size_t WS_PP = 300 * MiB;
constexpr size_t WS_SS = 30 * MiB;
constexpr size_t WS_X2 = 364 * MiB;
constexpr size_t WS_END = 468 * MiB;
constexpr int CW_BAR = 4096;
constexpr int RING_BYTES = 131072, LDSCTL_OFF = RING_BYTES, MISC_OFF = LDSCTL_OFF + 320, XCH_OFF = RING_BYTES + 4096  , LDS_BYTES = 147456;

__device__ __forceinline__ float wave_sum(float v) {
#pragma unroll
    for (int o = 1; o < 64; o <<= 1) v += __shfl_xor(v, o);
    return v;
}
__device__ __forceinline__ float wave_max(float v) {
#pragma unroll
    for (int o = 1; o < 64; o <<= 1) v = fmaxf(v, __shfl_xor(v, o));
    return v;
}
__device__ __forceinline__ unsigned cvtpk(float lo, float hi) { unsigned r; asm volatile("v_cvt_pk_bf16_f32 %0, %1, %2" : "=v"(r) : "v"(lo), "v"(hi)); return r; }
__device__ __forceinline__ float bflo(unsigned w) { return __builtin_bit_cast(float, w << 16); }
__device__ __forceinline__ float bfhi(unsigned w) { return __builtin_bit_cast(float, w & 0xffff0000u); }
__device__ __forceinline__ void unpack8(const v4u w, float (&f)[8]) { f[0] = bflo(w.x); f[1] = bfhi(w.x); f[2] = bflo(w.y); f[3] = bfhi(w.y); f[4] = bflo(w.z); f[5] = bfhi(w.z); f[6] = bflo(w.w); f[7] = bfhi(w.w); }
__device__ __forceinline__ v4u pack8f(const float (&f)[8]) { v4u w; w.x = cvtpk(f[0], f[1]); w.y = cvtpk(f[2], f[3]); w.z = cvtpk(f[4], f[5]); w.w = cvtpk(f[6], f[7]); return w; }
__device__ __forceinline__ void load8f(const float* p, float (&f)[8]) { const f32x4 a = *(const f32x4*)p, b = *(const f32x4*)(p + 4); f[0] = a[0]; f[1] = a[1]; f[2] = a[2]; f[3] = a[3]; f[4] = b[0]; f[5] = b[1]; f[6] = b[2]; f[7] = b[3]; }

__device__ __forceinline__ void p0_transpose_item(const float* W, int K, int N, bf16* WT, int drow0, LAS float* scr, int k0, int n0, int lane, const float* gain = nullptr) {
#pragma unroll 8
    for (int i = 0; i < 32; ++i) { const int kk = 2 * i + (lane >> 5); const float gk = gain ? gain[k0 + kk] : 1.0f; scr[kk * 33 + (lane & 31)] = W[(size_t)(k0 + kk) * N + n0 + (lane & 31)] * gk; }
    LDS_WAIT(); asm volatile("" ::: "memory");
    const int c = lane & 7;
#pragma unroll
    for (int j = 0; j < 4; ++j) { const int n = (lane >> 3) + 8 * j; const LAS float* s = scr + (8 * c) * 33 + n;
        v4u o; o.x = pk2(s[0 * 33], s[1 * 33]); o.y = pk2(s[2 * 33], s[3 * 33]); o.z = pk2(s[4 * 33], s[5 * 33]); o.w = pk2(s[6 * 33], s[7 * 33]);
        *(GAS v4u*)(WT + (size_t)(drow0 + n) * K + k0 + 8 * c) = o; }
    LDS_WAIT(); asm volatile("" ::: "memory");
}
__device__ __forceinline__ int map_in_row(int n0) {
    if (n0 < 1536) return n0;
    const int w = n0 - 1536, sec = w >> 8, within = w & 255, hl = within >> 6, dim = within & 63;
    return 1536 + 256 * sec + 128 * (dim >> 5) + 32 * hl + (dim & 31);
}
__device__ __forceinline__ void rms_row(const float* srow, const float* g, bf16* drow, int lane) {
    const GAS f32x4* xr = (const GAS f32x4*)srow + lane;
    f32x4 v[4]; float s = 0.f;
#pragma unroll
    for (int j = 0; j < 4; ++j) { v[j] = xr[64 * j]; s += (v[j].x * v[j].x + v[j].y * v[j].y) + (v[j].z * v[j].z + v[j].w * v[j].w); }
    const float rstd = __builtin_amdgcn_rsqf(wave_sum(s) * (1.f / DM) + EPS);
    GAS unsigned long long* o8 = (GAS unsigned long long*)drow + lane;
#pragma unroll
    for (int j = 0; j < 4; ++j) { const f32x4 gg = ((const GAS f32x4*)g)[lane + 64 * j];
        o8[64 * j] = (unsigned long long)cvtpk(v[j].x * rstd * gg.x, v[j].y * rstd * gg.y) | ((unsigned long long)cvtpk(v[j].z * rstd * gg.z, v[j].w * rstd * gg.w) << 32); }
}
__device__ __forceinline__ void rms_rows(const float* src, const float* g, bf16* dst, int gw, int NGW, int lane) {
    for (int m = gw; m < MROWS; m += NGW) rms_row(src + (size_t)m * DM, g, dst + (size_t)m * DM, lane);
}

namespace att {
typedef float f32x16 __attribute__((ext_vector_type(16)));
typedef short s16x4 __attribute__((ext_vector_type(4)));
typedef short v4i16_t __attribute__((ext_vector_type(4)));
__device__ __forceinline__ constexpr int cr(int r) { return (r & 3) + 8 * (r >> 2); }
__device__ __forceinline__ s16x4 vtr(LAS const unsigned char* p) { return __builtin_bit_cast(s16x4, __builtin_amdgcn_ds_read_tr16_b64_v4i16((LAS v4i16_t*)p)); }

__device__ __forceinline__ void attn_tile(LAS unsigned char* wl, const bf16* Qg, const bf16* Kg, const bf16* Vg, bf16* OPb, float* LPb,
                                          int b, int h, int d, int r, int l0, float cb, float negM, int lane) {
    const int r32 = lane & 31, hi = lane >> 5;
    const size_t hb = (size_t)(b * NHEAD + h) * SEQ * HD;
    const bf16* Qh = Qg + hb; const bf16* Kh = Kg + hb; const bf16* Vh = Vg + hb;
    const int pq = r + d * (l0 + r32);
    bf16x8 qf[4];
#pragma unroll
    for (int s = 0; s < 4; ++s) qf[s] = *(const GAS bf16x8*)(Qh + (size_t)pq * HD + 16 * s + 8 * hi);
    const int kb0 = l0 >= 128 ? 0 : ((128 - l0) >> 5);
    bf16x8 kfn[4]; v4u vrn[4];
#define ATT_LOADKV(kb) do { const int lb_ = l0 - 128 + 32 * (kb); const size_t pk_ = (size_t)(r + d * (lb_ + r32)); \
        _Pragma("unroll") for (int s = 0; s < 4; ++s) kfn[s] = *(const GAS bf16x8*)(Kh + pk_ * HD + 16 * s + 8 * hi); \
        _Pragma("unroll") for (int it = 0; it < 4; ++it) { const int idx_ = lane + 64 * it, key_ = idx_ >> 3, c_ = idx_ & 7; \
            vrn[it] = *(const GAS v4u*)(Vh + (size_t)(r + d * (lb_ + key_)) * HD + 8 * c_); } } while (0)
    ATT_LOADKV(kb0);
    f32x16 o0, o1;
#pragma unroll
    for (int i = 0; i < 16; ++i) { o0[i] = 0.f; o1[i] = 0.f; }
    float lsum = 0.f;
    const int i4 = r32 - 4 * hi;
    const int laneoff = ((lane >> 4) & 1) * 32 + (lane & 3) * 8 + (4 * hi + ((lane & 15) >> 2)) * 64;
    for (int kb = kb0; kb < 5; ++kb) {
        bf16x8 kf[4]; v4u vr[4];
#pragma unroll
        for (int s = 0; s < 4; ++s) { kf[s] = kfn[s]; vr[s] = vrn[s]; }
#pragma unroll
        for (int it = 0; it < 4; ++it) { const int idx = lane + 64 * it, key = idx >> 3, c = idx & 7;
            *(LAS v4u*)(wl + (c >> 2) * 2048 + (key >> 4) * 1024 + (key & 15) * 64 + (c & 3) * 16) = vr[it]; }
        if (kb + 1 < 5) ATT_LOADKV(kb + 1);
        const float lt = negM - cb * (float)(128 + r32 - 32 * kb - 4 * hi);
        f32x16 sacc;
#pragma unroll
        for (int i = 0; i < 16; ++i) sacc[i] = __builtin_fmaf(cb, (float)cr(i), lt);
#pragma unroll
        for (int s = 0; s < 4; ++s) sacc = __builtin_amdgcn_mfma_f32_32x32x16_bf16(kf[s], qf[s], sacc, 0, 0, 0);
        float p[16];
#pragma unroll
        for (int i = 0; i < 16; ++i) p[i] = __builtin_amdgcn_exp2f(sacc[i]);
        if (kb == 0) {
#pragma unroll
            for (int i = 0; i < 16; ++i) p[i] = (cr(i) >= i4) ? p[i] : 0.f;
        }
        if (kb == 4) {
#pragma unroll
            for (int i = 0; i < 16; ++i) p[i] = (cr(i) <= i4) ? p[i] : 0.f;
        }
        float ps = 0.f;
#pragma unroll
        for (int i = 0; i < 16; ++i) ps += p[i];
        lsum += ps;
        v4u pw0, pw1;
        pw0.x = cvtpk(p[0], p[1]); pw0.y = cvtpk(p[2], p[3]); pw0.z = cvtpk(p[4], p[5]); pw0.w = cvtpk(p[6], p[7]);
        pw1.x = cvtpk(p[8], p[9]); pw1.y = cvtpk(p[10], p[11]); pw1.z = cvtpk(p[12], p[13]); pw1.w = cvtpk(p[14], p[15]);
        const bf16x8 pa0 = __builtin_bit_cast(bf16x8, pw0), pa1 = __builtin_bit_cast(bf16x8, pw1);
        LAS const unsigned char* vb = wl + laneoff;
#pragma unroll
        for (int d0 = 0; d0 < 2; ++d0) {
            const s16x4 a_lo = vtr(vb + d0 * 2048), a_hi = vtr(vb + d0 * 2048 + 512), b_lo = vtr(vb + d0 * 2048 + 1024), b_hi = vtr(vb + d0 * 2048 + 1024 + 512);
            const bf16x8 v0 = (bf16x8){a_lo[0], a_lo[1], a_lo[2], a_lo[3], a_hi[0], a_hi[1], a_hi[2], a_hi[3]};
            const bf16x8 v1 = (bf16x8){b_lo[0], b_lo[1], b_lo[2], b_lo[3], b_hi[0], b_hi[1], b_hi[2], b_hi[3]};
            if (d0 == 0) { o0 = __builtin_amdgcn_mfma_f32_32x32x16_bf16(pa0, v0, o0, 0, 0, 0); o0 = __builtin_amdgcn_mfma_f32_32x32x16_bf16(pa1, v1, o0, 0, 0, 0); }
            else         { o1 = __builtin_amdgcn_mfma_f32_32x32x16_bf16(pa0, v0, o1, 0, 0, 0); o1 = __builtin_amdgcn_mfma_f32_32x32x16_bf16(pa1, v1, o1, 0, 0, 0); }
        }
    }
#undef ATT_LOADKV
    lsum += __shfl_xor(lsum, 32);
    if (hi == 0) LPb[(size_t)(b * SEQ + pq) * NHEAD + h] = lsum;
    LAS unsigned short* stg = (LAS unsigned short*)(wl + 4096);
#pragma unroll
    for (int i = 0; i < 16; ++i) { const int q = cr(i) + 4 * hi;
        stg[q * 64 + r32] = (unsigned short)(cvtpk(o0[i], o0[i]) & 0xffffu); stg[q * 64 + 32 + r32] = (unsigned short)(cvtpk(o1[i], o1[i]) & 0xffffu); }
    LDS_WAIT(); asm volatile("" ::: "memory");
#pragma unroll
    for (int it = 0; it < 4; ++it) { const int row = it * 8 + (lane >> 3), ch = lane & 7;
        const v4u v = *(LAS const v4u*)(stg + row * 64 + ch * 8);
        *(GAS v4u*)(OPb + (size_t)(b * SEQ + r + d * (l0 + row)) * ATTW + h * HD + ch * 8) = v; }
    LDS_WAIT(); asm volatile("" ::: "memory");
}
}

#ifndef DUP_MASK
#define DUP_MASK 0
#endif
struct Args { const float* in[20]; float* out; unsigned char* ws; };
enum { I_X = 0, I_P, I_GMIX, I_WIN, I_CONVW, I_CONVB, I_QG, I_KG, I_GOC, I_GOA, I_WOUT, I_GFFN, I_WGATE, I_WUP, I_FCW, I_FCB, I_WDOWN, I_GPLE, I_WPG, I_WPP };

#define PHASE_PTRS KARG_DECL unsigned char* const ws_ = ARG_WS(); float* const out = ARG_OUT(); (void)out; \
    bf16* const WIN = (bf16*)(ws_ + WS_WIN); bf16* const WOUT = (bf16*)(ws_ + WS_WOUT); bf16* const WGU = (bf16*)(ws_ + WS_WGU); bf16* const WDN = (bf16*)(ws_ + WS_WDN); bf16* const WPG = (bf16*)(ws_ + WS_WPG); bf16* const WPP = (bf16*)(ws_ + WS_WPP); \
    bf16* const HB = (bf16*)(ws_ + WS_H); bf16* const PB = (bf16*)(ws_ + WS_PB); bf16* const ZC = (bf16*)(ws_ + WS_ZC); bf16* const QB = (bf16*)(ws_ + WS_Q); bf16* const KB = (bf16*)(ws_ + WS_K); bf16* const VB = (bf16*)(ws_ + WS_V); \
    bf16* const OP = (bf16*)(ws_ + WS_OP); float* const LP = (float*)(ws_ + WS_LP); bf16* const YB = (bf16*)(ws_ + WS_Y); bf16* const UB = (bf16*)(ws_ + WS_U); float* const TOPG = (float*)(ws_ + WS_TOPG); float* const BOTG = (float*)(ws_ + WS_BOTG); float* const TOPU = (float*)(ws_ + WS_TOPU); (void)TOPG; (void)BOTG; (void)TOPU; bf16* const PP = (bf16*)(ws_ + WS_PP); float* const SSB = (float*)(ws_ + WS_SS); (void)SSB; bf16* const X2B = (bf16*)(ws_ + WS_X2); (void)X2B; \
    (void)WIN; (void)WOUT; (void)WGU; (void)WDN; (void)WPG; (void)WPP; (void)HB; (void)PB; (void)ZC; (void)QB; (void)KB; (void)VB; (void)OP; (void)LP; (void)YB; (void)UB; (void)PP;
#define CAS __attribute__((address_space(4)))
#define ARG_IN(i) (*(const float* const CAS*)(ka_ + 8 * (i)))
#define ARG_OUT() (*(float* const CAS*)(ka_ + 8 * 20))
#define ARG_WS() (*(unsigned char* const CAS*)(ka_ + 8 * 21))
#define KARG_DECL const CAS unsigned char* ka_ = (const CAS unsigned char*)__builtin_amdgcn_kernarg_segment_ptr(); asm volatile("" : "+s"(ka_));
__device__ __forceinline__ void phase0(LAS unsigned char* L, const int lane, const int wave, const int G, const int bx, const int vcu, const int gw, const int NGW) {
    { PHASE_PTRS
    {
        LAS float* scr = (LAS float*)(L + wave * 16384);
        constexpr int I_IN = 16 * 96, I_OUT = 16 * 32, I_GT = 16 * 88, I_DN = 44 * 32, I_PG = 16 * 32, I_PPJ = 4 * 32;
        constexpr int NITEMS = I_IN + I_OUT + 2 * I_GT + I_DN + I_PG + I_PPJ;
        for (int it = gw; it < NITEMS; it += NGW) {
            int r = it;
            if (r < I_IN) { const int kb = r / 96, n0 = 32 * (r % 96); p0_transpose_item(ARG_IN(I_WIN), DM, INCOLS, WIN, map_in_row(n0), scr, 64 * kb, n0, lane); continue; } r -= I_IN;
            if (r < I_OUT) { const int kb = r / 32, n0 = 32 * (r % 32); p0_transpose_item(ARG_IN(I_WOUT), DM, DM, WOUT, n0, scr, 64 * kb, n0, lane); continue; } r -= I_OUT;
            if (r < I_GT) { const int kb = r / 88, n0 = 32 * (r % 88); p0_transpose_item(ARG_IN(I_WGATE), DM, DFF, WGU, 256 * (n0 >> 7) + (n0 & 127), scr, 64 * kb, n0, lane, ARG_IN(I_GFFN)); continue; } r -= I_GT;
            if (r < I_GT) { const int kb = r / 88, n0 = 32 * (r % 88); p0_transpose_item(ARG_IN(I_WUP), DM, DFF, WGU, 256 * (n0 >> 7) + 128 + (n0 & 127), scr, 64 * kb, n0, lane, ARG_IN(I_GFFN)); continue; } r -= I_GT;
            if (r < I_DN) { const int kb = r / 32, n0 = 32 * (r % 32); p0_transpose_item(ARG_IN(I_WDOWN), DFF, DM, WDN, n0, scr, 64 * kb, n0, lane); continue; } r -= I_DN;
            if (r < I_PG) { const int kb = r / 32, n0 = 32 * (r % 32); p0_transpose_item(ARG_IN(I_WPG), DM, DM, WPG, n0, scr, 64 * kb, n0, lane, ARG_IN(I_GPLE)); continue; } r -= I_PG;
            { const int kb = r / 32, n0 = 32 * (r % 32); p0_transpose_item(ARG_IN(I_WPP), PLED, DM, WPP, n0, scr, 64 * kb, n0, lane); }
        }
        rms_rows(ARG_IN(I_X), ARG_IN(I_GMIX), HB, gw, NGW, lane);
        for (int m = gw; m < MROWS; m += NGW) {
            const f32x4 v = ((const GAS f32x4*)(ARG_IN(I_P) + (size_t)m * PLED))[lane];
            ((GAS unsigned long long*)(PB + (size_t)m * PLED))[lane] = (unsigned long long)cvtpk(v.x, v.y) | ((unsigned long long)cvtpk(v.z, v.w) << 32);
        }
    }
    }
}
__device__ __forceinline__ void phase1(LAS unsigned char* L, const int lane, const int wave, const int G, const int bx, const int vcu, const int gw, const int NGW) {
    { PHASE_PTRS
    {
        int kdim_ = DM; asm volatile("" : "+s"(kdim_)); pg8::Gemm g{HB, WIN, MROWS, INCOLS, kdim_}; pg8::StaticOrder S; S.init(MROWS, INCOLS, G, bx);
        pg8::EpiInProj E{ZC, QB, KB, VB, ARG_IN(I_QG), ARG_IN(I_KG), 0.125f * LOG2E, EPS};
        pg8::gemm_phase<pg8::EpiInProj, pg8::StaticOrder, true, true>(L, g, S, E);
    }
    }
}
__device__ __forceinline__ void phase2(LAS unsigned char* L, const int lane, const int wave, const int G, const int bx, const int vcu, const int gw, const int NGW) {
    { PHASE_PTRS
    {
        const float mq = wave_max(fabsf(ARG_IN(I_QG)[lane])), mk = wave_max(fabsf(ARG_IN(I_KG)[lane]));
        const float negM = -8.0f * mq * mk * LOG2E;
        LAS unsigned char* wl = L + wave * 8192;
        const int nper = 3072 / G;
        for (int i = 0; i < nper; ++i) {
            const int u = vcu * nper + i, bh = u / 96, u96 = u % 96, branch = u96 >> 5, within = u96 & 31;
            const int d = 1 << (2 * branch), nblk = 32 >> (2 * branch), r = within / nblk, blk = within % nblk;
            const int b = bh >> 3, h = bh & 7;
            const float cb = __builtin_amdgcn_exp2f(-(float)(h + 1)) * (float)d * LOG2E;
            att::attn_tile(wl, QB, KB, VB, OP + (size_t)branch * MROWS * ATTW, LP + (size_t)branch * MROWS * NHEAD, b, h, d, r, blk * 256 + wave * 32, cb, negM, lane);
        }
    }
    }
}
__device__ __forceinline__ void phase3(LAS unsigned char* L, const int lane, const int wave, const int G, const int bx, const int vcu, const int gw, const int NGW) {
    { PHASE_PTRS
    {
        const int c = 8 * lane;
        float cw0[8], cw1[8], cw2[8], cbv[8], gc[8], ga[8];
        load8f(ARG_IN(I_CONVW) + c, cw0); load8f(ARG_IN(I_CONVW) + CONVW + c, cw1); load8f(ARG_IN(I_CONVW) + 2 * CONVW + c, cw2);
        load8f(ARG_IN(I_CONVB) + c, cbv); load8f(ARG_IN(I_GOC) + c, gc); load8f(ARG_IN(I_GOA) + c, ga);
        for (int ch = gw; ch < MROWS / 16; ch += NGW) {
            const int m0 = ch * 16;
            float u1[8], u2[8];
            if ((m0 & (SEQ - 1)) == 0) {
#pragma unroll
                for (int j = 0; j < 8; ++j) { u1[j] = 0.f; u2[j] = 0.f; }
            } else {
                float a[8], bb[8];
                unpack8(*(const GAS v4u*)(ZC + (size_t)(m0 - 1) * 1536 + 512 + c), a); unpack8(*(const GAS v4u*)(ZC + (size_t)(m0 - 1) * 1536 + 1024 + c), bb);
#pragma unroll
                for (int j = 0; j < 8; ++j) u1[j] = a[j] * bb[j];
                unpack8(*(const GAS v4u*)(ZC + (size_t)(m0 - 2) * 1536 + 512 + c), a); unpack8(*(const GAS v4u*)(ZC + (size_t)(m0 - 2) * 1536 + 1024 + c), bb);
#pragma unroll
                for (int j = 0; j < 8; ++j) u2[j] = a[j] * bb[j];
            }
            for (int tt = 0; tt < 16; ++tt) {
                const size_t m = (size_t)(m0 + tt);
                float zb[8], zc[8], zx[8], y[8];
                unpack8(*(const GAS v4u*)(ZC + m * 1536 + c), zb); unpack8(*(const GAS v4u*)(ZC + m * 1536 + 512 + c), zc); unpack8(*(const GAS v4u*)(ZC + m * 1536 + 1024 + c), zx);
                float o1[8], o2[8], o3[8];
                unpack8(*(const GAS v4u*)(OP + m * ATTW + c), o1); unpack8(*(const GAS v4u*)(OP + ((size_t)MROWS + m) * ATTW + c), o2); unpack8(*(const GAS v4u*)(OP + ((size_t)2 * MROWS + m) * ATTW + c), o3);
                const float lt = LP[m * NHEAD + (lane >> 3)] + LP[((size_t)MROWS + m) * NHEAD + (lane >> 3)] + LP[((size_t)2 * MROWS + m) * NHEAD + (lane >> 3)];
                float ss = 0.f;
#pragma unroll
                for (int j = 0; j < 8; ++j) { const float u0 = zc[j] * zx[j]; y[j] = zb[j] * (cw0[j] * u2[j] + cw1[j] * u1[j] + cw2[j] * u0 + cbv[j]); ss += y[j] * y[j]; u2[j] = u1[j]; u1[j] = u0; }
                const float rc = __builtin_amdgcn_rsqf(wave_sum(ss) * (1.f / CONVW) + EPS);
#pragma unroll
                for (int j = 0; j < 8; ++j) y[j] = y[j] * rc * gc[j];
                *(GAS v4u*)(YB + m * DM + c) = pack8f(y);
                const float rl = 1.0f / lt; float sa = 0.f;
#pragma unroll
                for (int j = 0; j < 8; ++j) { y[j] = (o1[j] + o2[j] + o3[j]) * rl; sa += y[j] * y[j]; }
                const float ra = __builtin_amdgcn_rsqf(wave_sum(sa) * (1.f / ATTW) + EPS);
#pragma unroll
                for (int j = 0; j < 8; ++j) y[j] = y[j] * ra * ga[j];
                *(GAS v4u*)(YB + m * DM + CONVW + c) = pack8f(y);
            }
        }
    }
    }
}
__device__ __forceinline__ void phase4(LAS unsigned char* L, const int lane, const int wave, const int G, const int bx, const int vcu, const int gw, const int NGW) {
    { PHASE_PTRS
    {
        int kdim_ = DM; asm volatile("" : "+s"(kdim_)); pg8::Gemm g{YB, WOUT, MROWS, DM, kdim_}; pg8::StaticOrder S; S.init(MROWS, DM, G, bx);
        pg8::EpiResNorm<false> E{ARG_IN(I_X), HB, SSB, DM, (LAS float*)(L + XCH_OFF)};
        pg8::gemm_phase<pg8::EpiResNorm<false>, pg8::StaticOrder, true, true>(L, g, S, E);
    }
    }
}
__device__ __forceinline__ void phase6(LAS unsigned char* L, const int lane, const int wave, const int G, const int bx, const int vcu, const int gw, const int NGW) {
    { PHASE_PTRS
    {
        int kdim_ = DM; asm volatile("" : "+s"(kdim_)); pg8::Gemm g{HB, WGU, MROWS, 2 * DFF, kdim_}; pg8::StaticOrder S; S.init(MROWS, 2 * DFF, G, bx);
        pg8::EpiGUAct E{UB, DFF, SSB, EPS, ARG_IN(I_FCW), ARG_IN(I_FCB), TOPG, BOTG, TOPU, (LAS float*)(L + XCH_OFF)};
        pg8::gemm_phase<pg8::EpiGUAct, pg8::StaticOrder, true, true>(L, g, S, E);
    }
    }
}
__device__ __forceinline__ void phase7(LAS unsigned char* L, const int lane, const int wave, const int G, const int bx, const int vcu, const int gw, const int NGW) {
    { PHASE_PTRS
    {
        for (int it = gw; it < 128 * 6; it += NGW) {
            const int pm = it / 6, cg = it % 6, c = cg * 512 + 8 * lane;
            if ((pm & 31) != 0 && c < DFF) {
                float w0[8], w1[8], w2[8], bv[8], g0[8], g1[8], gm1[8], gm2[8], u0[8], u1[8], a0[8], a1[8];
                load8f(ARG_IN(I_FCW) + c, w0); load8f(ARG_IN(I_FCW) + DFF + c, w1); load8f(ARG_IN(I_FCW) + 2 * DFF + c, w2); load8f(ARG_IN(I_FCB) + c, bv);
                load8f(TOPG + (size_t)(pm * 2) * DFF + c, g0); load8f(TOPG + (size_t)(pm * 2 + 1) * DFF + c, g1);
                load8f(BOTG + (size_t)(pm * 2 - 2) * DFF + c, gm2); load8f(BOTG + (size_t)(pm * 2 - 1) * DFF + c, gm1);
                load8f(TOPU + (size_t)(pm * 2) * DFF + c, u0); load8f(TOPU + (size_t)(pm * 2 + 1) * DFF + c, u1);
#pragma unroll
                for (int j = 0; j < 8; ++j) {
                    const float p0 = w0[j] * gm2[j] + w1[j] * gm1[j] + w2[j] * g0[j] + bv[j], p1 = w0[j] * gm1[j] + w1[j] * g0[j] + w2[j] * g1[j] + bv[j];
                    a0[j] = p0 * __builtin_amdgcn_rcpf(1.0f + __builtin_amdgcn_exp2f(-LOG2E * p0)) * u0[j];
                    a1[j] = p1 * __builtin_amdgcn_rcpf(1.0f + __builtin_amdgcn_exp2f(-LOG2E * p1)) * u1[j];
                }
                *(GAS v4u*)(UB + (size_t)(pm * 256) * DFF + c) = pack8f(a0);
                *(GAS v4u*)(UB + (size_t)(pm * 256 + 1) * DFF + c) = pack8f(a1);
            }
        }
    }
    {
        int kdim_ = PLED; asm volatile("" : "+s"(kdim_)); pg8::Gemm g{PB, WPP, MROWS, DM, kdim_}; pg8::StaticOrder S; S.init(MROWS, DM, G, bx);
        pg8::EpiBf16 E{PP, DM};
        pg8::gemm_phase<pg8::EpiBf16, pg8::StaticOrder, true, true>(L, g, S, E);
    }
    }
}
__device__ __forceinline__ void phase8(LAS unsigned char* L, const int lane, const int wave, const int G, const int bx, const int vcu, const int gw, const int NGW) {
    { PHASE_PTRS
    {
        int kdim_ = DFF; asm volatile("" : "+s"(kdim_)); pg8::Gemm g{UB, WDN, MROWS, DM, kdim_}; pg8::StaticOrder S; S.init(MROWS, DM, G, bx);
        pg8::EpiResNorm<true> E{HB, X2B, SSB, DM, (LAS float*)(L + XCH_OFF)};
        pg8::gemm_phase<pg8::EpiResNorm<true>, pg8::StaticOrder, true, true>(L, g, S, E);
    }
    }
}
__device__ __forceinline__ void phase10(LAS unsigned char* L, const int lane, const int wave, const int G, const int bx, const int vcu, const int gw, const int NGW) {
    { PHASE_PTRS
    {
        int kdim_ = DM; asm volatile("" : "+s"(kdim_)); pg8::Gemm g{X2B, WPG, MROWS, DM, kdim_}; pg8::StaticOrder S; S.init(MROWS, DM, G, bx);
        pg8::EpiPle E{X2B, out, PP, DM, SSB, EPS};
        pg8::gemm_phase<pg8::EpiPle, pg8::StaticOrder, true, true>(L, g, S, E);
    }
    }
}
__global__ void __launch_bounds__(NWAVES * 64, 2) hybrid_fwd(Args args) {
    extern __shared__ __attribute__((aligned(16))) unsigned char lds[];
    LAS unsigned char* L = (LAS unsigned char*)lds;
    volatile LAS unsigned* MISC = (volatile LAS unsigned*)(L + MISC_OFF);
    const int tid = threadIdx.x, lane = tid & 63, wave = __builtin_amdgcn_readfirstlane(tid >> 6);
    const int G = gridDim.x; const int bx = blockIdx.x;
    const int vcu = (G % 8 == 0) ? (bx % 8) * (G / 8) + bx / 8 : bx;
    const int gw = vcu * NWAVES + wave, NGW = G * NWAVES;
    gu32* ctl; { KARG_DECL ctl = (gu32*)(ARG_WS() + WS_CTL); }
    for (int u = tid; u < (LDS_BYTES - LDSCTL_OFF) / 4; u += NWAVES * 64) ((LAS unsigned*)(L + LDSCTL_OFF))[u] = 0u;
    __syncthreads();
    XcdBarrier bar = xcd_barrier_post((unsigned*)(ctl + CW_BAR), MISC + 8);

#ifndef SKIP_P0
    phase0(L, lane, wave, G, bx, vcu, gw, NGW);
#endif
    xcd_barrier(bar);
#if (DUP_MASK >> 0) & 1
    phase0(L, lane, wave, G, bx, vcu, gw, NGW);
    xcd_barrier(bar);
#endif

#ifndef SKIP_P1
    phase1(L, lane, wave, G, bx, vcu, gw, NGW);
#endif
    xcd_barrier(bar);
#if (DUP_MASK >> 1) & 1
    phase1(L, lane, wave, G, bx, vcu, gw, NGW);
    xcd_barrier(bar);
#endif

#ifndef SKIP_P2
    phase2(L, lane, wave, G, bx, vcu, gw, NGW);
#endif
    xcd_barrier(bar);
#if (DUP_MASK >> 2) & 1
    phase2(L, lane, wave, G, bx, vcu, gw, NGW);
    xcd_barrier(bar);
#endif

#ifndef SKIP_P3
    phase3(L, lane, wave, G, bx, vcu, gw, NGW);
#endif
    xcd_barrier(bar);
#if (DUP_MASK >> 3) & 1
    phase3(L, lane, wave, G, bx, vcu, gw, NGW);
    xcd_barrier(bar);
#endif

#ifndef SKIP_P4
    phase4(L, lane, wave, G, bx, vcu, gw, NGW);
#endif
    xcd_barrier(bar);
#if (DUP_MASK >> 4) & 1
    phase4(L, lane, wave, G, bx, vcu, gw, NGW);
    xcd_barrier(bar);
#endif

#ifndef SKIP_P6
    phase6(L, lane, wave, G, bx, vcu, gw, NGW);
#endif
    xcd_barrier(bar);
#if (DUP_MASK >> 6) & 1
    phase6(L, lane, wave, G, bx, vcu, gw, NGW);
    xcd_barrier(bar);
#endif

#ifndef SKIP_P7
    phase7(L, lane, wave, G, bx, vcu, gw, NGW);
#endif
    xcd_barrier(bar);
#if (DUP_MASK >> 7) & 1
    phase7(L, lane, wave, G, bx, vcu, gw, NGW);
    xcd_barrier(bar);
#endif

#ifndef SKIP_P8
    phase8(L, lane, wave, G, bx, vcu, gw, NGW);
#endif
    xcd_barrier(bar);
#if (DUP_MASK >> 8) & 1
    phase8(L, lane, wave, G, bx, vcu, gw, NGW);
    xcd_barrier(bar);
#endif


#ifndef SKIP_P10
    phase10(L, lane, wave, G, bx, vcu, gw, NGW);
#endif
#if (DUP_MASK >> 10) & 1
    xcd_barrier(bar);
    phase10(L, lane, wave, G, bx, vcu, gw, NGW);
#endif
}

extern "C" void kernel_launch(void* const* d_in, const int* in_sizes, int n_in, void* d_out, int out_size, void* d_ws, size_t ws_size, hipStream_t stream) {
    static int grid = 0;
    if (grid == 0) {
        if (n_in != 20 || out_size != MROWS * DM || ws_size < WS_END) { fprintf(stderr, "kernel_launch: unexpected shapes (n_in %d, out %d, ws %zu); nothing launched\n", n_in, out_size, ws_size); grid = -1; return; }
        int dev = 0, cus = 0, per_cu = 0;
        if (hipGetDevice(&dev) != hipSuccess || hipDeviceGetAttribute(&cus, hipDeviceAttributeMultiprocessorCount, dev) != hipSuccess) { grid = -1; return; }
        if (hipFuncSetAttribute((const void*)hybrid_fwd, hipFuncAttributeMaxDynamicSharedMemorySize, LDS_BYTES) != hipSuccess) { fprintf(stderr, "kernel_launch: hipFuncSetAttribute failed\n"); grid = -1; return; }
        if (hipOccupancyMaxActiveBlocksPerMultiprocessor(&per_cu, (const void*)hybrid_fwd, NWAVES * 64, LDS_BYTES) != hipSuccess || per_cu < 1)
            fprintf(stderr, "kernel_launch: note: occupancy query reports %d workgroups per CU\n", per_cu);
        (void)hipGetLastError();
        grid = cus;
        if (grid != 256) fprintf(stderr, "kernel_launch: %d CUs (built for 256)\n", grid);
    }
    if (grid < 0) return;
    if (hipMemsetAsync((char*)d_ws + WS_CTL, 0, CTL_ZERO_BYTES, stream) != hipSuccess) { fprintf(stderr, "kernel_launch: hipMemsetAsync failed\n"); return; }
    Args a{};
    for (int i = 0; i < 20; ++i) a.in[i] = (const float*)d_in[i];
    a.out = (float*)d_out; a.ws = (unsigned char*)d_ws;
    hipLaunchKernelGGL(hybrid_fwd, dim3(grid), dim3(NWAVES * 64), LDS_BYTES, stream, a);
    const hipError_t le = hipPeekAtLastError();
    if (le != hipSuccess) fprintf(stderr, "kernel_launch: launch failed: %s\n", hipGetErrorName(le));
}
```

```cpp
#include <hip/hip_runtime.h>
#include <cstdio>
#include <cstdint>
namespace pg8 {
#define PG8_LAS __attribute__((address_space(3)))
typedef unsigned short bf16_t;
typedef short bf16x8 __attribute__((ext_vector_type(8)));
typedef float f32x4 __attribute__((ext_vector_type(4)));
typedef unsigned u32x4 __attribute__((ext_vector_type(4)));
constexpr int BM = 256, BK = 64, HALF = 128, HTB = HALF * BK * 2  , STAGE_BYTES = 8 * HTB, NXCD = 8, WGM = 8;

__host__ __device__ __forceinline__ int lds_byte(int r, int c) { const int st = (r >> 4) * 2 + (c >> 5), rr = r & 15, cc = c & 31, ob = rr * 64 + cc * 2; return st * 1024 + (ob ^ (((ob >> 9) & 1) << 5)); }
__host__ __device__ __forceinline__ void stage_rc(int b, int& R, int& C) { const int st = b / 1024, sb = b % 1024, swz = sb ^ (((sb >> 9) & 1) << 5); R = (st >> 1) * 16 + swz / 64; C = (st & 1) * 32 + (swz % 64) / 2; }
__host__ __device__ __forceinline__ int perm32(int rho) { const int n = rho >> 4, i = rho & 15; return 8 * (i >> 2) + 4 * n + (i & 3); }

struct Unit { int pm, pn; };
struct Gemm { const bf16_t* A; const bf16_t* Bt; int M, N, K; };

struct StaticOrder {
    int nM, nN, nwg, G, c;
    __host__ __device__ void init(int M, int N, int G_, int c_) { nM = M / BM; nN = N / BM; nwg = nM * nN; G = G_; c = c_; }
    __host__ __device__ bool next(int i, Unit& u) const {
        const long L = (long)i * G + c; if (L >= nwg) return false;
        int wgid = (int)L; { const int q = nwg / NXCD, r = nwg % NXCD, xcd = wgid % NXCD, off = wgid / NXCD; wgid = (xcd < r ? xcd * (q + 1) : r * (q + 1) + (xcd - r) * q) + off; }
        const int nig = WGM * nN, gid = wgid / nig, fm = gid * WGM, gsz = (nM - fm) < WGM ? (nM - fm) : WGM;
        u.pm = fm + ((wgid % nig) % gsz); u.pn = (wgid % nig) / gsz; return true;
    }
    __device__ __forceinline__ void a_ready(const Unit&) const {}
    __device__ __forceinline__ void done(const Unit&) const {}
};

__device__ __forceinline__ unsigned cvt_pk_bf16(float lo, float hi) { unsigned r; asm volatile("v_cvt_pk_bf16_f32 %0, %1, %2" : "=v"(r) : "v"(lo), "v"(hi)); return r; }
__device__ __forceinline__ u32x4 pack8(const f32x4& v0, const f32x4& v1) { u32x4 w; w.x = cvt_pk_bf16(v0[0], v0[1]); w.y = cvt_pk_bf16(v0[2], v0[3]); w.z = cvt_pk_bf16(v1[0], v1[1]); w.w = cvt_pk_bf16(v1[2], v1[3]); return w; }
__device__ __forceinline__ float bf2f(unsigned short h) { return __builtin_bit_cast(float, (unsigned)h << 16); }

struct EpiBf16 {
    static constexpr bool PERM = true, AFTER_DRAIN = false;
    bf16_t* O; int ldc;
    __device__ __forceinline__ void operator()(const f32x4 (&acc)[2][2][4][2], const Unit& u, int wr, int wc, int fr, int fq) const {
        const int row0 = u.pm * BM + wr * 64 + fr, col0 = u.pn * BM + wc * 32 + 8 * fq;
#pragma unroll
        for (int ai = 0; ai < 2; ++ai)
#pragma unroll
            for (int m = 0; m < 4; ++m) { bf16_t* rowp = O + (size_t)(row0 + ai * HALF + m * 16) * ldc + col0;
#pragma unroll
                for (int bj = 0; bj < 2; ++bj) *(u32x4*)(rowp + bj * HALF) = pack8(acc[ai][bj][m][0], acc[ai][bj][m][1]); }
    }
};
__device__ __forceinline__ float rstd4(const f32x4 a, float eps) { return __builtin_amdgcn_rsqf(((a[0] + a[1]) + (a[2] + a[3])) * (1.0f / 1024.0f) + eps); }
struct EpiGU {
    static constexpr bool PERM = true, AFTER_DRAIN = false;
    bf16_t* G; bf16_t* U; int ldc; const float* SS; float eps;
    __device__ __forceinline__ void operator()(const f32x4 (&acc)[2][2][4][2], const Unit& u, int wr, int wc, int fr, int fq) const {
        const int row0 = u.pm * BM + wr * 64 + fr, col0 = u.pn * HALF + wc * 32 + 8 * fq;
        f32x4 sp[2][4];
#pragma unroll
        for (int ai = 0; ai < 2; ++ai)
#pragma unroll
            for (int m = 0; m < 4; ++m) sp[ai][m] = *(const f32x4*)(SS + (size_t)(row0 + ai * HALF + m * 16) * 4);
#pragma unroll
        for (int ai = 0; ai < 2; ++ai)
#pragma unroll
            for (int m = 0; m < 4; ++m) { const int row = row0 + ai * HALF + m * 16; const float rs = rstd4(sp[ai][m], eps); const size_t off = (size_t)row * ldc + col0;
                *(u32x4*)(G + off) = pack8(acc[ai][0][m][0] * rs, acc[ai][0][m][1] * rs);
                *(u32x4*)(U + off) = pack8(acc[ai][1][m][0] * rs, acc[ai][1][m][1] * rs); }
    }
};
__device__ __forceinline__ float dpp_ror1(float v) { return __builtin_bit_cast(float, __builtin_amdgcn_mov_dpp(__builtin_bit_cast(int, v), 0x121, 0xf, 0xf, false)); }
__device__ __forceinline__ float dpp_ror2(float v) { return __builtin_bit_cast(float, __builtin_amdgcn_mov_dpp(__builtin_bit_cast(int, v), 0x122, 0xf, 0xf, false)); }
struct EpiGUAct {
    static constexpr bool PERM = true, AFTER_DRAIN = false;
    bf16_t* ACT; int ldc; const float* SS; float eps; const float* cw; const float* cbias; float* TOPG; float* BOTG; float* TOPU; PG8_LAS float* xch;
    __device__ __forceinline__ void operator()(const f32x4 (&acc_)[2][2][4][2], const Unit& u, int wr, int wc, int fr, int fq) const {
        f32x4 (&acc)[2][2][4][2] = const_cast<f32x4 (&)[2][2][4][2]>(acc_);
        const int row0 = u.pm * BM + wr * 64 + fr, colh = wc * 32 + 8 * fq, col0 = u.pn * HALF + colh;
        {
            f32x4 sp[2][4];
#pragma unroll
            for (int ai = 0; ai < 2; ++ai)
#pragma unroll
                for (int m = 0; m < 4; ++m) sp[ai][m] = *(const f32x4*)(SS + (size_t)(row0 + ai * HALF + m * 16) * 4);
#pragma unroll
            for (int ai = 0; ai < 2; ++ai)
#pragma unroll
                for (int m = 0; m < 4; ++m) { const float rs = rstd4(sp[ai][m], eps);
#pragma unroll
                    for (int bj = 0; bj < 2; ++bj)
#pragma unroll
                        for (int n = 0; n < 2; ++n) acc[ai][bj][m][n] = acc[ai][bj][m][n] * rs; }
        }
        if (fr >= 14) {
#pragma unroll
            for (int ai = 0; ai < 2; ++ai)
#pragma unroll
                for (int n = 0; n < 2; ++n) *(PG8_LAS f32x4*)(xch + (((wr * 2 + ai) * 2 + (fr - 14)) * 128 + colh + 4 * n)) = acc[ai][0][3][n];
            if (wr == 1) {
#pragma unroll
                for (int n = 0; n < 2; ++n) *(f32x4*)(BOTG + (size_t)(u.pm * 2 + fr - 14) * ldc + col0 + 4 * n) = acc[1][0][3][n];
            }
        }
        if (wr == 0 && fr < 2) {
#pragma unroll
            for (int n = 0; n < 2; ++n) { *(f32x4*)(TOPG + (size_t)(u.pm * 2 + fr) * ldc + col0 + 4 * n) = acc[0][0][0][n]; *(f32x4*)(TOPU + (size_t)(u.pm * 2 + fr) * ldc + col0 + 4 * n) = acc[0][1][0][n]; }
        }
        asm volatile("s_waitcnt lgkmcnt(0)" ::: "memory"); __builtin_amdgcn_s_barrier(); asm volatile("" ::: "memory");
        typedef unsigned u32x2v __attribute__((ext_vector_type(2)));
#pragma unroll
        for (int n = 0; n < 2; ++n) {
            const f32x4 w0 = *(const f32x4*)(cw + col0 + 4 * n), w1 = *(const f32x4*)(cw + ldc + col0 + 4 * n), w2 = *(const f32x4*)(cw + 2 * ldc + col0 + 4 * n), bb = *(const f32x4*)(cbias + col0 + 4 * n);
#pragma unroll
            for (int ai = 0; ai < 2; ++ai) {
                f32x4 r1p, r2p;
                if (wr == 0 && ai == 0) { r1p = (f32x4){0.f, 0.f, 0.f, 0.f}; r2p = (f32x4){0.f, 0.f, 0.f, 0.f}; }
                else {
                    const int pw = wr ^ 1, pai = (wr == 1) ? ai : ai - 1;
                    const PG8_LAS float* xb = xch + ((pw * 2 + pai) * 2) * 128 + colh + 4 * n;
                    const f32x4 e2 = *(const PG8_LAS f32x4*)(xb), e1 = *(const PG8_LAS f32x4*)(xb + 128); r1p = e1; r2p = (fr == 0) ? e2 : e1;
                }
#pragma unroll
                for (int m = 0; m < 4; ++m) {
                    const f32x4 g = acc[ai][0][m][n], uu = acc[ai][1][m][n];
                    f32x4 r1, r2, a4;
#pragma unroll
                    for (int j = 0; j < 4; ++j) { r1[j] = dpp_ror1(g[j]); r2[j] = dpp_ror2(g[j]); }
#pragma unroll
                    for (int j = 0; j < 4; ++j) {
                        const float p1 = (fr == 0) ? r1p[j] : r1[j], p2 = (fr < 2) ? r2p[j] : r2[j];
                        const float pre = w0[j] * p2 + w1[j] * p1 + w2[j] * g[j] + bb[j];
                        a4[j] = pre * __builtin_amdgcn_rcpf(1.0f + __builtin_amdgcn_exp2f(-1.4426950408889634f * pre)) * uu[j];
                    }
                    r1p = r1; r2p = r2;
                    u32x2v w; w.x = cvt_pk_bf16(a4[0], a4[1]); w.y = cvt_pk_bf16(a4[2], a4[3]);
                    *(u32x2v*)(ACT + (size_t)(row0 + ai * HALF + m * 16) * ldc + col0 + 4 * n) = w;
                    asm volatile("" ::: "memory");
                }
            }
        }
    }
};
struct EpiInProj {
    static constexpr bool PERM = true, AFTER_DRAIN = false;
    bf16_t* ZC; bf16_t* Q; bf16_t* Kk; bf16_t* V; const float* gq; const float* gk; float qscale; float eps;
    __device__ __forceinline__ void operator()(const f32x4 (&acc)[2][2][4][2], const Unit& u, int wr, int wc, int fr, int fq) const {
        if (u.pn < 6) {
            const int row0 = u.pm * BM + wr * 64 + fr, col0 = u.pn * BM + wc * 32 + 8 * fq;
#pragma unroll
            for (int ai = 0; ai < 2; ++ai)
#pragma unroll
                for (int m = 0; m < 4; ++m) { bf16_t* rowp = ZC + (size_t)(row0 + ai * HALF + m * 16) * 1536 + col0;
#pragma unroll
                    for (int bj = 0; bj < 2; ++bj) *(u32x4*)(rowp + bj * HALF) = pack8(acc[ai][bj][m][0], acc[ai][bj][m][1]); }
        } else {
            const int sec = u.pn - 6, which = sec >> 1, head = 4 * (sec & 1) + wc;
            if (which < 2) {
                bf16_t* base = which == 0 ? Q : Kk;
                const float* g = which == 0 ? gq : gk;
                const float sc = which == 0 ? qscale : 1.f;
                const f32x4 g00 = *(const f32x4*)(g + 8 * fq), g01 = *(const f32x4*)(g + 8 * fq + 4), g10 = *(const f32x4*)(g + 32 + 8 * fq), g11 = *(const f32x4*)(g + 32 + 8 * fq + 4);
#pragma unroll
                for (int ai = 0; ai < 2; ++ai)
#pragma unroll
                    for (int m = 0; m < 4; ++m) {
                        const int row = u.pm * BM + ai * HALF + wr * 64 + m * 16 + fr, b = row >> 13, t = row & 8191;
                        float ss = 0.f;
#pragma unroll
                        for (int bj = 0; bj < 2; ++bj)
#pragma unroll
                            for (int n = 0; n < 2; ++n) { const f32x4 x = acc[ai][bj][m][n]; ss += (x[0] * x[0] + x[1] * x[1]) + (x[2] * x[2] + x[3] * x[3]); }
                        ss += __shfl_xor(ss, 16); ss += __shfl_xor(ss, 32);
                        const float rs = sc * __builtin_amdgcn_rsqf(ss * (1.0f / 64.0f) + eps);
                        bf16_t* dst = base + ((size_t)((b * 8 + head) * 8192 + t)) * 64 + 8 * fq;
                        *(u32x4*)(dst) = pack8(acc[ai][0][m][0] * rs * g00, acc[ai][0][m][1] * rs * g01);
                        *(u32x4*)(dst + 32) = pack8(acc[ai][1][m][0] * rs * g10, acc[ai][1][m][1] * rs * g11);
                    }
            } else {
#pragma unroll
                for (int ai = 0; ai < 2; ++ai)
#pragma unroll
                    for (int m = 0; m < 4; ++m) {
                        const int row = u.pm * BM + ai * HALF + wr * 64 + m * 16 + fr, b = row >> 13, t = row & 8191;
                        bf16_t* dst = V + ((size_t)((b * 8 + head) * 8192 + t)) * 64 + 8 * fq;
                        *(u32x4*)(dst) = pack8(acc[ai][0][m][0], acc[ai][0][m][1]);
                        *(u32x4*)(dst + 32) = pack8(acc[ai][1][m][0], acc[ai][1][m][1]);
                    }
            }
        }
    }
};
template <bool BASE_BF16> struct EpiResNorm {
    static constexpr bool PERM = true, AFTER_DRAIN = false;
    const void* base; bf16_t* XB; float* SS; int ldc; PG8_LAS float* red;
    __device__ __forceinline__ void operator()(const f32x4 (&acc)[2][2][4][2], const Unit& u, int wr, int wc, int fr, int fq) const {
        const int row0 = u.pm * BM + wr * 64 + fr, col0 = u.pn * BM + wc * 32 + 8 * fq;
#pragma unroll
        for (int ai = 0; ai < 2; ++ai)
#pragma unroll
            for (int m = 0; m < 4; ++m) { const int row = row0 + ai * HALF + m * 16; const size_t off = (size_t)row * ldc + col0; float ss = 0.f;
#pragma unroll
                for (int bj = 0; bj < 2; ++bj) {
                    f32x4 b0, b1;
                    if constexpr (BASE_BF16) { const u32x4 w = *(const u32x4*)((const bf16_t*)base + off + bj * HALF);
                        b0[0] = __builtin_bit_cast(float, w.x << 16); b0[1] = __builtin_bit_cast(float, w.x & 0xffff0000u); b0[2] = __builtin_bit_cast(float, w.y << 16); b0[3] = __builtin_bit_cast(float, w.y & 0xffff0000u);
                        b1[0] = __builtin_bit_cast(float, w.z << 16); b1[1] = __builtin_bit_cast(float, w.z & 0xffff0000u); b1[2] = __builtin_bit_cast(float, w.w << 16); b1[3] = __builtin_bit_cast(float, w.w & 0xffff0000u); }
                    else { b0 = *(const f32x4*)((const float*)base + off + bj * HALF); b1 = *(const f32x4*)((const float*)base + off + bj * HALF + 4); }
                    const f32x4 x0 = b0 + acc[ai][bj][m][0], x1 = b1 + acc[ai][bj][m][1];
                    *(u32x4*)(XB + off + bj * HALF) = pack8(x0, x1);
                    ss += ((x0[0] * x0[0] + x0[1] * x0[1]) + (x0[2] * x0[2] + x0[3] * x0[3])) + ((x1[0] * x1[0] + x1[1] * x1[1]) + (x1[2] * x1[2] + x1[3] * x1[3]));
                }
                ss += __shfl_xor(ss, 16); ss += __shfl_xor(ss, 32);
                if (fq == 0) red[(ai * HALF + wr * 64 + m * 16 + fr) * 4 + wc] = ss; }
        asm volatile("s_waitcnt lgkmcnt(0)" ::: "memory"); __builtin_amdgcn_s_barrier(); asm volatile("" ::: "memory");
        { const int t = threadIdx.x; if (t < 256) { const f32x4 v = *(const PG8_LAS f32x4*)(red + t * 4); SS[(size_t)(u.pm * BM + t) * 4 + u.pn] = (v[0] + v[1]) + (v[2] + v[3]); } }
        asm volatile("s_waitcnt lgkmcnt(0)" ::: "memory"); __builtin_amdgcn_s_barrier(); asm volatile("" ::: "memory");
    }
};
struct EpiPle {
    static constexpr bool PERM = true, AFTER_DRAIN = false;
    const bf16_t* xb; float* out; const bf16_t* pp; int ldc; const float* SS; float eps;
    __device__ __forceinline__ void operator()(const f32x4 (&acc)[2][2][4][2], const Unit& u, int wr, int wc, int fr, int fq) const {
        const int row0 = u.pm * BM + wr * 64 + fr, col0 = u.pn * BM + wc * 32 + 8 * fq;
        f32x4 sp[2][4];
#pragma unroll
        for (int ai = 0; ai < 2; ++ai)
#pragma unroll
            for (int m = 0; m < 4; ++m) sp[ai][m] = *(const f32x4*)(SS + (size_t)(row0 + ai * HALF + m * 16) * 4);
#pragma unroll
        for (int ai = 0; ai < 2; ++ai)
#pragma unroll
            for (int m = 0; m < 4; ++m) { const size_t off = (size_t)(row0 + ai * HALF + m * 16) * ldc + col0; const float rs = -1.4426950408889634f * rstd4(sp[ai][m], eps);
#pragma unroll
                for (int bj = 0; bj < 2; ++bj) { const size_t o2 = off + bj * HALF; const u32x4 bw = *(const u32x4*)(xb + o2), pw = *(const u32x4*)(pp + o2);
                    const unsigned bws[4] = {bw.x, bw.y, bw.z, bw.w}, pws[4] = {pw.x, pw.y, pw.z, pw.w};
                    f32x4 o[2];
#pragma unroll
                    for (int n = 0; n < 2; ++n)
#pragma unroll
                        for (int e = 0; e < 4; ++e) { const unsigned bb = bws[2 * n + (e >> 1)], pq = pws[2 * n + (e >> 1)];
                            const float bv = (e & 1) ? __builtin_bit_cast(float, bb & 0xffff0000u) : __builtin_bit_cast(float, bb << 16), pv = (e & 1) ? __builtin_bit_cast(float, pq & 0xffff0000u) : __builtin_bit_cast(float, pq << 16);
                            const float sg = __builtin_amdgcn_rcpf(1.0f + __builtin_amdgcn_exp2f(rs * acc[ai][bj][m][n][e])); o[n][e] = bv + sg * pv; }
                    *(f32x4*)(out + o2) = o[0]; *(f32x4*)(out + o2 + 4) = o[1]; } }
    }
};

template <class Epi, class Sched, bool ALIGN_EPI = false, bool SP2 = false>
__device__ __forceinline__ void gemm_phase(PG8_LAS unsigned char* lds, const Gemm g, const Sched& S, const Epi& E) {
    const int tid = threadIdx.x, wid = __builtin_amdgcn_readfirstlane(tid >> 6), lane = tid & 63, wr = wid >> 2, wc = wid & 3, fr = lane & 15, fq = lane >> 4;
    const int K = g.K, nt = K / BK;
    unsigned voffA[2], voffB[2];
#pragma unroll
    for (int i = 0; i < 2; ++i) { int R, C; stage_rc(tid * 16 + i * 8192, R, C); const int Rb = Epi::PERM ? ((R & ~31) + perm32(R & 31)) : R;
        voffA[i] = (unsigned)(R * K + C) * 2u; voffB[i] = (unsigned)(Rb * K + C) * 2u; }
    const size_t kstep = (size_t)(BK * 2);
    const size_t hstep = (size_t)HALF * K * 2;
    const size_t tstep = 2 * hstep;
    const unsigned ldsw = (unsigned)wid * 1024u;
    const int aoff = lds_byte(wr * 64 + fr, fq * 8), boff = lds_byte(wc * 32 + fr, fq * 8);
#define PG8_SA(b, h) (((b) * 2 + (h)) * HTB)
#define PG8_SB(b, h) ((4 + (b) * 2 + (h)) * HTB)
#define PG8_STAGE(bufoff, gbase, voff) do { _Pragma("unroll") for (int _i = 0; _i < 2; ++_i) \
        __builtin_amdgcn_global_load_lds((const unsigned*)((const char*)(gbase) + (voff)[_i]), (PG8_LAS unsigned*)(lds + (bufoff) + ldsw + _i * 8192), 16, 0, 0); } while (0)
#define PG8_LDA(dst, b, h) do { _Pragma("unroll") for (int m = 0; m < 4; ++m) _Pragma("unroll") for (int k = 0; k < 2; ++k) dst[m][k] = *(const PG8_LAS bf16x8*)(lds + PG8_SA(b, h) + aoff + m * 2048 + k * 1024); } while (0)
#define PG8_LDB(dst, b, h) do { _Pragma("unroll") for (int n = 0; n < 2; ++n) _Pragma("unroll") for (int k = 0; k < 2; ++k) dst[n][k] = *(const PG8_LAS bf16x8*)(lds + PG8_SB(b, h) + boff + n * 2048 + k * 1024); } while (0)
#define PG8_MMA(ai, bj, At, Bt) do { __builtin_amdgcn_s_setprio(1); _Pragma("unroll") for (int m = 0; m < 4; ++m) _Pragma("unroll") for (int n = 0; n < 2; ++n) _Pragma("unroll") for (int k = 0; k < 2; ++k) \
        acc[ai][bj][m][n] = __builtin_amdgcn_mfma_f32_16x16x32_bf16(Bt[n][k], At[m][k], acc[ai][bj][m][n], 0, 0, 0); __builtin_amdgcn_s_setprio(0); } while (0)
#define PG8_WAIT_V(n) asm volatile("s_waitcnt vmcnt(" #n ")" ::: "memory")
#define PG8_WAIT_L(n) asm volatile("s_waitcnt lgkmcnt(" #n ")" ::: "memory")
#define PG8_BAR __builtin_amdgcn_s_barrier()
#define PG8_SCHED __builtin_amdgcn_sched_barrier(0)
    Unit cur, nxt; int ui = 0;
    if (!S.next(0, cur)) return;
    f32x4 acc[2][2][4][2];
#pragma unroll
    for (int a = 0; a < 2; ++a)
#pragma unroll
        for (int b = 0; b < 2; ++b)
#pragma unroll
            for (int m = 0; m < 4; ++m)
#pragma unroll
                for (int n = 0; n < 2; ++n) acc[a][b][m][n] = (f32x4){0.f, 0.f, 0.f, 0.f};
    bf16x8 At[4][2], B0[2][2], B1[2][2];
    const char* cA = (const char*)g.A + (size_t)cur.pm * tstep; const char* cB = (const char*)g.Bt + (size_t)cur.pn * tstep;
    S.a_ready(cur);
    if constexpr (SP2) {
        PG8_STAGE(PG8_SB(0, 0), cB, voffB); PG8_STAGE(PG8_SB(0, 1), cB + hstep, voffB); PG8_STAGE(PG8_SA(0, 0), cA, voffA); PG8_STAGE(PG8_SA(0, 1), cA + hstep, voffA);
        if (wr == 1) PG8_BAR;
        PG8_WAIT_V(2); PG8_BAR;
        PG8_STAGE(PG8_SB(1, 0), cB + kstep, voffB); PG8_STAGE(PG8_SA(1, 0), cA + kstep, voffA); PG8_STAGE(PG8_SB(1, 1), cB + hstep + kstep, voffB);
        PG8_WAIT_V(6); PG8_BAR;
    } else {
        PG8_STAGE(PG8_SB(0, 0), cB, voffB); PG8_STAGE(PG8_SA(0, 0), cA, voffA); PG8_STAGE(PG8_SB(0, 1), cB + hstep, voffB); PG8_STAGE(PG8_SA(0, 1), cA + hstep, voffA);
        if (wr == 1) PG8_BAR;
        PG8_WAIT_V(4); PG8_BAR;
        PG8_STAGE(PG8_SB(1, 0), cB + kstep, voffB); PG8_STAGE(PG8_SA(1, 0), cA + kstep, voffA); PG8_STAGE(PG8_SB(1, 1), cB + hstep + kstep, voffB);
        PG8_WAIT_V(6); PG8_BAR;
    }
    for (;;) {
        const bool has_next = S.next(ui + 1, nxt);
        const char* nA = has_next ? (const char*)g.A + (size_t)nxt.pm * tstep : cA; const char* nB = has_next ? (const char*)g.Bt + (size_t)nxt.pn * tstep : cB;
        for (int t = 0; t < nt; t += 2) {
            const bool last = (t == nt - 2);
            const char* a1 = cA + (size_t)(t + 1) * kstep;
            const char* a2 = last ? nA : cA + (size_t)(t + 2) * kstep; const char* b2 = last ? nB : cB + (size_t)(t + 2) * kstep;
            const char* a3 = a2 + kstep; const char* b3 = b2 + kstep;
            if (last && has_next) S.a_ready(nxt);
            if constexpr (SP2) {
            PG8_LDB(B0, 0, 0); PG8_LDB(B1, 0, 1); PG8_SCHED; PG8_LDA(At, 0, 0); PG8_STAGE(PG8_SA(1, 1), a1 + hstep, voffA);
            PG8_WAIT_V(8); PG8_WAIT_L(0); PG8_BAR; PG8_MMA(0, 0, At, B0); PG8_MMA(0, 1, At, B1); PG8_BAR; PG8_SCHED;
            PG8_LDA(At, 0, 1); PG8_STAGE(PG8_SB(0, 0), b2, voffB); PG8_STAGE(PG8_SB(0, 1), b2 + hstep, voffB); PG8_STAGE(PG8_SA(0, 0), a2, voffA);
            PG8_WAIT_V(8); PG8_WAIT_L(0); PG8_BAR; PG8_MMA(1, 0, At, B0); PG8_MMA(1, 1, At, B1); PG8_BAR; PG8_SCHED;
            PG8_LDB(B0, 1, 0); PG8_LDB(B1, 1, 1); PG8_SCHED; PG8_LDA(At, 1, 0); PG8_STAGE(PG8_SA(0, 1), a2 + hstep, voffA);
            PG8_WAIT_V(8); PG8_WAIT_L(0); PG8_BAR; PG8_MMA(0, 0, At, B0); PG8_MMA(0, 1, At, B1); PG8_BAR; PG8_SCHED;
            PG8_LDA(At, 1, 1); PG8_STAGE(PG8_SB(1, 0), b3, voffB); PG8_STAGE(PG8_SB(1, 1), b3 + hstep, voffB); PG8_STAGE(PG8_SA(1, 0), a3, voffA);
            PG8_WAIT_V(8); PG8_WAIT_L(0); PG8_BAR; PG8_MMA(1, 0, At, B0); PG8_MMA(1, 1, At, B1); PG8_BAR; PG8_SCHED;
            } else {
            PG8_LDB(B0, 0, 0); PG8_SCHED; PG8_LDA(At, 0, 0); PG8_STAGE(PG8_SA(1, 1), a1 + hstep, voffA);
            PG8_WAIT_L(8); PG8_BAR; PG8_WAIT_L(0); PG8_MMA(0, 0, At, B0); PG8_BAR; PG8_SCHED;
            PG8_LDB(B1, 0, 1); PG8_STAGE(PG8_SB(0, 0), b2, voffB);
            PG8_BAR; PG8_WAIT_L(0); PG8_MMA(0, 1, At, B1); PG8_BAR;
            PG8_LDA(At, 0, 1); PG8_STAGE(PG8_SA(0, 0), a2, voffA);
            PG8_BAR; PG8_WAIT_L(0); PG8_MMA(1, 0, At, B0); PG8_BAR; PG8_SCHED;
            PG8_STAGE(PG8_SB(0, 1), b2 + hstep, voffB);
            PG8_WAIT_V(6); PG8_BAR; PG8_MMA(1, 1, At, B1); PG8_BAR;
            PG8_LDB(B0, 1, 0); PG8_SCHED; PG8_LDA(At, 1, 0); PG8_STAGE(PG8_SA(0, 1), a2 + hstep, voffA);
            PG8_WAIT_L(8); PG8_BAR; PG8_WAIT_L(0); PG8_MMA(0, 0, At, B0); PG8_BAR; PG8_SCHED;
            PG8_LDB(B1, 1, 1); PG8_STAGE(PG8_SB(1, 0), b3, voffB);
            PG8_BAR; PG8_WAIT_L(0); PG8_MMA(0, 1, At, B1); PG8_BAR;
            PG8_LDA(At, 1, 1); PG8_STAGE(PG8_SA(1, 0), a3, voffA);
            PG8_BAR; PG8_WAIT_L(0); PG8_MMA(1, 0, At, B0); PG8_BAR; PG8_SCHED;
            PG8_STAGE(PG8_SB(1, 1), b3 + hstep, voffB);
            PG8_WAIT_V(6); PG8_BAR; PG8_MMA(1, 1, At, B1); PG8_BAR;
            }
        }
        if constexpr (ALIGN_EPI) { if (wr == 0) PG8_BAR; }
        if constexpr (!Epi::AFTER_DRAIN) { E(acc, cur, wr, wc, fr, fq); S.done(cur); }
        if (!has_next) break;
#pragma unroll
        for (int a = 0; a < 2; ++a)
#pragma unroll
            for (int b = 0; b < 2; ++b)
#pragma unroll
                for (int m = 0; m < 4; ++m)
#pragma unroll
                    for (int n = 0; n < 2; ++n) acc[a][b][m][n] = (f32x4){0.f, 0.f, 0.f, 0.f};
        cur = nxt; cA = nA; cB = nB; ++ui;
        if constexpr (ALIGN_EPI) { if (wr == 1) PG8_BAR; }
    }
    PG8_WAIT_V(0);
    if constexpr (!ALIGN_EPI) { if (wr == 0) PG8_BAR; }
    PG8_BAR;
    if constexpr (Epi::AFTER_DRAIN) { E.fused(acc, cur, wr, wc, fr, fq, lds, wid, lane); S.done(cur); }
#undef PG8_SA
#undef PG8_SB
#undef PG8_STAGE
#undef PG8_LDA
#undef PG8_LDB
#undef PG8_MMA
#undef PG8_WAIT_V
#undef PG8_WAIT_L
#undef PG8_BAR
#undef PG8_SCHED
}
}
#define GAS __attribute__((address_space(1)))
#define LAS __attribute__((address_space(3)))
typedef unsigned short bf16;
typedef unsigned v4u __attribute__((ext_vector_type(4)));
typedef float f32x4 __attribute__((ext_vector_type(4)));
typedef short bf16x8 __attribute__((ext_vector_type(8)));
typedef GAS unsigned gu32;
typedef GAS unsigned long long gu64;
#define RLX_AGENT __ATOMIC_RELAXED, __HIP_MEMORY_SCOPE_AGENT
#define LDS_WAIT() asm volatile("s_waitcnt lgkmcnt(0)" ::: "memory")
#define VM_WAIT() asm volatile("s_waitcnt vmcnt(0)" ::: "memory")
__device__ __forceinline__ unsigned long long rt() { return __builtin_amdgcn_s_memrealtime(); }
__device__ __forceinline__ unsigned f2bf(float f) { unsigned u = __builtin_bit_cast(unsigned, f); return (u + 0x7fffu + ((u >> 16) & 1u)) >> 16; }
__device__ __forceinline__ unsigned pk2(float lo, float hi) { return f2bf(lo) | (f2bf(hi) << 16); }

#define XB_TMO      128
#define XB_XCNT(j)  (256  + 64 * (j))
#define XB_XSUB(j)  (1280 + 64 * (j))
#define XB_XGEN(j)  (2304 + 64 * (j))
#define XB_TOP      3328
#define XB_TOPGEN   3392
#define XCD_BAR_WORDS 3456
#define XB_SPIN_CAP (1u << 18)

__device__ __forceinline__ unsigned xb_ld(unsigned* p)              { return __hip_atomic_load(p, __ATOMIC_RELAXED, __HIP_MEMORY_SCOPE_AGENT); }
__device__ __forceinline__ unsigned xb_add(unsigned* p, unsigned v) { return __hip_atomic_fetch_add(p, v, __ATOMIC_RELAXED, __HIP_MEMORY_SCOPE_AGENT); }
__device__ __forceinline__ unsigned xb_xcc_id() { return (unsigned)__builtin_amdgcn_s_getreg((3 << 11) | 20) & 0xFu; }
#define XB_SPIN(cond, bar) do { unsigned _sp = 0; while (cond) { __builtin_amdgcn_s_sleep(1); \
    if ((++_sp & 255u) == 0u) { if (xb_ld(&(bar)[XB_TMO])) break; if (_sp > XB_SPIN_CAP) { atomicAdd(&(bar)[XB_TMO], 1u); break; } } } } while (0)

struct XcdBarrier {
    unsigned* bar; unsigned x;
    volatile LAS unsigned* st;
};

__device__ __forceinline__ XcdBarrier xcd_barrier_post(unsigned* bar, volatile LAS unsigned* st) {
    XcdBarrier b; b.bar = bar; b.x = xb_xcc_id(); b.st = st;
    if (threadIdx.x == 0) (void)xb_add(&bar[XB_XCNT(b.x)], 1u);
    return b;
}
__device__ __forceinline__ void xcd_barrier_complete(unsigned* bar, unsigned x, unsigned& nloc, unsigned& nx) {
    const unsigned G = gridDim.x * gridDim.y * gridDim.z;
    unsigned sum, cnt, mine, sp = 0u;
    for (;;) {
        sum = 0u; cnt = 0u; mine = 0u;
#pragma unroll
        for (unsigned j = 0; j < 16; ++j) { const unsigned c = xb_ld(&bar[XB_XCNT(j)]); sum += c; cnt += (c > 0u) ? 1u : 0u; mine = (j == x) ? c : mine; }
        if (sum == G) break;
        __builtin_amdgcn_s_sleep(1);
        if ((++sp & 255u) == 0u) { if (xb_ld(&bar[XB_TMO])) break; if (sp > XB_SPIN_CAP) { atomicAdd(&bar[XB_TMO], 1u); break; } }
    }
    nloc = mine > 0u ? mine : 1u; nx = cnt > 0u ? cnt : 1u;
}

__device__ __forceinline__ void xcd_barrier(const XcdBarrier& b) {
    asm volatile("s_waitcnt vmcnt(0)" ::: "memory");
    __syncthreads();
    if (threadIdx.x == 0) {
        unsigned* bar = b.bar;
        __builtin_amdgcn_s_waitcnt(0);
        unsigned nloc = b.st[0], nx = b.st[1];
        if (nloc == 0u) { xcd_barrier_complete(bar, b.x, nloc, nx); b.st[0] = nloc; b.st[1] = nx; }
        const unsigned old = xb_add(&bar[XB_XSUB(b.x)], 1u);
        const unsigned gen = old / nloc;
        if (old + 1u == (gen + 1u) * nloc) {
            __builtin_amdgcn_fence(__ATOMIC_RELEASE, "agent");
            asm volatile("s_waitcnt vmcnt(0)" ::: "memory");
            const unsigned og = xb_add(&bar[XB_TOP], 1u);
            const unsigned tg = og / nx;
            if (og + 1u == (tg + 1u) * nx) xb_add(&bar[XB_TOPGEN], 1u);
            else XB_SPIN(xb_ld(&bar[XB_TOPGEN]) == tg, bar);
            __builtin_amdgcn_fence(__ATOMIC_ACQUIRE, "agent");
            xb_add(&bar[XB_XGEN(b.x)], 1u);
            asm volatile("s_waitcnt vmcnt(0)" ::: "memory");
        } else {
            XB_SPIN(xb_ld(&bar[XB_XGEN(b.x)]) == gen, bar);
            __builtin_amdgcn_fence(__ATOMIC_ACQUIRE, "agent");
            asm volatile("s_waitcnt vmcnt(0)" ::: "memory");
        }
    }
    __syncthreads();
}

constexpr int NWAVES = 8;
constexpr int BATCH = 4, SEQ = 8192, DM = 1024, MROWS = BATCH * SEQ, CONVW = 512, NHEAD = 8, HD = 64, ATTW = 512, INCOLS = 3072, DFF = 2816, PLED = 256;
constexpr float EPS = 1e-6f;
constexpr float LOG2E = 1.4426950408889634f;
constexpr size_t MiB = 1u << 20;
constexpr size_t WS_CTL = 0, CTL_ZERO_BYTES = 1 * MiB;
constexpr size_t WS_WIN = 2 * MiB, WS_WOUT = 8 * MiB, WS_WGU = 10 * MiB, WS_WDN = 21 * MiB, WS_WPG = 27 * MiB, WS_WPP = 29 * MiB;
constexpr size_t WS_H = 32 * MiB;
constexpr size_t WS_PB = 96 * MiB;
constexpr size_t WS_ZC = 112 * MiB;
constexpr size_t WS_Q = 208 * MiB, WS_K = 240 * MiB, WS_V = 272 * MiB;
constexpr size_t WS_OP = 304 * MiB;
constexpr size_t WS_LP = 400 * MiB;
constexpr size_t WS_Y = 404 * MiB;
constexpr size_t WS_U = 112 * MiB;
constexpr size_t WS_TOPG = 288 * MiB, WS_BOTG = 291 * MiB, WS_TOPU = 294 * MiB;
constexpr size_t WS_PP = 300 * MiB;
constexpr size_t WS_SS = 30 * MiB;
constexpr size_t WS_X2 = 364 * MiB;
constexpr size_t WS_END = 468 * MiB;
constexpr int CW_BAR = 4096;
constexpr int RING_BYTES = 131072, LDSCTL_OFF = RING_BYTES, MISC_OFF = LDSCTL_OFF + 320, XCH_OFF = RING_BYTES + 4096  , LDS_BYTES = 147456;

__device__ __forceinline__ float wave_sum(float v) {
#pragma unroll
    for (int o = 1; o < 64; o <<= 1) v += __shfl_xor(v, o);
    return v;
}
__device__ __forceinline__ float wave_max(float v) {
#pragma unroll
    for (int o = 1; o < 64; o <<= 1) v = fmaxf(v, __shfl_xor(v, o));
    return v;
}
__device__ __forceinline__ unsigned cvtpk(float lo, float hi) { unsigned r; asm volatile("v_cvt_pk_bf16_f32 %0, %1, %2" : "=v"(r) : "v"(lo), "v"(hi)); return r; }
__device__ __forceinline__ float bflo(unsigned w) { return __builtin_bit_cast(float, w << 16); }
__device__ __forceinline__ float bfhi(unsigned w) { return __builtin_bit_cast(float, w & 0xffff0000u); }
__device__ __forceinline__ void unpack8(const v4u w, float (&f)[8]) { f[0] = bflo(w.x); f[1] = bfhi(w.x); f[2] = bflo(w.y); f[3] = bfhi(w.y); f[4] = bflo(w.z); f[5] = bfhi(w.z); f[6] = bflo(w.w); f[7] = bfhi(w.w); }
__device__ __forceinline__ v4u pack8f(const float (&f)[8]) { v4u w; w.x = cvtpk(f[0], f[1]); w.y = cvtpk(f[2], f[3]); w.z = cvtpk(f[4], f[5]); w.w = cvtpk(f[6], f[7]); return w; }
__device__ __forceinline__ void load8f(const float* p, float (&f)[8]) { const f32x4 a = *(const f32x4*)p, b = *(const f32x4*)(p + 4); f[0] = a[0]; f[1] = a[1]; f[2] = a[2]; f[3] = a[3]; f[4] = b[0]; f[5] = b[1]; f[6] = b[2]; f[7] = b[3]; }

__device__ __forceinline__ void p0_transpose_item(const float* W, int K, int N, bf16* WT, int drow0, LAS float* scr, int k0, int n0, int lane, const float* gain = nullptr) {
    f32x4 w[8]; float gk[8];
#pragma unroll
    for (int i = 0; i < 8; ++i) { const int kk = 8 * i + (lane >> 3); w[i] = *(const GAS f32x4*)(W + (size_t)(k0 + kk) * N + n0 + 4 * (lane & 7)); gk[i] = gain ? gain[k0 + kk] : 1.0f; }
#pragma unroll
    for (int i = 0; i < 8; ++i) { const int kk = 8 * i + (lane >> 3); LAS float* d = scr + kk * 33 + 4 * (lane & 7); d[0] = w[i].x * gk[i]; d[1] = w[i].y * gk[i]; d[2] = w[i].z * gk[i]; d[3] = w[i].w * gk[i]; }
    LDS_WAIT(); asm volatile("" ::: "memory");
    const int c = lane & 7;
#pragma unroll
    for (int j = 0; j < 4; ++j) { const int n = (lane >> 3) + 8 * j; const LAS float* s = scr + (8 * c) * 33 + n;
        v4u o; o.x = cvtpk(s[0 * 33], s[1 * 33]); o.y = cvtpk(s[2 * 33], s[3 * 33]); o.z = cvtpk(s[4 * 33], s[5 * 33]); o.w = cvtpk(s[6 * 33], s[7 * 33]);
        *(GAS v4u*)(WT + (size_t)(drow0 + n) * K + k0 + 8 * c) = o; }
    LDS_WAIT(); asm volatile("" ::: "memory");
}
__device__ __forceinline__ int map_in_row(int n0) {
    if (n0 < 1536) return n0;
    const int w = n0 - 1536, sec = w >> 8, within = w & 255, hl = within >> 6, dim = within & 63;
    return 1536 + 256 * sec + 128 * (dim >> 5) + 32 * hl + (dim & 31);
}
__device__ __forceinline__ void rms_row(const float* srow, const float* g, bf16* drow, int lane) {
    const GAS f32x4* xr = (const GAS f32x4*)srow + lane;
    f32x4 v[4]; float s = 0.f;
#pragma unroll
    for (int j = 0; j < 4; ++j) { v[j] = xr[64 * j]; s += (v[j].x * v[j].x + v[j].y * v[j].y) + (v[j].z * v[j].z + v[j].w * v[j].w); }
    const float rstd = __builtin_amdgcn_rsqf(wave_sum(s) * (1.f / DM) + EPS);
    GAS unsigned long long* o8 = (GAS unsigned long long*)drow + lane;
#pragma unroll
    for (int j = 0; j < 4; ++j) { const f32x4 gg = ((const GAS f32x4*)g)[lane + 64 * j];
        o8[64 * j] = (unsigned long long)cvtpk(v[j].x * rstd * gg.x, v[j].y * rstd * gg.y) | ((unsigned long long)cvtpk(v[j].z * rstd * gg.z, v[j].w * rstd * gg.w) << 32); }
}
__device__ __forceinline__ void rms_rows(const float* src, const float* g, bf16* dst, int gw, int NGW, int lane) {
    f32x4 gg[4];
#pragma unroll
    for (int j = 0; j < 4; ++j) gg[j] = ((const GAS f32x4*)g)[lane + 64 * j];
    for (int m = gw * 4; m < MROWS; m += NGW * 4) {
        f32x4 v[4][4]; float s[4];
#pragma unroll
        for (int r = 0; r < 4; ++r)
#pragma unroll
            for (int j = 0; j < 4; ++j) v[r][j] = ((const GAS f32x4*)(src + (size_t)(m + r) * DM))[lane + 64 * j];
#pragma unroll
        for (int r = 0; r < 4; ++r) { s[r] = 0.f;
#pragma unroll
            for (int j = 0; j < 4; ++j) s[r] += (v[r][j].x * v[r][j].x + v[r][j].y * v[r][j].y) + (v[r][j].z * v[r][j].z + v[r][j].w * v[r][j].w); }
#pragma unroll
        for (int o = 1; o < 64; o <<= 1) {
#pragma unroll
            for (int r = 0; r < 4; ++r) s[r] += __shfl_xor(s[r], o); }
#pragma unroll
        for (int r = 0; r < 4; ++r) { const float rstd = __builtin_amdgcn_rsqf(s[r] * (1.f / DM) + EPS);
            GAS unsigned long long* o8 = (GAS unsigned long long*)(dst + (size_t)(m + r) * DM) + lane;
#pragma unroll
            for (int j = 0; j < 4; ++j) o8[64 * j] = (unsigned long long)cvtpk(v[r][j].x * rstd * gg[j].x, v[r][j].y * rstd * gg[j].y) | ((unsigned long long)cvtpk(v[r][j].z * rstd * gg[j].z, v[r][j].w * rstd * gg[j].w) << 32); }
    }
}

namespace att {
typedef float f32x16 __attribute__((ext_vector_type(16)));
typedef short s16x4 __attribute__((ext_vector_type(4)));
typedef short v4i16_t __attribute__((ext_vector_type(4)));
__device__ __forceinline__ constexpr int cr(int r) { return (r & 3) + 8 * (r >> 2); }
__device__ __forceinline__ s16x4 vtr(LAS const unsigned char* p) { return __builtin_bit_cast(s16x4, __builtin_amdgcn_ds_read_tr16_b64_v4i16((LAS v4i16_t*)p)); }

constexpr int K_OFF = 0, V_OFF = 49152, O_OFF = 98304;
struct UnitP { int b, h, d, r, blk, branch; float cb; };
__device__ __forceinline__ UnitP unit_params(int u) {
    UnitP p; const int bh = u / 96, u96 = u % 96, within = u96 & 31; p.branch = u96 >> 5;
    p.d = 1 << (2 * p.branch); const int nblk = 32 >> (2 * p.branch); p.r = within / nblk; p.blk = within % nblk; p.b = bh >> 3; p.h = bh & 7;
    p.cb = __builtin_amdgcn_exp2f(-(float)(p.h + 1)) * (float)p.d * LOG2E; return p;
}
struct Stage { v4u k[6], v[6]; bf16x8 q[4]; };
__device__ __forceinline__ void stage_load(Stage& st, const bf16* Qg, const bf16* Kg, const bf16* Vg, const UnitP& p, int tid, int wave, int lane) {
    const size_t hb = (size_t)(p.b * NHEAD + p.h) * SEQ * HD; const bf16* Kh = Kg + hb; const bf16* Vh = Vg + hb; const bf16* Qh = Qg + hb;
    const int lbase = p.blk * 256 - 128;
#pragma unroll
    for (int it = 0; it < 6; ++it) { const int idx = tid + 512 * it, row = idx >> 3, c = idx & 7; int l = lbase + row; l = l < 0 ? 0 : l;
        const size_t off = (size_t)(p.r + p.d * l) * HD + 8 * c; st.k[it] = *(const GAS v4u*)(Kh + off); st.v[it] = *(const GAS v4u*)(Vh + off); }
    const int pq = p.r + p.d * (p.blk * 256 + 32 * wave + (lane & 31));
#pragma unroll
    for (int s = 0; s < 4; ++s) st.q[s] = *(const GAS bf16x8*)(Qh + (size_t)pq * HD + 16 * s + 8 * (lane >> 5));
}
__device__ __forceinline__ void stage_write(const Stage& st, LAS unsigned char* L, int tid) {
#pragma unroll
    for (int it = 0; it < 6; ++it) { const int idx = tid + 512 * it, row = idx >> 3, c = idx & 7;
        *(LAS v4u*)(L + K_OFF + row * 128 + ((c ^ (row & 7)) << 4)) = st.k[it];
        *(LAS v4u*)(L + V_OFF + ((row >> 4) * 2 + (c >> 2)) * 1024 + (row & 15) * 64 + (c & 3) * 16) = st.v[it]; }
}
__device__ __forceinline__ void compute_tile(LAS unsigned char* L, const bf16x8 (&qf)[4], const UnitP& p, bf16* OPb, float* LPb, float negM, int wave, int lane) {
    const int r32 = lane & 31, hi = lane >> 5;
    const int l0 = p.blk * 256 + 32 * wave, d = p.d, r = p.r; const float cb = p.cb;
    const int pq = r + d * (l0 + r32);
    const int kb0 = l0 >= 128 ? 0 : ((128 - l0) >> 5);
    f32x16 o0, o1;
#pragma unroll
    for (int i = 0; i < 16; ++i) { o0[i] = 0.f; o1[i] = 0.f; }
    float lsum = 0.f;
    const int i4 = r32 - 4 * hi;
    const int laneoff = ((lane >> 4) & 1) * 32 + (lane & 3) * 8 + (4 * hi + ((lane & 15) >> 2)) * 64;
#pragma unroll
    for (int kb = 0; kb < 5; ++kb) if (kb >= kb0) {
        const int row = 32 * (wave + kb) + r32;
        bf16x8 kf[4];
#pragma unroll
        for (int s = 0; s < 4; ++s) kf[s] = *(LAS const bf16x8*)(L + K_OFF + row * 128 + (((2 * s + hi) ^ (row & 7)) << 4));
        const float lt = negM - cb * (float)(128 + r32 - 32 * kb - 4 * hi);
        f32x16 sacc;
#pragma unroll
        for (int i = 0; i < 16; ++i) sacc[i] = __builtin_fmaf(cb, (float)cr(i), lt);
#pragma unroll
        for (int s = 0; s < 4; ++s) sacc = __builtin_amdgcn_mfma_f32_32x32x16_bf16(kf[s], qf[s], sacc, 0, 0, 0);
        float pe[16];
#pragma unroll
        for (int i = 0; i < 16; ++i) pe[i] = __builtin_amdgcn_exp2f(sacc[i]);
        if (kb == 0) {
#pragma unroll
            for (int i = 0; i < 16; ++i) pe[i] = (cr(i) >= i4) ? pe[i] : 0.f;
        }
        if (kb == 4) {
#pragma unroll
            for (int i = 0; i < 16; ++i) pe[i] = (cr(i) <= i4) ? pe[i] : 0.f;
        }
        float ps = 0.f;
#pragma unroll
        for (int i = 0; i < 16; ++i) ps += pe[i];
        lsum += ps;
        v4u pw0, pw1;
        pw0.x = cvtpk(pe[0], pe[1]); pw0.y = cvtpk(pe[2], pe[3]); pw0.z = cvtpk(pe[4], pe[5]); pw0.w = cvtpk(pe[6], pe[7]);
        pw1.x = cvtpk(pe[8], pe[9]); pw1.y = cvtpk(pe[10], pe[11]); pw1.z = cvtpk(pe[12], pe[13]); pw1.w = cvtpk(pe[14], pe[15]);
        const bf16x8 pa0 = __builtin_bit_cast(bf16x8, pw0), pa1 = __builtin_bit_cast(bf16x8, pw1);
        LAS const unsigned char* vb = L + V_OFF + (wave + kb) * 4096 + laneoff;
#pragma unroll
        for (int d0 = 0; d0 < 2; ++d0) {
            const s16x4 a_lo = vtr(vb + d0 * 1024), a_hi = vtr(vb + d0 * 1024 + 512), b_lo = vtr(vb + 2048 + d0 * 1024), b_hi = vtr(vb + 2048 + d0 * 1024 + 512);
            const bf16x8 v0 = (bf16x8){a_lo[0], a_lo[1], a_lo[2], a_lo[3], a_hi[0], a_hi[1], a_hi[2], a_hi[3]};
            const bf16x8 v1 = (bf16x8){b_lo[0], b_lo[1], b_lo[2], b_lo[3], b_hi[0], b_hi[1], b_hi[2], b_hi[3]};
            if (d0 == 0) { o0 = __builtin_amdgcn_mfma_f32_32x32x16_bf16(pa0, v0, o0, 0, 0, 0); o0 = __builtin_amdgcn_mfma_f32_32x32x16_bf16(pa1, v1, o0, 0, 0, 0); }
            else         { o1 = __builtin_amdgcn_mfma_f32_32x32x16_bf16(pa0, v0, o1, 0, 0, 0); o1 = __builtin_amdgcn_mfma_f32_32x32x16_bf16(pa1, v1, o1, 0, 0, 0); }
        }
    }
    lsum += __shfl_xor(lsum, 32);
    if (hi == 0) LPb[(size_t)(p.b * SEQ + pq) * NHEAD + p.h] = lsum;
    LAS unsigned short* stg = (LAS unsigned short*)(L + O_OFF + wave * 4096);
#pragma unroll
    for (int i = 0; i < 16; ++i) { const int q = cr(i) + 4 * hi;
        stg[q * 64 + r32] = (unsigned short)(cvtpk(o0[i], o0[i]) & 0xffffu); stg[q * 64 + 32 + r32] = (unsigned short)(cvtpk(o1[i], o1[i]) & 0xffffu); }
    LDS_WAIT(); asm volatile("" ::: "memory");
#pragma unroll
    for (int it = 0; it < 4; ++it) { const int row = it * 8 + (lane >> 3), ch = lane & 7;
        const v4u v = *(LAS const v4u*)(stg + row * 64 + ch * 8);
        *(GAS v4u*)(OPb + (size_t)(p.b * SEQ + r + d * (l0 + row)) * ATTW + p.h * HD + ch * 8) = v; }
    LDS_WAIT(); asm volatile("" ::: "memory");
}
}

#ifndef DUP_MASK
#define DUP_MASK 0
#endif
struct Args { const float* in[20]; float* out; unsigned char* ws; };
enum { I_X = 0, I_P, I_GMIX, I_WIN, I_CONVW, I_CONVB, I_QG, I_KG, I_GOC, I_GOA, I_WOUT, I_GFFN, I_WGATE, I_WUP, I_FCW, I_FCB, I_WDOWN, I_GPLE, I_WPG, I_WPP };

#define PHASE_PTRS KARG_DECL unsigned char* const ws_ = ARG_WS(); float* const out = ARG_OUT(); (void)out; \
    bf16* const WIN = (bf16*)(ws_ + WS_WIN); bf16* const WOUT = (bf16*)(ws_ + WS_WOUT); bf16* const WGU = (bf16*)(ws_ + WS_WGU); bf16* const WDN = (bf16*)(ws_ + WS_WDN); bf16* const WPG = (bf16*)(ws_ + WS_WPG); bf16* const WPP = (bf16*)(ws_ + WS_WPP); \
    bf16* const HB = (bf16*)(ws_ + WS_H); bf16* const PB = (bf16*)(ws_ + WS_PB); bf16* const ZC = (bf16*)(ws_ + WS_ZC); bf16* const QB = (bf16*)(ws_ + WS_Q); bf16* const KB = (bf16*)(ws_ + WS_K); bf16* const VB = (bf16*)(ws_ + WS_V); \
    bf16* const OP = (bf16*)(ws_ + WS_OP); float* const LP = (float*)(ws_ + WS_LP); bf16* const YB = (bf16*)(ws_ + WS_Y); bf16* const UB = (bf16*)(ws_ + WS_U); float* const TOPG = (float*)(ws_ + WS_TOPG); float* const BOTG = (float*)(ws_ + WS_BOTG); float* const TOPU = (float*)(ws_ + WS_TOPU); (void)TOPG; (void)BOTG; (void)TOPU; bf16* const PP = (bf16*)(ws_ + WS_PP); float* const SSB = (float*)(ws_ + WS_SS); (void)SSB; bf16* const X2B = (bf16*)(ws_ + WS_X2); (void)X2B; \
    (void)WIN; (void)WOUT; (void)WGU; (void)WDN; (void)WPG; (void)WPP; (void)HB; (void)PB; (void)ZC; (void)QB; (void)KB; (void)VB; (void)OP; (void)LP; (void)YB; (void)UB; (void)PP;
#define CAS __attribute__((address_space(4)))
#define ARG_IN(i) (*(const float* const CAS*)(ka_ + 8 * (i)))
#define ARG_OUT() (*(float* const CAS*)(ka_ + 8 * 20))
#define ARG_WS() (*(unsigned char* const CAS*)(ka_ + 8 * 21))
#define KARG_DECL const CAS unsigned char* ka_ = (const CAS unsigned char*)__builtin_amdgcn_kernarg_segment_ptr(); asm volatile("" : "+s"(ka_));
__device__ __forceinline__ void phase0(LAS unsigned char* L, const int lane, const int wave, const int G, const int bx, const int vcu, const int gw, const int NGW) {
    { PHASE_PTRS
    {
        LAS float* scr = (LAS float*)(L + wave * 16384);
        constexpr int I_IN = 16 * 96, I_OUT = 16 * 32, I_GT = 16 * 88, I_DN = 44 * 32, I_PG = 16 * 32, I_PPJ = 4 * 32;
        constexpr int NITEMS = I_IN + I_OUT + 2 * I_GT + I_DN + I_PG + I_PPJ;
        for (int it = gw; it < NITEMS; it += NGW) {
            int r = it;
            if (r < I_IN) { const int kb = r / 96, n0 = 32 * (r % 96); p0_transpose_item(ARG_IN(I_WIN), DM, INCOLS, WIN, map_in_row(n0), scr, 64 * kb, n0, lane); continue; } r -= I_IN;
            if (r < I_OUT) { const int kb = r / 32, n0 = 32 * (r % 32); p0_transpose_item(ARG_IN(I_WOUT), DM, DM, WOUT, n0, scr, 64 * kb, n0, lane); continue; } r -= I_OUT;
            if (r < I_GT) { const int kb = r / 88, n0 = 32 * (r % 88); p0_transpose_item(ARG_IN(I_WGATE), DM, DFF, WGU, 256 * (n0 >> 7) + (n0 & 127), scr, 64 * kb, n0, lane, ARG_IN(I_GFFN)); continue; } r -= I_GT;
            if (r < I_GT) { const int kb = r / 88, n0 = 32 * (r % 88); p0_transpose_item(ARG_IN(I_WUP), DM, DFF, WGU, 256 * (n0 >> 7) + 128 + (n0 & 127), scr, 64 * kb, n0, lane, ARG_IN(I_GFFN)); continue; } r -= I_GT;
            if (r < I_DN) { const int kb = r / 32, n0 = 32 * (r % 32); p0_transpose_item(ARG_IN(I_WDOWN), DFF, DM, WDN, n0, scr, 64 * kb, n0, lane); continue; } r -= I_DN;
            if (r < I_PG) { const int kb = r / 32, n0 = 32 * (r % 32); p0_transpose_item(ARG_IN(I_WPG), DM, DM, WPG, n0, scr, 64 * kb, n0, lane, ARG_IN(I_GPLE)); continue; } r -= I_PG;
            { const int kb = r / 32, n0 = 32 * (r % 32); p0_transpose_item(ARG_IN(I_WPP), PLED, DM, WPP, n0, scr, 64 * kb, n0, lane); }
        }
        rms_rows(ARG_IN(I_X), ARG_IN(I_GMIX), HB, gw, NGW, lane);
        for (int m = gw * 8; m < MROWS; m += NGW * 8) {
            f32x4 v[8];
#pragma unroll
            for (int r = 0; r < 8; ++r) v[r] = ((const GAS f32x4*)(ARG_IN(I_P) + (size_t)(m + r) * PLED))[lane];
#pragma unroll
            for (int r = 0; r < 8; ++r) ((GAS unsigned long long*)(PB + (size_t)(m + r) * PLED))[lane] = (unsigned long long)cvtpk(v[r].x, v[r].y) | ((unsigned long long)cvtpk(v[r].z, v[r].w) << 32);
        }
    }
    }
}
__device__ __forceinline__ void phase1(LAS unsigned char* L, const int lane, const int wave, const int G, const int bx, const int vcu, const int gw, const int NGW) {
    { PHASE_PTRS
    {
        int kdim_ = DM; asm volatile("" : "+s"(kdim_)); pg8::Gemm g{HB, WIN, MROWS, INCOLS, kdim_}; pg8::StaticOrder S; S.init(MROWS, INCOLS, G, bx);
        pg8::EpiInProj E{ZC, QB, KB, VB, ARG_IN(I_QG), ARG_IN(I_KG), 0.125f * LOG2E, EPS};
        pg8::gemm_phase<pg8::EpiInProj, pg8::StaticOrder, true, true>(L, g, S, E);
    }
    }
}
__device__ __forceinline__ void phase2(LAS unsigned char* L, const int lane, const int wave, const int G, const int bx, const int vcu, const int gw, const int NGW) {
    { PHASE_PTRS
    {
        const float mq = wave_max(fabsf(ARG_IN(I_QG)[lane])), mk = wave_max(fabsf(ARG_IN(I_KG)[lane]));
        const float negM = -8.0f * mq * mk * LOG2E;
        const int nper = 3072 / G, tid = threadIdx.x;
        att::Stage st; att::UnitP p = att::unit_params(vcu * nper);
        att::stage_load(st, QB, KB, VB, p, tid, wave, lane);
        for (int i = 0; i < nper; ++i) {
            att::stage_write(st, L, tid);
            bf16x8 qf[4];
#pragma unroll
            for (int s = 0; s < 4; ++s) qf[s] = st.q[s];
            asm volatile("s_waitcnt lgkmcnt(0)" ::: "memory"); __builtin_amdgcn_s_barrier(); asm volatile("" ::: "memory");
            att::UnitP pn = p;
            if (i + 1 < nper) { pn = att::unit_params(vcu * nper + i + 1); att::stage_load(st, QB, KB, VB, pn, tid, wave, lane); }
            att::compute_tile(L, qf, p, OP + (size_t)p.branch * MROWS * ATTW, LP + (size_t)p.branch * MROWS * NHEAD, negM, wave, lane);
            asm volatile("s_waitcnt lgkmcnt(0)" ::: "memory"); __builtin_amdgcn_s_barrier(); asm volatile("" ::: "memory");
            p = pn;
        }
    }
    }
}
__device__ __forceinline__ void phase3(LAS unsigned char* L, const int lane, const int wave, const int G, const int bx, const int vcu, const int gw, const int NGW) {
    { PHASE_PTRS
    {
        const int c = 8 * lane;
        float cw0[8], cw1[8], cw2[8], cbv[8], gc[8], ga[8];
        load8f(ARG_IN(I_CONVW) + c, cw0); load8f(ARG_IN(I_CONVW) + CONVW + c, cw1); load8f(ARG_IN(I_CONVW) + 2 * CONVW + c, cw2);
        load8f(ARG_IN(I_CONVB) + c, cbv); load8f(ARG_IN(I_GOC) + c, gc); load8f(ARG_IN(I_GOA) + c, ga);
        for (int ch = gw; ch < MROWS / 16; ch += NGW) {
            const int m0 = ch * 16;
            float u1[8], u2[8];
            if ((m0 & (SEQ - 1)) == 0) {
#pragma unroll
                for (int j = 0; j < 8; ++j) { u1[j] = 0.f; u2[j] = 0.f; }
            } else {
                float a[8], bb[8];
                unpack8(*(const GAS v4u*)(ZC + (size_t)(m0 - 1) * 1536 + 512 + c), a); unpack8(*(const GAS v4u*)(ZC + (size_t)(m0 - 1) * 1536 + 1024 + c), bb);
#pragma unroll
                for (int j = 0; j < 8; ++j) u1[j] = a[j] * bb[j];
                unpack8(*(const GAS v4u*)(ZC + (size_t)(m0 - 2) * 1536 + 512 + c), a); unpack8(*(const GAS v4u*)(ZC + (size_t)(m0 - 2) * 1536 + 1024 + c), bb);
#pragma unroll
                for (int j = 0; j < 8; ++j) u2[j] = a[j] * bb[j];
            }
            for (int tt = 0; tt < 16; ++tt) {
                const size_t m = (size_t)(m0 + tt);
                float zb[8], zc[8], zx[8], y[8];
                unpack8(*(const GAS v4u*)(ZC + m * 1536 + c), zb); unpack8(*(const GAS v4u*)(ZC + m * 1536 + 512 + c), zc); unpack8(*(const GAS v4u*)(ZC + m * 1536 + 1024 + c), zx);
                float o1[8], o2[8], o3[8];
                unpack8(*(const GAS v4u*)(OP + m * ATTW + c), o1); unpack8(*(const GAS v4u*)(OP + ((size_t)MROWS + m) * ATTW + c), o2); unpack8(*(const GAS v4u*)(OP + ((size_t)2 * MROWS + m) * ATTW + c), o3);
                const float lt = LP[m * NHEAD + (lane >> 3)] + LP[((size_t)MROWS + m) * NHEAD + (lane >> 3)] + LP[((size_t)2 * MROWS + m) * NHEAD + (lane >> 3)];
                float ss = 0.f;
#pragma unroll
                for (int j = 0; j < 8; ++j) { const float u0 = zc[j] * zx[j]; y[j] = zb[j] * (cw0[j] * u2[j] + cw1[j] * u1[j] + cw2[j] * u0 + cbv[j]); ss += y[j] * y[j]; u2[j] = u1[j]; u1[j] = u0; }
                const float rc = __builtin_amdgcn_rsqf(wave_sum(ss) * (1.f / CONVW) + EPS);
#pragma unroll
                for (int j = 0; j < 8; ++j) y[j] = y[j] * rc * gc[j];
                *(GAS v4u*)(YB + m * DM + c) = pack8f(y);
                const float rl = 1.0f / lt; float sa = 0.f;
#pragma unroll
                for (int j = 0; j < 8; ++j) { y[j] = (o1[j] + o2[j] + o3[j]) * rl; sa += y[j] * y[j]; }
                const float ra = __builtin_amdgcn_rsqf(wave_sum(sa) * (1.f / ATTW) + EPS);
#pragma unroll
                for (int j = 0; j < 8; ++j) y[j] = y[j] * ra * ga[j];
                *(GAS v4u*)(YB + m * DM + CONVW + c) = pack8f(y);
            }
        }
    }
    }
}
__device__ __forceinline__ void phase4(LAS unsigned char* L, const int lane, const int wave, const int G, const int bx, const int vcu, const int gw, const int NGW) {
    { PHASE_PTRS
    {
        int kdim_ = DM; asm volatile("" : "+s"(kdim_)); pg8::Gemm g{YB, WOUT, MROWS, DM, kdim_}; pg8::StaticOrder S; S.init(MROWS, DM, G, bx);
        pg8::EpiResNorm<false> E{ARG_IN(I_X), HB, SSB, DM, (LAS float*)(L + XCH_OFF)};
        pg8::gemm_phase<pg8::EpiResNorm<false>, pg8::StaticOrder, true, true>(L, g, S, E);
    }
    }
}
__device__ __forceinline__ void phase6(LAS unsigned char* L, const int lane, const int wave, const int G, const int bx, const int vcu, const int gw, const int NGW) {
    { PHASE_PTRS
    {
        int kdim_ = DM; asm volatile("" : "+s"(kdim_)); pg8::Gemm g{HB, WGU, MROWS, 2 * DFF, kdim_}; pg8::StaticOrder S; S.init(MROWS, 2 * DFF, G, bx);
        pg8::EpiGUAct E{UB, DFF, SSB, EPS, ARG_IN(I_FCW), ARG_IN(I_FCB), TOPG, BOTG, TOPU, (LAS float*)(L + XCH_OFF)};
        pg8::gemm_phase<pg8::EpiGUAct, pg8::StaticOrder, true, true>(L, g, S, E);
    }
    }
}
__device__ __forceinline__ void phase7(LAS unsigned char* L, const int lane, const int wave, const int G, const int bx, const int vcu, const int gw, const int NGW) {
    { PHASE_PTRS
    {
        for (int it = gw; it < 128 * 6; it += NGW) {
            const int pm = it / 6, cg = it % 6, c = cg * 512 + 8 * lane;
            if ((pm & 31) != 0 && c < DFF) {
                float w0[8], w1[8], w2[8], bv[8], g0[8], g1[8], gm1[8], gm2[8], u0[8], u1[8], a0[8], a1[8];
                load8f(ARG_IN(I_FCW) + c, w0); load8f(ARG_IN(I_FCW) + DFF + c, w1); load8f(ARG_IN(I_FCW) + 2 * DFF + c, w2); load8f(ARG_IN(I_FCB) + c, bv);
                load8f(TOPG + (size_t)(pm * 2) * DFF + c, g0); load8f(TOPG + (size_t)(pm * 2 + 1) * DFF + c, g1);
                load8f(BOTG + (size_t)(pm * 2 - 2) * DFF + c, gm2); load8f(BOTG + (size_t)(pm * 2 - 1) * DFF + c, gm1);
                load8f(TOPU + (size_t)(pm * 2) * DFF + c, u0); load8f(TOPU + (size_t)(pm * 2 + 1) * DFF + c, u1);
#pragma unroll
                for (int j = 0; j < 8; ++j) {
                    const float p0 = w0[j] * gm2[j] + w1[j] * gm1[j] + w2[j] * g0[j] + bv[j], p1 = w0[j] * gm1[j] + w1[j] * g0[j] + w2[j] * g1[j] + bv[j];
                    a0[j] = p0 * __builtin_amdgcn_rcpf(1.0f + __builtin_amdgcn_exp2f(-LOG2E * p0)) * u0[j];
                    a1[j] = p1 * __builtin_amdgcn_rcpf(1.0f + __builtin_amdgcn_exp2f(-LOG2E * p1)) * u1[j];
                }
                *(GAS v4u*)(UB + (size_t)(pm * 256) * DFF + c) = pack8f(a0);
                *(GAS v4u*)(UB + (size_t)(pm * 256 + 1) * DFF + c) = pack8f(a1);
            }
        }
    }
    {
        int kdim_ = PLED; asm volatile("" : "+s"(kdim_)); pg8::Gemm g{PB, WPP, MROWS, DM, kdim_}; pg8::StaticOrder S; S.init(MROWS, DM, G, bx);
        pg8::EpiBf16 E{PP, DM};
        pg8::gemm_phase<pg8::EpiBf16, pg8::StaticOrder, true, true>(L, g, S, E);
    }
    }
}
__device__ __forceinline__ void phase8(LAS unsigned char* L, const int lane, const int wave, const int G, const int bx, const int vcu, const int gw, const int NGW) {
    { PHASE_PTRS
    {
        int kdim_ = DFF; asm volatile("" : "+s"(kdim_)); pg8::Gemm g{UB, WDN, MROWS, DM, kdim_}; pg8::StaticOrder S; S.init(MROWS, DM, G, bx);
        pg8::EpiResNorm<true> E{HB, X2B, SSB, DM, (LAS float*)(L + XCH_OFF)};
        pg8::gemm_phase<pg8::EpiResNorm<true>, pg8::StaticOrder, true, true>(L, g, S, E);
    }
    }
}
__device__ __forceinline__ void phase10(LAS unsigned char* L, const int lane, const int wave, const int G, const int bx, const int vcu, const int gw, const int NGW) {
    { PHASE_PTRS
    {
        int kdim_ = DM; asm volatile("" : "+s"(kdim_)); pg8::Gemm g{X2B, WPG, MROWS, DM, kdim_}; pg8::StaticOrder S; S.init(MROWS, DM, G, bx);
        pg8::EpiPle E{X2B, out, PP, DM, SSB, EPS};
        pg8::gemm_phase<pg8::EpiPle, pg8::StaticOrder, true, true>(L, g, S, E);
    }
    }
}
__global__ void __launch_bounds__(NWAVES * 64, 2) hybrid_fwd(Args args) {
    extern __shared__ __attribute__((aligned(16))) unsigned char lds[];
    LAS unsigned char* L = (LAS unsigned char*)lds;
    volatile LAS unsigned* MISC = (volatile LAS unsigned*)(L + MISC_OFF);
    const int tid = threadIdx.x, lane = tid & 63, wave = __builtin_amdgcn_readfirstlane(tid >> 6);
    const int G = gridDim.x; const int bx = blockIdx.x;
    const int vcu = (G % 8 == 0) ? (bx % 8) * (G / 8) + bx / 8 : bx;
    const int gw = vcu * NWAVES + wave, NGW = G * NWAVES;
    gu32* ctl; { KARG_DECL ctl = (gu32*)(ARG_WS() + WS_CTL); }
    for (int u = tid; u < (LDS_BYTES - LDSCTL_OFF) / 4; u += NWAVES * 64) ((LAS unsigned*)(L + LDSCTL_OFF))[u] = 0u;
    __syncthreads();
    XcdBarrier bar = xcd_barrier_post((unsigned*)(ctl + CW_BAR), MISC + 8);

#ifndef SKIP_P0
    phase0(L, lane, wave, G, bx, vcu, gw, NGW);
#endif
    xcd_barrier(bar);
#if (DUP_MASK >> 0) & 1
    phase0(L, lane, wave, G, bx, vcu, gw, NGW);
    xcd_barrier(bar);
#endif

#ifndef SKIP_P1
    phase1(L, lane, wave, G, bx, vcu, gw, NGW);
#endif
    xcd_barrier(bar);
#if (DUP_MASK >> 1) & 1
    phase1(L, lane, wave, G, bx, vcu, gw, NGW);
    xcd_barrier(bar);
#endif

#ifndef SKIP_P2
    phase2(L, lane, wave, G, bx, vcu, gw, NGW);
#endif
    xcd_barrier(bar);
#if (DUP_MASK >> 2) & 1
    phase2(L, lane, wave, G, bx, vcu, gw, NGW);
    xcd_barrier(bar);
#endif

#ifndef SKIP_P3
    phase3(L, lane, wave, G, bx, vcu, gw, NGW);
#endif
    xcd_barrier(bar);
#if (DUP_MASK >> 3) & 1
    phase3(L, lane, wave, G, bx, vcu, gw, NGW);
    xcd_barrier(bar);
#endif

#ifndef SKIP_P4
    phase4(L, lane, wave, G, bx, vcu, gw, NGW);
#endif
    xcd_barrier(bar);
#if (DUP_MASK >> 4) & 1
    phase4(L, lane, wave, G, bx, vcu, gw, NGW);
    xcd_barrier(bar);
#endif

#ifndef SKIP_P6
    phase6(L, lane, wave, G, bx, vcu, gw, NGW);
#endif
    xcd_barrier(bar);
#if (DUP_MASK >> 6) & 1
    phase6(L, lane, wave, G, bx, vcu, gw, NGW);
    xcd_barrier(bar);
#endif

#ifndef SKIP_P7
    phase7(L, lane, wave, G, bx, vcu, gw, NGW);
#endif
    xcd_barrier(bar);
#if (DUP_MASK >> 7) & 1
    phase7(L, lane, wave, G, bx, vcu, gw, NGW);
    xcd_barrier(bar);
#endif

#ifndef SKIP_P8
    phase8(L, lane, wave, G, bx, vcu, gw, NGW);
#endif
    xcd_barrier(bar);
#if (DUP_MASK >> 8) & 1
    phase8(L, lane, wave, G, bx, vcu, gw, NGW);
    xcd_barrier(bar);
#endif


#ifndef SKIP_P10
    phase10(L, lane, wave, G, bx, vcu, gw, NGW);
#endif
#if (DUP_MASK >> 10) & 1
    xcd_barrier(bar);
    phase10(L, lane, wave, G, bx, vcu, gw, NGW);
#endif
}

extern "C" void kernel_launch(void* const* d_in, const int* in_sizes, int n_in, void* d_out, int out_size, void* d_ws, size_t ws_size, hipStream_t stream) {
    static int grid = 0;
    if (grid == 0) {
        if (n_in != 20 || out_size != MROWS * DM || ws_size < WS_END) { fprintf(stderr, "kernel_launch: unexpected shapes (n_in %d, out %d, ws %zu); nothing launched\n", n_in, out_size, ws_size); grid = -1; return; }
        int dev = 0, cus = 0, per_cu = 0;
        if (hipGetDevice(&dev) != hipSuccess || hipDeviceGetAttribute(&cus, hipDeviceAttributeMultiprocessorCount, dev) != hipSuccess) { grid = -1; return; }
        if (hipFuncSetAttribute((const void*)hybrid_fwd, hipFuncAttributeMaxDynamicSharedMemorySize, LDS_BYTES) != hipSuccess) { fprintf(stderr, "kernel_launch: hipFuncSetAttribute failed\n"); grid = -1; return; }
        if (hipOccupancyMaxActiveBlocksPerMultiprocessor(&per_cu, (const void*)hybrid_fwd, NWAVES * 64, LDS_BYTES) != hipSuccess || per_cu < 1)
            fprintf(stderr, "kernel_launch: note: occupancy query reports %d workgroups per CU\n", per_cu);
        (void)hipGetLastError();
        grid = cus;
        if (grid != 256) fprintf(stderr, "kernel_launch: %d CUs (built for 256)\n", grid);
    }
    if (grid < 0) return;
    if (hipMemsetAsync((char*)d_ws + WS_CTL, 0, CTL_ZERO_BYTES, stream) != hipSuccess) { fprintf(stderr, "kernel_launch: hipMemsetAsync failed\n"); return; }
    Args a{};
    for (int i = 0; i < 20; ++i) a.in[i] = (const float*)d_in[i];
    a.out = (float*)d_out; a.ws = (unsigned char*)d_ws;
    hipLaunchKernelGGL(hybrid_fwd, dim3(grid), dim3(NWAVES * 64), LDS_BYTES, stream, a);
    const hipError_t le = hipPeekAtLastError();
    if (le != hipSuccess) fprintf(stderr, "kernel_launch: launch failed: %s\n", hipGetErrorName(le));
}
```

```cpp
#include <hip/hip_runtime.h>
#include <cstdio>
#include <cstdint>
namespace pg8 {
#define PG8_LAS __attribute__((address_space(3)))
typedef unsigned short bf16_t;
typedef short bf16x8 __attribute__((ext_vector_type(8)));
typedef float f32x4 __attribute__((ext_vector_type(4)));
typedef unsigned u32x4 __attribute__((ext_vector_type(4)));
constexpr int BM = 256, BK = 64, HALF = 128, HTB = HALF * BK * 2  , STAGE_BYTES = 8 * HTB, NXCD = 8;
#ifndef PG8_WGM
#define PG8_WGM 4
#endif
constexpr int WGM = PG8_WGM;

__host__ __device__ __forceinline__ int lds_byte(int r, int c) { const int st = (r >> 4) * 2 + (c >> 5), rr = r & 15, cc = c & 31, ob = rr * 64 + cc * 2; return st * 1024 + (ob ^ (((ob >> 9) & 1) << 5)); }
__host__ __device__ __forceinline__ void stage_rc(int b, int& R, int& C) { const int st = b / 1024, sb = b % 1024, swz = sb ^ (((sb >> 9) & 1) << 5); R = (st >> 1) * 16 + swz / 64; C = (st & 1) * 32 + (swz % 64) / 2; }
__host__ __device__ __forceinline__ int perm32(int rho) { const int n = rho >> 4, i = rho & 15; return 8 * (i >> 2) + 4 * n + (i & 3); }

struct Unit { int pm, pn; };
struct Gemm { const bf16_t* A; const bf16_t* Bt; int M, N, K; unsigned* tacc = nullptr; };

struct StaticOrder {
    int nM, nN, nwg, G, c, wgm;
    __host__ __device__ void init(int M, int N, int G_, int c_, int wgm_ = WGM) { nM = M / BM; nN = N / BM; nwg = nM * nN; G = G_; c = c_; wgm = wgm_; }
    __host__ __device__ bool next(int i, Unit& u) const {
        const long L = (long)i * G + c; if (L >= nwg) return false;
        int wgid = (int)L; { const int q = nwg / NXCD, r = nwg % NXCD, xcd = wgid % NXCD, off = wgid / NXCD; wgid = (xcd < r ? xcd * (q + 1) : r * (q + 1) + (xcd - r) * q) + off; }
        const int nig = wgm * nN, gid = wgid / nig, fm = gid * wgm, gsz = (nM - fm) < wgm ? (nM - fm) : wgm;
        u.pm = fm + ((wgid % nig) % gsz); u.pn = (wgid % nig) / gsz; return true;
    }
    __device__ __forceinline__ void a_ready(const Unit&) const {}
    __device__ __forceinline__ void done(const Unit&) const {}
};

__device__ __forceinline__ unsigned cvt_pk_bf16(float lo, float hi) { unsigned r; asm volatile("v_cvt_pk_bf16_f32 %0, %1, %2" : "=v"(r) : "v"(lo), "v"(hi)); return r; }
__device__ __forceinline__ u32x4 pack8(const f32x4& v0, const f32x4& v1) { u32x4 w; w.x = cvt_pk_bf16(v0[0], v0[1]); w.y = cvt_pk_bf16(v0[2], v0[3]); w.z = cvt_pk_bf16(v1[0], v1[1]); w.w = cvt_pk_bf16(v1[2], v1[3]); return w; }
__device__ __forceinline__ float bf2f(unsigned short h) { return __builtin_bit_cast(float, (unsigned)h << 16); }

struct EpiBf16 {
    static constexpr bool PERM = true, AFTER_DRAIN = false;
    bf16_t* O; int ldc;
    __device__ __forceinline__ void operator()(const f32x4 (&acc)[2][2][4][2], const Unit& u, int wr, int wc, int fr, int fq) const {
        const int row0 = u.pm * BM + wr * 64 + fr, col0 = u.pn * BM + wc * 32 + 8 * fq;
#pragma unroll
        for (int ai = 0; ai < 2; ++ai)
#pragma unroll
            for (int m = 0; m < 4; ++m) { bf16_t* rowp = O + (size_t)(row0 + ai * HALF + m * 16) * ldc + col0;
#pragma unroll
                for (int bj = 0; bj < 2; ++bj) *(u32x4*)(rowp + bj * HALF) = pack8(acc[ai][bj][m][0], acc[ai][bj][m][1]); }
    }
};
__device__ __forceinline__ float rstd4(const f32x4 a, float eps) { return __builtin_amdgcn_rsqf(((a[0] + a[1]) + (a[2] + a[3])) * (1.0f / 1024.0f) + eps); }
struct EpiGU {
    static constexpr bool PERM = true, AFTER_DRAIN = false;
    bf16_t* G; bf16_t* U; int ldc; const float* SS; float eps;
    __device__ __forceinline__ void operator()(const f32x4 (&acc)[2][2][4][2], const Unit& u, int wr, int wc, int fr, int fq) const {
        const int row0 = u.pm * BM + wr * 64 + fr, col0 = u.pn * HALF + wc * 32 + 8 * fq;
        f32x4 sp[2][4];
#pragma unroll
        for (int ai = 0; ai < 2; ++ai)
#pragma unroll
            for (int m = 0; m < 4; ++m) sp[ai][m] = *(const f32x4*)(SS + (size_t)(row0 + ai * HALF + m * 16) * 4);
#pragma unroll
        for (int ai = 0; ai < 2; ++ai)
#pragma unroll
            for (int m = 0; m < 4; ++m) { const int row = row0 + ai * HALF + m * 16; const float rs = rstd4(sp[ai][m], eps); const size_t off = (size_t)row * ldc + col0;
                *(u32x4*)(G + off) = pack8(acc[ai][0][m][0] * rs, acc[ai][0][m][1] * rs);
                *(u32x4*)(U + off) = pack8(acc[ai][1][m][0] * rs, acc[ai][1][m][1] * rs); }
    }
};
__device__ __forceinline__ float dpp_ror1(float v) { return __builtin_bit_cast(float, __builtin_amdgcn_mov_dpp(__builtin_bit_cast(int, v), 0x121, 0xf, 0xf, false)); }
__device__ __forceinline__ float dpp_ror2(float v) { return __builtin_bit_cast(float, __builtin_amdgcn_mov_dpp(__builtin_bit_cast(int, v), 0x122, 0xf, 0xf, false)); }
struct EpiGUAct {
    static constexpr bool PERM = true, AFTER_DRAIN = false;
    bf16_t* ACT; int ldc; const float* SS; float eps; const float* cw; const float* cbias; float* TOPG; float* BOTG; float* TOPU; PG8_LAS float* xch;
    __device__ __forceinline__ void operator()(const f32x4 (&acc_)[2][2][4][2], const Unit& u, int wr, int wc, int fr, int fq) const {
        f32x4 (&acc)[2][2][4][2] = const_cast<f32x4 (&)[2][2][4][2]>(acc_);
        const int row0 = u.pm * BM + wr * 64 + fr, colh = wc * 32 + 8 * fq, col0 = u.pn * HALF + colh;
        {
            f32x4 sp[2][4];
#pragma unroll
            for (int ai = 0; ai < 2; ++ai)
#pragma unroll
                for (int m = 0; m < 4; ++m) sp[ai][m] = *(const f32x4*)(SS + (size_t)(row0 + ai * HALF + m * 16) * 4);
#pragma unroll
            for (int ai = 0; ai < 2; ++ai)
#pragma unroll
                for (int m = 0; m < 4; ++m) { const float rs = rstd4(sp[ai][m], eps);
#pragma unroll
                    for (int bj = 0; bj < 2; ++bj)
#pragma unroll
                        for (int n = 0; n < 2; ++n) acc[ai][bj][m][n] = acc[ai][bj][m][n] * rs; }
        }
        if (fr >= 14) {
#pragma unroll
            for (int ai = 0; ai < 2; ++ai)
#pragma unroll
                for (int n = 0; n < 2; ++n) *(PG8_LAS f32x4*)(xch + (((wr * 2 + ai) * 2 + (fr - 14)) * 128 + colh + 4 * n)) = acc[ai][0][3][n];
            if (wr == 1) {
#pragma unroll
                for (int n = 0; n < 2; ++n) *(f32x4*)(BOTG + (size_t)(u.pm * 2 + fr - 14) * ldc + col0 + 4 * n) = acc[1][0][3][n];
            }
        }
        if (wr == 0 && fr < 2) {
#pragma unroll
            for (int n = 0; n < 2; ++n) { *(f32x4*)(TOPG + (size_t)(u.pm * 2 + fr) * ldc + col0 + 4 * n) = acc[0][0][0][n]; *(f32x4*)(TOPU + (size_t)(u.pm * 2 + fr) * ldc + col0 + 4 * n) = acc[0][1][0][n]; }
        }
        asm volatile("s_waitcnt lgkmcnt(0)" ::: "memory"); __builtin_amdgcn_s_barrier(); asm volatile("" ::: "memory");
        typedef unsigned u32x2v __attribute__((ext_vector_type(2)));
#pragma unroll
        for (int n = 0; n < 2; ++n) {
            const f32x4 w0 = *(const f32x4*)(cw + col0 + 4 * n), w1 = *(const f32x4*)(cw + ldc + col0 + 4 * n), w2 = *(const f32x4*)(cw + 2 * ldc + col0 + 4 * n), bb = *(const f32x4*)(cbias + col0 + 4 * n);
#pragma unroll
            for (int ai = 0; ai < 2; ++ai) {
                f32x4 r1p, r2p;
                if (wr == 0 && ai == 0) { r1p = (f32x4){0.f, 0.f, 0.f, 0.f}; r2p = (f32x4){0.f, 0.f, 0.f, 0.f}; }
                else {
                    const int pw = wr ^ 1, pai = (wr == 1) ? ai : ai - 1;
                    const PG8_LAS float* xb = xch + ((pw * 2 + pai) * 2) * 128 + colh + 4 * n;
                    const f32x4 e2 = *(const PG8_LAS f32x4*)(xb), e1 = *(const PG8_LAS f32x4*)(xb + 128); r1p = e1; r2p = (fr == 0) ? e2 : e1;
                }
#pragma unroll
                for (int m = 0; m < 4; ++m) {
                    const f32x4 g = acc[ai][0][m][n], uu = acc[ai][1][m][n];
                    f32x4 r1, r2, a4;
#pragma unroll
                    for (int j = 0; j < 4; ++j) { r1[j] = dpp_ror1(g[j]); r2[j] = dpp_ror2(g[j]); }
#pragma unroll
                    for (int j = 0; j < 4; ++j) {
                        const float p1 = (fr == 0) ? r1p[j] : r1[j], p2 = (fr < 2) ? r2p[j] : r2[j];
                        const float pre = w0[j] * p2 + w1[j] * p1 + w2[j] * g[j] + bb[j];
                        a4[j] = pre * __builtin_amdgcn_rcpf(1.0f + __builtin_amdgcn_exp2f(-1.4426950408889634f * pre)) * uu[j];
                    }
                    r1p = r1; r2p = r2;
                    u32x2v w; w.x = cvt_pk_bf16(a4[0], a4[1]); w.y = cvt_pk_bf16(a4[2], a4[3]);
                    *(u32x2v*)(ACT + (size_t)(row0 + ai * HALF + m * 16) * ldc + col0 + 4 * n) = w;
                    asm volatile("" ::: "memory");
                }
            }
        }
    }
};
struct EpiInProj {
    static constexpr bool PERM = true, AFTER_DRAIN = false;
    bf16_t* ZC; bf16_t* Q; bf16_t* Kk; bf16_t* V; const float* gq; const float* gk; float qscale; float eps;
    __device__ __forceinline__ void operator()(const f32x4 (&acc)[2][2][4][2], const Unit& u, int wr, int wc, int fr, int fq) const {
        if (u.pn < 6) {
            const int row0 = u.pm * BM + wr * 64 + fr, col0 = u.pn * BM + wc * 32 + 8 * fq;
#pragma unroll
            for (int ai = 0; ai < 2; ++ai)
#pragma unroll
                for (int m = 0; m < 4; ++m) { bf16_t* rowp = ZC + (size_t)(row0 + ai * HALF + m * 16) * 1536 + col0;
#pragma unroll
                    for (int bj = 0; bj < 2; ++bj) *(u32x4*)(rowp + bj * HALF) = pack8(acc[ai][bj][m][0], acc[ai][bj][m][1]); }
        } else {
            const int sec = u.pn - 6, which = sec >> 1, head = 4 * (sec & 1) + wc;
            if (which < 2) {
                bf16_t* base = which == 0 ? Q : Kk;
                const float* g = which == 0 ? gq : gk;
                const float sc = which == 0 ? qscale : 1.f;
                const f32x4 g00 = *(const f32x4*)(g + 8 * fq), g01 = *(const f32x4*)(g + 8 * fq + 4), g10 = *(const f32x4*)(g + 32 + 8 * fq), g11 = *(const f32x4*)(g + 32 + 8 * fq + 4);
#pragma unroll
                for (int ai = 0; ai < 2; ++ai)
#pragma unroll
                    for (int m = 0; m < 4; ++m) {
                        const int row = u.pm * BM + ai * HALF + wr * 64 + m * 16 + fr, b = row >> 13, t = row & 8191;
                        float ss = 0.f;
#pragma unroll
                        for (int bj = 0; bj < 2; ++bj)
#pragma unroll
                            for (int n = 0; n < 2; ++n) { const f32x4 x = acc[ai][bj][m][n]; ss += (x[0] * x[0] + x[1] * x[1]) + (x[2] * x[2] + x[3] * x[3]); }
                        ss += __shfl_xor(ss, 16); ss += __shfl_xor(ss, 32);
                        const float rs = sc * __builtin_amdgcn_rsqf(ss * (1.0f / 64.0f) + eps);
                        bf16_t* dst = base + ((size_t)((b * 8 + head) * 8192 + t)) * 64 + 8 * fq;
                        *(u32x4*)(dst) = pack8(acc[ai][0][m][0] * rs * g00, acc[ai][0][m][1] * rs * g01);
                        *(u32x4*)(dst + 32) = pack8(acc[ai][1][m][0] * rs * g10, acc[ai][1][m][1] * rs * g11);
                    }
            } else {
#pragma unroll
                for (int ai = 0; ai < 2; ++ai)
#pragma unroll
                    for (int m = 0; m < 4; ++m) {
                        const int row = u.pm * BM + ai * HALF + wr * 64 + m * 16 + fr, b = row >> 13, t = row & 8191;
                        bf16_t* dst = V + ((size_t)((b * 8 + head) * 8192 + t)) * 64 + 8 * fq;
                        *(u32x4*)(dst) = pack8(acc[ai][0][m][0], acc[ai][0][m][1]);
                        *(u32x4*)(dst + 32) = pack8(acc[ai][1][m][0], acc[ai][1][m][1]);
                    }
            }
        }
    }
};
template <bool BASE_BF16> struct EpiResNorm {
    static constexpr bool PERM = true, AFTER_DRAIN = false;
    const void* base; bf16_t* XB; float* SS; int ldc; PG8_LAS float* red;
    __device__ __forceinline__ void operator()(const f32x4 (&acc)[2][2][4][2], const Unit& u, int wr, int wc, int fr, int fq) const {
        const int row0 = u.pm * BM + wr * 64 + fr, col0 = u.pn * BM + wc * 32 + 8 * fq;
        constexpr int NB = BASE_BF16 ? 1 : 2, GPB = 8 / NB;
#pragma unroll
        for (int bt = 0; bt < NB; ++bt) {
            u32x4 pb[GPB][2]; f32x4 pf[BASE_BF16 ? 1 : GPB][2][2];
#pragma unroll
            for (int gi = 0; gi < GPB; ++gi) { const int g8 = bt * GPB + gi, ai = g8 >> 2, m = g8 & 3; const size_t off = (size_t)(row0 + ai * HALF + m * 16) * ldc + col0;
#pragma unroll
                for (int bj = 0; bj < 2; ++bj) {
                    if constexpr (BASE_BF16) pb[gi][bj] = *(const u32x4*)((const bf16_t*)base + off + bj * HALF);
                    else { pf[gi][bj][0] = *(const f32x4*)((const float*)base + off + bj * HALF); pf[gi][bj][1] = *(const f32x4*)((const float*)base + off + bj * HALF + 4); } } }
#pragma unroll
            for (int gi = 0; gi < GPB; ++gi) { const int g8 = bt * GPB + gi, ai = g8 >> 2, m = g8 & 3; const int row = row0 + ai * HALF + m * 16; const size_t off = (size_t)row * ldc + col0; float ss = 0.f;
#pragma unroll
                for (int bj = 0; bj < 2; ++bj) {
                    f32x4 b0, b1;
                    if constexpr (BASE_BF16) { const u32x4 w = pb[gi][bj];
                        b0[0] = __builtin_bit_cast(float, w.x << 16); b0[1] = __builtin_bit_cast(float, w.x & 0xffff0000u); b0[2] = __builtin_bit_cast(float, w.y << 16); b0[3] = __builtin_bit_cast(float, w.y & 0xffff0000u);
                        b1[0] = __builtin_bit_cast(float, w.z << 16); b1[1] = __builtin_bit_cast(float, w.z & 0xffff0000u); b1[2] = __builtin_bit_cast(float, w.w << 16); b1[3] = __builtin_bit_cast(float, w.w & 0xffff0000u); }
                    else { b0 = pf[gi][bj][0]; b1 = pf[gi][bj][1]; }
                    const f32x4 x0 = b0 + acc[ai][bj][m][0], x1 = b1 + acc[ai][bj][m][1];
                    *(u32x4*)(XB + off + bj * HALF) = pack8(x0, x1);
                    ss += ((x0[0] * x0[0] + x0[1] * x0[1]) + (x0[2] * x0[2] + x0[3] * x0[3])) + ((x1[0] * x1[0] + x1[1] * x1[1]) + (x1[2] * x1[2] + x1[3] * x1[3]));
                }
                ss += __shfl_xor(ss, 16); ss += __shfl_xor(ss, 32);
                if (fq == 0) red[(ai * HALF + wr * 64 + m * 16 + fr) * 4 + wc] = ss; }
            asm volatile("" ::: "memory");
        }
        asm volatile("s_waitcnt lgkmcnt(0)" ::: "memory"); __builtin_amdgcn_s_barrier(); asm volatile("" ::: "memory");
        { const int t = threadIdx.x; if (t < 256) { const f32x4 v = *(const PG8_LAS f32x4*)(red + t * 4); SS[(size_t)(u.pm * BM + t) * 4 + u.pn] = (v[0] + v[1]) + (v[2] + v[3]); } }
        asm volatile("s_waitcnt lgkmcnt(0)" ::: "memory"); __builtin_amdgcn_s_barrier(); asm volatile("" ::: "memory");
    }
};
struct EpiPle {
    static constexpr bool PERM = true, AFTER_DRAIN = false;
    const bf16_t* xb; float* out; const bf16_t* pp; int ldc; const float* SS; float eps;
    __device__ __forceinline__ void operator()(const f32x4 (&acc)[2][2][4][2], const Unit& u, int wr, int wc, int fr, int fq) const {
        const int row0 = u.pm * BM + wr * 64 + fr, col0 = u.pn * BM + wc * 32 + 8 * fq;
        float rsv[8];
        {
            f32x4 sp[8];
#pragma unroll
            for (int g8 = 0; g8 < 8; ++g8) sp[g8] = *(const f32x4*)(SS + (size_t)(row0 + (g8 >> 2) * HALF + (g8 & 3) * 16) * 4);
#pragma unroll
            for (int g8 = 0; g8 < 8; ++g8) rsv[g8] = -1.4426950408889634f * rstd4(sp[g8], eps);
        }
        asm volatile("" ::: "memory");
#pragma unroll
        for (int bt = 0; bt < 4; ++bt) {
            u32x4 bw[2][2], pw[2][2];
#pragma unroll
            for (int gi = 0; gi < 2; ++gi) { const int g8 = bt * 2 + gi; const size_t off = (size_t)(row0 + (g8 >> 2) * HALF + (g8 & 3) * 16) * ldc + col0;
#pragma unroll
                for (int bj = 0; bj < 2; ++bj) { bw[gi][bj] = *(const u32x4*)(xb + off + bj * HALF); pw[gi][bj] = *(const u32x4*)(pp + off + bj * HALF); } }
#pragma unroll
            for (int gi = 0; gi < 2; ++gi) { const int g8 = bt * 2 + gi, ai = g8 >> 2, m = g8 & 3; const size_t off = (size_t)(row0 + ai * HALF + m * 16) * ldc + col0; const float rs = rsv[g8];
#pragma unroll
                for (int bj = 0; bj < 2; ++bj) { const size_t o2 = off + bj * HALF;
                    const unsigned bws[4] = {bw[gi][bj].x, bw[gi][bj].y, bw[gi][bj].z, bw[gi][bj].w}, pws[4] = {pw[gi][bj].x, pw[gi][bj].y, pw[gi][bj].z, pw[gi][bj].w};
                    f32x4 o[2];
#pragma unroll
                    for (int n = 0; n < 2; ++n)
#pragma unroll
                        for (int e = 0; e < 4; ++e) { const unsigned bb = bws[2 * n + (e >> 1)], pq = pws[2 * n + (e >> 1)];
                            const float bv = (e & 1) ? __builtin_bit_cast(float, bb & 0xffff0000u) : __builtin_bit_cast(float, bb << 16), pv = (e & 1) ? __builtin_bit_cast(float, pq & 0xffff0000u) : __builtin_bit_cast(float, pq << 16);
                            const float sg = __builtin_amdgcn_rcpf(1.0f + __builtin_amdgcn_exp2f(rs * acc[ai][bj][m][n][e])); o[n][e] = bv + sg * pv; }
                    *(f32x4*)(out + o2) = o[0]; *(f32x4*)(out + o2 + 4) = o[1]; } }
            asm volatile("" ::: "memory");
        }
    }
};

template <class Epi, class Sched, bool ALIGN_EPI = false, bool SP2 = false>
__device__ __forceinline__ void gemm_phase(PG8_LAS unsigned char* lds, const Gemm g, const Sched& S, const Epi& E) {
    int tid_ = threadIdx.x; asm volatile("" : "+v"(tid_));
    const int tid = tid_, wid = __builtin_amdgcn_readfirstlane(tid >> 6), lane = tid & 63, wr = wid >> 2, wc = wid & 3, fr = lane & 15, fq = lane >> 4;
    const int K = g.K, nt = K / BK;
    unsigned voffA[2], voffB[2];
#pragma unroll
    for (int i = 0; i < 2; ++i) { int R, C; stage_rc(tid * 16 + i * 8192, R, C); const int Rb = Epi::PERM ? ((R & ~31) + perm32(R & 31)) : R;
        voffA[i] = (unsigned)(R * K + C) * 2u; voffB[i] = (unsigned)(Rb * K + C) * 2u; }
    const size_t kstep = (size_t)(BK * 2);
    const size_t hstep = (size_t)HALF * K * 2;
    const size_t tstep = 2 * hstep;
    const unsigned ldsw = (unsigned)wid * 1024u;
    const int aoff = lds_byte(wr * 64 + fr, fq * 8), boff = lds_byte(wc * 32 + fr, fq * 8);
#define PG8_SA(b, h) (((b) * 2 + (h)) * HTB)
#define PG8_SB(b, h) ((4 + (b) * 2 + (h)) * HTB)
#define PG8_STAGE(bufoff, gbase, voff) do { _Pragma("unroll") for (int _i = 0; _i < 2; ++_i) \
        __builtin_amdgcn_global_load_lds((const unsigned*)((const char*)(gbase) + (voff)[_i]), (PG8_LAS unsigned*)(lds + (bufoff) + ldsw + _i * 8192), 16, 0, 0); } while (0)
#define PG8_LDA(dst, b, h) do { _Pragma("unroll") for (int m = 0; m < 4; ++m) _Pragma("unroll") for (int k = 0; k < 2; ++k) dst[m][k] = *(const PG8_LAS bf16x8*)(lds + PG8_SA(b, h) + aoff + m * 2048 + k * 1024); } while (0)
#define PG8_LDB(dst, b, h) do { _Pragma("unroll") for (int n = 0; n < 2; ++n) _Pragma("unroll") for (int k = 0; k < 2; ++k) dst[n][k] = *(const PG8_LAS bf16x8*)(lds + PG8_SB(b, h) + boff + n * 2048 + k * 1024); } while (0)
#ifndef PG8_PRIO
#define PG8_PRIO 1
#endif
#define PG8_MMA(ai, bj, At, Bt) do { if (PG8_PRIO) __builtin_amdgcn_s_setprio(1); _Pragma("unroll") for (int m = 0; m < 4; ++m) _Pragma("unroll") for (int n = 0; n < 2; ++n) _Pragma("unroll") for (int k = 0; k < 2; ++k) \
        acc[ai][bj][m][n] = __builtin_amdgcn_mfma_f32_16x16x32_bf16(Bt[n][k], At[m][k], acc[ai][bj][m][n], 0, 0, 0); if (PG8_PRIO) __builtin_amdgcn_s_setprio(0); } while (0)
#define PG8_WAIT_V(n) asm volatile("s_waitcnt vmcnt(" #n ")" ::: "memory")
#define PG8_WAIT_L(n) asm volatile("s_waitcnt lgkmcnt(" #n ")" ::: "memory")
#define PG8_BAR __builtin_amdgcn_s_barrier()
#define PG8_SCHED __builtin_amdgcn_sched_barrier(0)
    Unit cur, nxt; int ui = 0;
    if (!S.next(0, cur)) return;
    f32x4 acc[2][2][4][2];
#pragma unroll
    for (int a = 0; a < 2; ++a)
#pragma unroll
        for (int b = 0; b < 2; ++b)
#pragma unroll
            for (int m = 0; m < 4; ++m)
#pragma unroll
                for (int n = 0; n < 2; ++n) acc[a][b][m][n] = (f32x4){0.f, 0.f, 0.f, 0.f};
    bf16x8 At[4][2], B0[2][2], B1[2][2];
    const char* cA = (const char*)g.A + (size_t)cur.pm * tstep; const char* cB = (const char*)g.Bt + (size_t)cur.pn * tstep;
    S.a_ready(cur);
    if constexpr (SP2) {
        PG8_STAGE(PG8_SB(0, 0), cB, voffB); PG8_STAGE(PG8_SB(0, 1), cB + hstep, voffB); PG8_STAGE(PG8_SA(0, 0), cA, voffA); PG8_STAGE(PG8_SA(0, 1), cA + hstep, voffA);
        if (wr == 1) PG8_BAR;
        PG8_WAIT_V(2); PG8_BAR;
        PG8_STAGE(PG8_SB(1, 0), cB + kstep, voffB); PG8_STAGE(PG8_SA(1, 0), cA + kstep, voffA); PG8_STAGE(PG8_SB(1, 1), cB + hstep + kstep, voffB);
        PG8_WAIT_V(6); PG8_BAR;
    } else {
        PG8_STAGE(PG8_SB(0, 0), cB, voffB); PG8_STAGE(PG8_SA(0, 0), cA, voffA); PG8_STAGE(PG8_SB(0, 1), cB + hstep, voffB); PG8_STAGE(PG8_SA(0, 1), cA + hstep, voffA);
        if (wr == 1) PG8_BAR;
        PG8_WAIT_V(4); PG8_BAR;
        PG8_STAGE(PG8_SB(1, 0), cB + kstep, voffB); PG8_STAGE(PG8_SA(1, 0), cA + kstep, voffA); PG8_STAGE(PG8_SB(1, 1), cB + hstep + kstep, voffB);
        PG8_WAIT_V(6); PG8_BAR;
    }
    for (;;) {
        const bool has_next = S.next(ui + 1, nxt);
        const char* nA = has_next ? (const char*)g.A + (size_t)nxt.pm * tstep : cA; const char* nB = has_next ? (const char*)g.Bt + (size_t)nxt.pn * tstep : cB;
        for (int t = 0; t < nt; t += 2) {
            const bool last = (t == nt - 2);
            const char* a1 = cA + (size_t)(t + 1) * kstep;
            const char* a2 = last ? nA : cA + (size_t)(t + 2) * kstep; const char* b2 = last ? nB : cB + (size_t)(t + 2) * kstep;
            const char* a3 = a2 + kstep; const char* b3 = b2 + kstep;
            if (last && has_next) S.a_ready(nxt);
            if constexpr (SP2) {
            PG8_LDB(B0, 0, 0); PG8_LDB(B1, 0, 1); PG8_SCHED; PG8_LDA(At, 0, 0); PG8_STAGE(PG8_SA(1, 1), a1 + hstep, voffA);
            PG8_WAIT_V(8); PG8_WAIT_L(0); PG8_BAR; PG8_MMA(0, 0, At, B0); PG8_MMA(0, 1, At, B1); PG8_BAR; PG8_SCHED;
            PG8_LDA(At, 0, 1); PG8_STAGE(PG8_SB(0, 0), b2, voffB); PG8_STAGE(PG8_SB(0, 1), b2 + hstep, voffB); PG8_STAGE(PG8_SA(0, 0), a2, voffA);
            PG8_WAIT_V(8); PG8_WAIT_L(0); PG8_BAR; PG8_MMA(1, 0, At, B0); PG8_MMA(1, 1, At, B1); PG8_BAR; PG8_SCHED;
            PG8_LDB(B0, 1, 0); PG8_LDB(B1, 1, 1); PG8_SCHED; PG8_LDA(At, 1, 0); PG8_STAGE(PG8_SA(0, 1), a2 + hstep, voffA);
            PG8_WAIT_V(8); PG8_WAIT_L(0); PG8_BAR; PG8_MMA(0, 0, At, B0); PG8_MMA(0, 1, At, B1); PG8_BAR; PG8_SCHED;
            PG8_LDA(At, 1, 1); PG8_STAGE(PG8_SB(1, 0), b3, voffB); PG8_STAGE(PG8_SB(1, 1), b3 + hstep, voffB); PG8_STAGE(PG8_SA(1, 0), a3, voffA);
            PG8_WAIT_V(8); PG8_WAIT_L(0); PG8_BAR; PG8_MMA(1, 0, At, B0); PG8_MMA(1, 1, At, B1); PG8_BAR; PG8_SCHED;
            } else {
            PG8_LDB(B0, 0, 0); PG8_SCHED; PG8_LDA(At, 0, 0); PG8_STAGE(PG8_SA(1, 1), a1 + hstep, voffA);
            PG8_WAIT_L(8); PG8_BAR; PG8_WAIT_L(0); PG8_MMA(0, 0, At, B0); PG8_BAR; PG8_SCHED;
            PG8_LDB(B1, 0, 1); PG8_STAGE(PG8_SB(0, 0), b2, voffB);
            PG8_BAR; PG8_WAIT_L(0); PG8_MMA(0, 1, At, B1); PG8_BAR;
            PG8_LDA(At, 0, 1); PG8_STAGE(PG8_SA(0, 0), a2, voffA);
            PG8_BAR; PG8_WAIT_L(0); PG8_MMA(1, 0, At, B0); PG8_BAR; PG8_SCHED;
            PG8_STAGE(PG8_SB(0, 1), b2 + hstep, voffB);
            PG8_WAIT_V(6); PG8_BAR; PG8_MMA(1, 1, At, B1); PG8_BAR;
            PG8_LDB(B0, 1, 0); PG8_SCHED; PG8_LDA(At, 1, 0); PG8_STAGE(PG8_SA(0, 1), a2 + hstep, voffA);
            PG8_WAIT_L(8); PG8_BAR; PG8_WAIT_L(0); PG8_MMA(0, 0, At, B0); PG8_BAR; PG8_SCHED;
            PG8_LDB(B1, 1, 1); PG8_STAGE(PG8_SB(1, 0), b3, voffB);
            PG8_BAR; PG8_WAIT_L(0); PG8_MMA(0, 1, At, B1); PG8_BAR;
            PG8_LDA(At, 1, 1); PG8_STAGE(PG8_SA(1, 0), a3, voffA);
            PG8_BAR; PG8_WAIT_L(0); PG8_MMA(1, 0, At, B0); PG8_BAR; PG8_SCHED;
            PG8_STAGE(PG8_SB(1, 1), b3 + hstep, voffB);
            PG8_WAIT_V(6); PG8_BAR; PG8_MMA(1, 1, At, B1); PG8_BAR;
            }
        }
        if constexpr (ALIGN_EPI) { if (wr == 0) PG8_BAR; }
#ifdef PROBE_EPI
        unsigned long long te0_ = 0; if (g.tacc) te0_ = __builtin_amdgcn_s_memrealtime();
#endif
        if constexpr (!Epi::AFTER_DRAIN) { E(acc, cur, wr, wc, fr, fq); S.done(cur); }
#ifdef PROBE_EPI
        if (g.tacc && blockIdx.x == 0 && tid == 0) { *g.tacc += (unsigned)(__builtin_amdgcn_s_memrealtime() - te0_); }
#endif
        if (!has_next) break;
#pragma unroll
        for (int a = 0; a < 2; ++a)
#pragma unroll
            for (int b = 0; b < 2; ++b)
#pragma unroll
                for (int m = 0; m < 4; ++m)
#pragma unroll
                    for (int n = 0; n < 2; ++n) acc[a][b][m][n] = (f32x4){0.f, 0.f, 0.f, 0.f};
        cur = nxt; cA = nA; cB = nB; ++ui;
        if constexpr (ALIGN_EPI) { if (wr == 1) PG8_BAR; }
    }
    PG8_WAIT_V(0);
    if constexpr (!ALIGN_EPI) { if (wr == 0) PG8_BAR; }
    PG8_BAR;
    if constexpr (Epi::AFTER_DRAIN) { E.fused(acc, cur, wr, wc, fr, fq, lds, wid, lane); S.done(cur); }
#undef PG8_SA
#undef PG8_SB
#undef PG8_STAGE
#undef PG8_LDA
#undef PG8_LDB
#undef PG8_MMA
#undef PG8_WAIT_V
#undef PG8_WAIT_L
#undef PG8_BAR
#undef PG8_SCHED
}
}
#define GAS __attribute__((address_space(1)))
#define LAS __attribute__((address_space(3)))
typedef unsigned short bf16;
typedef unsigned v4u __attribute__((ext_vector_type(4)));
typedef float f32x4 __attribute__((ext_vector_type(4)));
typedef short bf16x8 __attribute__((ext_vector_type(8)));
typedef GAS unsigned gu32;
typedef GAS unsigned long long gu64;
#define RLX_AGENT __ATOMIC_RELAXED, __HIP_MEMORY_SCOPE_AGENT
#define LDS_WAIT() asm volatile("s_waitcnt lgkmcnt(0)" ::: "memory")
#define VM_WAIT() asm volatile("s_waitcnt vmcnt(0)" ::: "memory")
__device__ __forceinline__ unsigned long long rt() { return __builtin_amdgcn_s_memrealtime(); }
__device__ __forceinline__ unsigned f2bf(float f) { unsigned u = __builtin_bit_cast(unsigned, f); return (u + 0x7fffu + ((u >> 16) & 1u)) >> 16; }
__device__ __forceinline__ unsigned pk2(float lo, float hi) { return f2bf(lo) | (f2bf(hi) << 16); }

#define XB_TMO      128
#define XB_XCNT(j)  (256  + 64 * (j))
#define XB_XSUB(j)  (1280 + 64 * (j))
#define XB_XGEN(j)  (2304 + 64 * (j))
#define XB_TOP      3328
#define XB_TOPGEN   3392
#define XCD_BAR_WORDS 3456
#define XB_SPIN_CAP (1u << 18)

__device__ __forceinline__ unsigned xb_ld(unsigned* p)              { return __hip_atomic_load(p, __ATOMIC_RELAXED, __HIP_MEMORY_SCOPE_AGENT); }
__device__ __forceinline__ unsigned xb_add(unsigned* p, unsigned v) { return __hip_atomic_fetch_add(p, v, __ATOMIC_RELAXED, __HIP_MEMORY_SCOPE_AGENT); }
__device__ __forceinline__ unsigned xb_xcc_id() { return (unsigned)__builtin_amdgcn_s_getreg((3 << 11) | 20) & 0xFu; }
#define XB_SPIN(cond, bar) do { unsigned _sp = 0; while (cond) { __builtin_amdgcn_s_sleep(1); \
    if ((++_sp & 255u) == 0u) { if (xb_ld(&(bar)[XB_TMO])) break; if (_sp > XB_SPIN_CAP) { atomicAdd(&(bar)[XB_TMO], 1u); break; } } } } while (0)

struct XcdBarrier {
    unsigned* bar; unsigned x;
    volatile LAS unsigned* st;
};

__device__ __forceinline__ XcdBarrier xcd_barrier_post(unsigned* bar, volatile LAS unsigned* st) {
    XcdBarrier b; b.bar = bar; b.x = xb_xcc_id(); b.st = st;
    if (threadIdx.x == 0) (void)xb_add(&bar[XB_XCNT(b.x)], 1u);
    return b;
}
__device__ __forceinline__ void xcd_barrier_complete(unsigned* bar, unsigned x, unsigned& nloc, unsigned& nx) {
    const unsigned G = gridDim.x * gridDim.y * gridDim.z;
    unsigned sum, cnt, mine, sp = 0u;
    for (;;) {
        sum = 0u; cnt = 0u; mine = 0u;
#pragma unroll
        for (unsigned j = 0; j < 16; ++j) { const unsigned c = xb_ld(&bar[XB_XCNT(j)]); sum += c; cnt += (c > 0u) ? 1u : 0u; mine = (j == x) ? c : mine; }
        if (sum == G) break;
        __builtin_amdgcn_s_sleep(1);
        if ((++sp & 255u) == 0u) { if (xb_ld(&bar[XB_TMO])) break; if (sp > XB_SPIN_CAP) { atomicAdd(&bar[XB_TMO], 1u); break; } }
    }
    nloc = mine > 0u ? mine : 1u; nx = cnt > 0u ? cnt : 1u;
}

__device__ __forceinline__ void xcd_barrier(const XcdBarrier& b) {
    asm volatile("s_waitcnt vmcnt(0)" ::: "memory");
    __syncthreads();
    if (threadIdx.x == 0) {
        unsigned* bar = b.bar;
        __builtin_amdgcn_s_waitcnt(0);
        unsigned nloc = b.st[0], nx = b.st[1];
        if (nloc == 0u) { xcd_barrier_complete(bar, b.x, nloc, nx); b.st[0] = nloc; b.st[1] = nx; }
        const unsigned old = xb_add(&bar[XB_XSUB(b.x)], 1u);
        const unsigned gen = old / nloc;
        if (old + 1u == (gen + 1u) * nloc) {
            __builtin_amdgcn_fence(__ATOMIC_RELEASE, "agent");
            asm volatile("s_waitcnt vmcnt(0)" ::: "memory");
            const unsigned og = xb_add(&bar[XB_TOP], 1u);
            const unsigned tg = og / nx;
            if (og + 1u == (tg + 1u) * nx) xb_add(&bar[XB_TOPGEN], 1u);
            else XB_SPIN(xb_ld(&bar[XB_TOPGEN]) == tg, bar);
            __builtin_amdgcn_fence(__ATOMIC_ACQUIRE, "agent");
            xb_add(&bar[XB_XGEN(b.x)], 1u);
            asm volatile("s_waitcnt vmcnt(0)" ::: "memory");
        } else {
            XB_SPIN(xb_ld(&bar[XB_XGEN(b.x)]) == gen, bar);
            __builtin_amdgcn_fence(__ATOMIC_ACQUIRE, "agent");
            asm volatile("s_waitcnt vmcnt(0)" ::: "memory");
        }
    }
    __syncthreads();
}

constexpr int NWAVES = 8;
constexpr int BATCH = 4, SEQ = 8192, DM = 1024, MROWS = BATCH * SEQ, CONVW = 512, NHEAD = 8, HD = 64, ATTW = 512, INCOLS = 3072, DFF = 2816, PLED = 256;
constexpr float EPS = 1e-6f;
constexpr float LOG2E = 1.4426950408889634f;
constexpr size_t MiB = 1u << 20;
constexpr size_t WS_CTL = 0, CTL_ZERO_BYTES = 1 * MiB;
constexpr size_t WS_WIN = 2 * MiB, WS_WOUT = 8 * MiB, WS_WGU = 10 * MiB, WS_WDN = 21 * MiB, WS_WPG = 27 * MiB, WS_WPP = 29 * MiB;
constexpr size_t WS_H = 32 * MiB;
constexpr size_t WS_PB = 96 * MiB;
constexpr size_t WS_ZC = 112 * MiB;
constexpr size_t WS_Q = 208 * MiB, WS_K = 240 * MiB, WS_V = 272 * MiB;
constexpr size_t WS_OP = 304 * MiB;
constexpr size_t WS_LP = 400 * MiB;
constexpr size_t WS_Y = 404 * MiB;
constexpr size_t WS_U = 112 * MiB;
constexpr size_t WS_TOPG = 288 * MiB, WS_BOTG = 291 * MiB, WS_TOPU = 294 * MiB;
constexpr size_t WS_PP = 300 * MiB;
constexpr size_t WS_SS = 30 * MiB;
constexpr size_t WS_X2 = 364 * MiB;
constexpr size_t WS_END = 468 * MiB;
constexpr int CW_BAR = 4096;
constexpr int CW_Q0 = 64;
constexpr int RING_BYTES = 131072, LDSCTL_OFF = RING_BYTES, MISC_OFF = LDSCTL_OFF + 320, XCH_OFF = RING_BYTES + 4096  , LDS_BYTES = 147456;

__device__ __forceinline__ float wave_sum(float v) {
#pragma unroll
    for (int o = 1; o < 64; o <<= 1) v += __shfl_xor(v, o);
    return v;
}
__device__ __forceinline__ float wave_max(float v) {
#pragma unroll
    for (int o = 1; o < 64; o <<= 1) v = fmaxf(v, __shfl_xor(v, o));
    return v;
}
__device__ __forceinline__ unsigned cvtpk(float lo, float hi) { unsigned r; asm volatile("v_cvt_pk_bf16_f32 %0, %1, %2" : "=v"(r) : "v"(lo), "v"(hi)); return r; }
__device__ __forceinline__ float bflo(unsigned w) { return __builtin_bit_cast(float, w << 16); }
__device__ __forceinline__ float bfhi(unsigned w) { return __builtin_bit_cast(float, w & 0xffff0000u); }
__device__ __forceinline__ void unpack8(const v4u w, float (&f)[8]) { f[0] = bflo(w.x); f[1] = bfhi(w.x); f[2] = bflo(w.y); f[3] = bfhi(w.y); f[4] = bflo(w.z); f[5] = bfhi(w.z); f[6] = bflo(w.w); f[7] = bfhi(w.w); }
__device__ __forceinline__ v4u pack8f(const float (&f)[8]) { v4u w; w.x = cvtpk(f[0], f[1]); w.y = cvtpk(f[2], f[3]); w.z = cvtpk(f[4], f[5]); w.w = cvtpk(f[6], f[7]); return w; }
__device__ __forceinline__ void load8f(const float* p, float (&f)[8]) { const f32x4 a = *(const f32x4*)p, b = *(const f32x4*)(p + 4); f[0] = a[0]; f[1] = a[1]; f[2] = a[2]; f[3] = a[3]; f[4] = b[0]; f[5] = b[1]; f[6] = b[2]; f[7] = b[3]; }

__device__ __forceinline__ void p0_transpose_item(const float* W, int K, int N, bf16* WT, int drow0, LAS float* scr, int k0, int n0, int lane, const float* gain = nullptr) {
    f32x4 w[8]; float gk[8];
#pragma unroll
    for (int i = 0; i < 8; ++i) { const int kk = 8 * i + (lane >> 3); w[i] = *(const GAS f32x4*)(W + (size_t)(k0 + kk) * N + n0 + 4 * (lane & 7)); gk[i] = gain ? gain[k0 + kk] : 1.0f; }
#pragma unroll
    for (int i = 0; i < 8; ++i) { const int kk = 8 * i + (lane >> 3); LAS float* d = scr + kk * 33 + 4 * (lane & 7); d[0] = w[i].x * gk[i]; d[1] = w[i].y * gk[i]; d[2] = w[i].z * gk[i]; d[3] = w[i].w * gk[i]; }
    LDS_WAIT(); asm volatile("" ::: "memory");
    const int c = lane & 7;
#pragma unroll
    for (int j = 0; j < 4; ++j) { const int n = (lane >> 3) + 8 * j; const LAS float* s = scr + (8 * c) * 33 + n;
        v4u o; o.x = cvtpk(s[0 * 33], s[1 * 33]); o.y = cvtpk(s[2 * 33], s[3 * 33]); o.z = cvtpk(s[4 * 33], s[5 * 33]); o.w = cvtpk(s[6 * 33], s[7 * 33]);
        *(GAS v4u*)(WT + (size_t)(drow0 + n) * K + k0 + 8 * c) = o; }
    LDS_WAIT(); asm volatile("" ::: "memory");
}
__device__ __forceinline__ int map_in_row(int n0) {
    if (n0 < 1536) return n0;
    const int w = n0 - 1536, sec = w >> 8, within = w & 255, hl = within >> 6, dim = within & 63;
    return 1536 + 256 * sec + 128 * (dim >> 5) + 32 * hl + (dim & 31);
}
__device__ __forceinline__ void rms_row(const float* srow, const float* g, bf16* drow, int lane) {
    const GAS f32x4* xr = (const GAS f32x4*)srow + lane;
    f32x4 v[4]; float s = 0.f;
#pragma unroll
    for (int j = 0; j < 4; ++j) { v[j] = xr[64 * j]; s += (v[j].x * v[j].x + v[j].y * v[j].y) + (v[j].z * v[j].z + v[j].w * v[j].w); }
    const float rstd = __builtin_amdgcn_rsqf(wave_sum(s) * (1.f / DM) + EPS);
    GAS unsigned long long* o8 = (GAS unsigned long long*)drow + lane;
#pragma unroll
    for (int j = 0; j < 4; ++j) { const f32x4 gg = ((const GAS f32x4*)g)[lane + 64 * j];
        o8[64 * j] = (unsigned long long)cvtpk(v[j].x * rstd * gg.x, v[j].y * rstd * gg.y) | ((unsigned long long)cvtpk(v[j].z * rstd * gg.z, v[j].w * rstd * gg.w) << 32); }
}
__device__ __forceinline__ void rms_rows(const float* src, const float* g, bf16* dst, int gw, int NGW, int lane) {
    f32x4 gg[4];
#pragma unroll
    for (int j = 0; j < 4; ++j) gg[j] = ((const GAS f32x4*)g)[lane + 64 * j];
    for (int m = gw * 4; m < MROWS; m += NGW * 4) {
        f32x4 v[4][4]; float s[4];
#pragma unroll
        for (int r = 0; r < 4; ++r)
#pragma unroll
            for (int j = 0; j < 4; ++j) v[r][j] = ((const GAS f32x4*)(src + (size_t)(m + r) * DM))[lane + 64 * j];
#pragma unroll
        for (int r = 0; r < 4; ++r) { s[r] = 0.f;
#pragma unroll
            for (int j = 0; j < 4; ++j) s[r] += (v[r][j].x * v[r][j].x + v[r][j].y * v[r][j].y) + (v[r][j].z * v[r][j].z + v[r][j].w * v[r][j].w); }
#pragma unroll
        for (int o = 1; o < 64; o <<= 1) {
#pragma unroll
            for (int r = 0; r < 4; ++r) s[r] += __shfl_xor(s[r], o); }
#pragma unroll
        for (int r = 0; r < 4; ++r) { const float rstd = __builtin_amdgcn_rsqf(s[r] * (1.f / DM) + EPS);
            GAS unsigned long long* o8 = (GAS unsigned long long*)(dst + (size_t)(m + r) * DM) + lane;
#pragma unroll
            for (int j = 0; j < 4; ++j) o8[64 * j] = (unsigned long long)cvtpk(v[r][j].x * rstd * gg[j].x, v[r][j].y * rstd * gg[j].y) | ((unsigned long long)cvtpk(v[r][j].z * rstd * gg[j].z, v[r][j].w * rstd * gg[j].w) << 32); }
    }
}

namespace att {
typedef float f32x16 __attribute__((ext_vector_type(16)));
typedef short s16x4 __attribute__((ext_vector_type(4)));
typedef short v4i16_t __attribute__((ext_vector_type(4)));
__device__ __forceinline__ constexpr int cr(int r) { return (r & 3) + 8 * (r >> 2); }
__device__ __forceinline__ s16x4 vtr(LAS const unsigned char* p) { return __builtin_bit_cast(s16x4, __builtin_amdgcn_ds_read_tr16_b64_v4i16((LAS v4i16_t*)p)); }

constexpr int K_OFF = 0, V_OFF = 49152, O_OFF = 98304;
struct UnitP { int b, h, d, r, blk, branch; float cb; };
__device__ __forceinline__ UnitP unit_params(int u) {
    UnitP p; const int bh = u / 96, u96 = u % 96, within = u96 & 31; p.branch = u96 >> 5;
    p.d = 1 << (2 * p.branch); const int nblk = 32 >> (2 * p.branch); p.r = within / nblk; p.blk = within % nblk; p.b = bh >> 3; p.h = bh & 7;
    p.cb = __builtin_amdgcn_exp2f(-(float)(p.h + 1)) * (float)p.d * LOG2E; return p;
}
struct Stage { v4u k[6], v[6]; bf16x8 q[4]; };
__device__ __forceinline__ void stage_load(Stage& st, const bf16* Qg, const bf16* Kg, const bf16* Vg, const UnitP& p, int tid, int wave, int lane) {
    const size_t hb = (size_t)(p.b * NHEAD + p.h) * SEQ * HD; const bf16* Kh = Kg + hb; const bf16* Vh = Vg + hb; const bf16* Qh = Qg + hb;
    const int lbase = p.blk * 256 - 128;
#pragma unroll
    for (int it = 0; it < 6; ++it) { const int idx = tid + 512 * it, row = idx >> 3, c = idx & 7; int l = lbase + row; l = l < 0 ? 0 : l;
        const size_t off = (size_t)(p.r + p.d * l) * HD + 8 * c; st.k[it] = *(const GAS v4u*)(Kh + off); st.v[it] = *(const GAS v4u*)(Vh + off); }
    const int pq = p.r + p.d * (p.blk * 256 + 32 * wave + (lane & 31));
#pragma unroll
    for (int s = 0; s < 4; ++s) st.q[s] = *(const GAS bf16x8*)(Qh + (size_t)pq * HD + 16 * s + 8 * (lane >> 5));
}
__device__ __forceinline__ void stage_write(const Stage& st, LAS unsigned char* L, int tid) {
#pragma unroll
    for (int it = 0; it < 6; ++it) { const int idx = tid + 512 * it, row = idx >> 3, c = idx & 7;
        *(LAS v4u*)(L + K_OFF + row * 128 + ((c ^ (row & 7)) << 4)) = st.k[it];
        *(LAS v4u*)(L + V_OFF + ((row >> 4) * 2 + (c >> 2)) * 1024 + (row & 15) * 64 + (c & 3) * 16) = st.v[it]; }
}
__device__ __forceinline__ void compute_tile(LAS unsigned char* L, const bf16x8 (&qf)[4], const UnitP& p, bf16* OPb, float* LPb, float negM, int wave, int lane) {
    const int r32 = lane & 31, hi = lane >> 5;
    const int l0 = p.blk * 256 + 32 * wave, d = p.d, r = p.r; const float cb = p.cb;
    const int pq = r + d * (l0 + r32);
    const int kb0 = l0 >= 128 ? 0 : ((128 - l0) >> 5);
    f32x16 o0, o1;
#pragma unroll
    for (int i = 0; i < 16; ++i) { o0[i] = 0.f; o1[i] = 0.f; }
    float lsum = 0.f;
    const int i4 = r32 - 4 * hi;
    const int laneoff = ((lane >> 4) & 1) * 32 + (lane & 3) * 8 + (4 * hi + ((lane & 15) >> 2)) * 64;
#pragma unroll
    for (int kb = 0; kb < 5; ++kb) if (kb >= kb0) {
        const int row = 32 * (wave + kb) + r32;
        bf16x8 kf[4];
#pragma unroll
        for (int s = 0; s < 4; ++s) kf[s] = *(LAS const bf16x8*)(L + K_OFF + row * 128 + (((2 * s + hi) ^ (row & 7)) << 4));
        const float lt = negM - cb * (float)(128 + r32 - 32 * kb - 4 * hi);
        f32x16 sacc;
#pragma unroll
        for (int i = 0; i < 16; ++i) sacc[i] = __builtin_fmaf(cb, (float)cr(i), lt);
#pragma unroll
        for (int s = 0; s < 4; ++s) sacc = __builtin_amdgcn_mfma_f32_32x32x16_bf16(kf[s], qf[s], sacc, 0, 0, 0);
        float pe[16];
#pragma unroll
        for (int i = 0; i < 16; ++i) pe[i] = __builtin_amdgcn_exp2f(sacc[i]);
        if (kb == 0) {
#pragma unroll
            for (int i = 0; i < 16; ++i) pe[i] = (cr(i) >= i4) ? pe[i] : 0.f;
        }
        if (kb == 4) {
#pragma unroll
            for (int i = 0; i < 16; ++i) pe[i] = (cr(i) <= i4) ? pe[i] : 0.f;
        }
        float ps = 0.f;
#pragma unroll
        for (int i = 0; i < 16; ++i) ps += pe[i];
        lsum += ps;
        v4u pw0, pw1;
        pw0.x = cvtpk(pe[0], pe[1]); pw0.y = cvtpk(pe[2], pe[3]); pw0.z = cvtpk(pe[4], pe[5]); pw0.w = cvtpk(pe[6], pe[7]);
        pw1.x = cvtpk(pe[8], pe[9]); pw1.y = cvtpk(pe[10], pe[11]); pw1.z = cvtpk(pe[12], pe[13]); pw1.w = cvtpk(pe[14], pe[15]);
        const bf16x8 pa0 = __builtin_bit_cast(bf16x8, pw0), pa1 = __builtin_bit_cast(bf16x8, pw1);
        LAS const unsigned char* vb = L + V_OFF + (wave + kb) * 4096 + laneoff;
#pragma unroll
        for (int d0 = 0; d0 < 2; ++d0) {
            const s16x4 a_lo = vtr(vb + d0 * 1024), a_hi = vtr(vb + d0 * 1024 + 512), b_lo = vtr(vb + 2048 + d0 * 1024), b_hi = vtr(vb + 2048 + d0 * 1024 + 512);
            const bf16x8 v0 = (bf16x8){a_lo[0], a_lo[1], a_lo[2], a_lo[3], a_hi[0], a_hi[1], a_hi[2], a_hi[3]};
            const bf16x8 v1 = (bf16x8){b_lo[0], b_lo[1], b_lo[2], b_lo[3], b_hi[0], b_hi[1], b_hi[2], b_hi[3]};
            if (d0 == 0) { o0 = __builtin_amdgcn_mfma_f32_32x32x16_bf16(pa0, v0, o0, 0, 0, 0); o0 = __builtin_amdgcn_mfma_f32_32x32x16_bf16(pa1, v1, o0, 0, 0, 0); }
            else         { o1 = __builtin_amdgcn_mfma_f32_32x32x16_bf16(pa0, v0, o1, 0, 0, 0); o1 = __builtin_amdgcn_mfma_f32_32x32x16_bf16(pa1, v1, o1, 0, 0, 0); }
        }
    }
    lsum += __shfl_xor(lsum, 32);
    if (hi == 0) LPb[(size_t)(p.b * SEQ + pq) * NHEAD + p.h] = lsum;
    LAS unsigned short* stg = (LAS unsigned short*)(L + O_OFF + wave * 4096);
#pragma unroll
    for (int i = 0; i < 16; ++i) { const int q = cr(i) + 4 * hi;
        stg[q * 64 + r32] = (unsigned short)(cvtpk(o0[i], o0[i]) & 0xffffu); stg[q * 64 + 32 + r32] = (unsigned short)(cvtpk(o1[i], o1[i]) & 0xffffu); }
    LDS_WAIT(); asm volatile("" ::: "memory");
#pragma unroll
    for (int it = 0; it < 4; ++it) { const int row = it * 8 + (lane >> 3), ch = lane & 7;
        const v4u v = *(LAS const v4u*)(stg + row * 64 + ch * 8);
        *(GAS v4u*)(OPb + (size_t)(p.b * SEQ + r + d * (l0 + row)) * ATTW + p.h * HD + ch * 8) = v; }
    LDS_WAIT(); asm volatile("" ::: "memory");
}
}

#ifndef DUP_MASK
#define DUP_MASK 0
#endif
#ifndef WGM_P1
#define WGM_P1 4
#endif
#ifndef WGM_P4
#define WGM_P4 4
#endif
#ifndef WGM_P6
#define WGM_P6 4
#endif
#ifndef WGM_P8
#define WGM_P8 4
#endif
#ifndef WGM_P10
#define WGM_P10 4
#endif
#ifndef PROBE_AMP
#define PROBE_AMP 4
#endif
#ifndef PROBE_BLK
#define PROBE_BLK 0
#endif
#ifdef PROBE_EPI
#define PROBE_EPI_SET(n) if ((n) == PROBE_EPI) g.tacc = (unsigned*)(ws_ + WS_CTL) + 8;
#else
#define PROBE_EPI_SET(n)
#endif
#ifndef PG8_SP2
#define PG8_SP2 true
#endif
struct Args { const float* in[20]; float* out; unsigned char* ws; };
enum { I_X = 0, I_P, I_GMIX, I_WIN, I_CONVW, I_CONVB, I_QG, I_KG, I_GOC, I_GOA, I_WOUT, I_GFFN, I_WGATE, I_WUP, I_FCW, I_FCB, I_WDOWN, I_GPLE, I_WPG, I_WPP };

#define PHASE_PTRS KARG_DECL unsigned char* const ws_ = ARG_WS(); float* const out = ARG_OUT(); (void)out; \
    bf16* const WIN = (bf16*)(ws_ + WS_WIN); bf16* const WOUT = (bf16*)(ws_ + WS_WOUT); bf16* const WGU = (bf16*)(ws_ + WS_WGU); bf16* const WDN = (bf16*)(ws_ + WS_WDN); bf16* const WPG = (bf16*)(ws_ + WS_WPG); bf16* const WPP = (bf16*)(ws_ + WS_WPP); \
    bf16* const HB = (bf16*)(ws_ + WS_H); bf16* const PB = (bf16*)(ws_ + WS_PB); bf16* const ZC = (bf16*)(ws_ + WS_ZC); bf16* const QB = (bf16*)(ws_ + WS_Q); bf16* const KB = (bf16*)(ws_ + WS_K); bf16* const VB = (bf16*)(ws_ + WS_V); \
    bf16* const OP = (bf16*)(ws_ + WS_OP); float* const LP = (float*)(ws_ + WS_LP); bf16* const YB = (bf16*)(ws_ + WS_Y); bf16* const UB = (bf16*)(ws_ + WS_U); float* const TOPG = (float*)(ws_ + WS_TOPG); float* const BOTG = (float*)(ws_ + WS_BOTG); float* const TOPU = (float*)(ws_ + WS_TOPU); (void)TOPG; (void)BOTG; (void)TOPU; bf16* const PP = (bf16*)(ws_ + WS_PP); float* const SSB = (float*)(ws_ + WS_SS); (void)SSB; bf16* const X2B = (bf16*)(ws_ + WS_X2); (void)X2B; \
    (void)WIN; (void)WOUT; (void)WGU; (void)WDN; (void)WPG; (void)WPP; (void)HB; (void)PB; (void)ZC; (void)QB; (void)KB; (void)VB; (void)OP; (void)LP; (void)YB; (void)UB; (void)PP;
#define CAS __attribute__((address_space(4)))
#define ARG_IN(i) (*(const float* const CAS*)(ka_ + 8 * (i)))
#define ARG_OUT() (*(float* const CAS*)(ka_ + 8 * 20))
#define ARG_WS() (*(unsigned char* const CAS*)(ka_ + 8 * 21))
#define KARG_DECL const CAS unsigned char* ka_ = (const CAS unsigned char*)__builtin_amdgcn_kernarg_segment_ptr(); asm volatile("" : "+s"(ka_));
__device__ __forceinline__ int wave_pull(unsigned* ctr, int lane) {
    unsigned v = 0u;
    if (lane == 0) v = __hip_atomic_fetch_add(ctr, 1u, __ATOMIC_RELAXED, __HIP_MEMORY_SCOPE_AGENT);
    return (int)__builtin_amdgcn_readfirstlane((int)v);
}
__device__ __forceinline__ void phase_stagger(int g, int ng, unsigned ticks) {
    if (g > 0) { const unsigned long long t0 = __builtin_amdgcn_s_memrealtime(); const unsigned long long wait = (unsigned long long)ticks * (unsigned)g / (unsigned)ng;
        while (__builtin_amdgcn_s_memrealtime() - t0 < wait) __builtin_amdgcn_s_sleep(16); }
}
#ifndef STAG6
#define STAG6 1000
#endif
#ifndef STAG6_NG
#define STAG6_NG 2
#endif
__device__ __forceinline__ void phase0(LAS unsigned char* L, const int lane, const int wave, const int G, const int bx, const int vcu, const int gw, const int NGW) {
    { PHASE_PTRS
    {
        LAS float* scr = (LAS float*)(L + wave * 16384);
        constexpr int I_IN = 16 * 96, I_OUT = 16 * 32, I_GT = 16 * 88, I_DN = 44 * 32, I_PG = 16 * 32, I_PPJ = 4 * 32;
        constexpr int NITEMS = I_IN + I_OUT + 2 * I_GT + I_DN + I_PG + I_PPJ;
        for (int it = gw; it < NITEMS; it += NGW) {
            int r = it;
            if (r < I_IN) { const int kb = r / 96, n0 = 32 * (r % 96); p0_transpose_item(ARG_IN(I_WIN), DM, INCOLS, WIN, map_in_row(n0), scr, 64 * kb, n0, lane); continue; } r -= I_IN;
            if (r < I_OUT) { const int kb = r / 32, n0 = 32 * (r % 32); p0_transpose_item(ARG_IN(I_WOUT), DM, DM, WOUT, n0, scr, 64 * kb, n0, lane); continue; } r -= I_OUT;
            if (r < I_GT) { const int kb = r / 88, n0 = 32 * (r % 88); p0_transpose_item(ARG_IN(I_WGATE), DM, DFF, WGU, 256 * (n0 >> 7) + (n0 & 127), scr, 64 * kb, n0, lane, ARG_IN(I_GFFN)); continue; } r -= I_GT;
            if (r < I_GT) { const int kb = r / 88, n0 = 32 * (r % 88); p0_transpose_item(ARG_IN(I_WUP), DM, DFF, WGU, 256 * (n0 >> 7) + 128 + (n0 & 127), scr, 64 * kb, n0, lane, ARG_IN(I_GFFN)); continue; } r -= I_GT;
            if (r < I_DN) { const int kb = r / 32, n0 = 32 * (r % 32); p0_transpose_item(ARG_IN(I_WDOWN), DFF, DM, WDN, n0, scr, 64 * kb, n0, lane); continue; } r -= I_DN;
            if (r < I_PG) { const int kb = r / 32, n0 = 32 * (r % 32); p0_transpose_item(ARG_IN(I_WPG), DM, DM, WPG, n0, scr, 64 * kb, n0, lane, ARG_IN(I_GPLE)); continue; } r -= I_PG;
            { const int kb = r / 32, n0 = 32 * (r % 32); p0_transpose_item(ARG_IN(I_WPP), PLED, DM, WPP, n0, scr, 64 * kb, n0, lane); }
        }
        rms_rows(ARG_IN(I_X), ARG_IN(I_GMIX), HB, gw, NGW, lane);
        for (int m = gw * 8; m < MROWS; m += NGW * 8) {
            f32x4 v[8];
#pragma unroll
            for (int r = 0; r < 8; ++r) v[r] = ((const GAS f32x4*)(ARG_IN(I_P) + (size_t)(m + r) * PLED))[lane];
#pragma unroll
            for (int r = 0; r < 8; ++r) ((GAS unsigned long long*)(PB + (size_t)(m + r) * PLED))[lane] = (unsigned long long)cvtpk(v[r].x, v[r].y) | ((unsigned long long)cvtpk(v[r].z, v[r].w) << 32);
        }
    }
    }
}
__device__ __forceinline__ void phase1(LAS unsigned char* L, const int lane, const int wave, const int G, const int bx, const int vcu, const int gw, const int NGW) {
    { PHASE_PTRS
    {
        int kdim_ = DM; asm volatile("" : "+s"(kdim_)); pg8::Gemm g{HB, WIN, MROWS, INCOLS, kdim_}; PROBE_EPI_SET(1) pg8::StaticOrder S; S.init(MROWS, INCOLS, G, bx, WGM_P1);
        pg8::EpiInProj E{ZC, QB, KB, VB, ARG_IN(I_QG), ARG_IN(I_KG), 0.125f * LOG2E, EPS};
        pg8::gemm_phase<pg8::EpiInProj, pg8::StaticOrder, true, PG8_SP2>(L, g, S, E);
    }
    }
}
__device__ __forceinline__ void phase2(LAS unsigned char* L, const int lane, const int wave, const int G, const int bx, const int vcu, const int gw, const int NGW) {
    { PHASE_PTRS
    {
        const float mq = wave_max(fabsf(ARG_IN(I_QG)[lane])), mk = wave_max(fabsf(ARG_IN(I_KG)[lane]));
        const float negM = -8.0f * mq * mk * LOG2E;
        const int nper = 3072 / G, tid = threadIdx.x;
#define ATT_UNIT(i) ((G == 256) ? ((4 * (vcu >> 5) + (i) / 3) * 96 + ((i) % 3) * 32 + (vcu & 31)) : (vcu * nper + (i)))
        att::Stage st; att::UnitP p = att::unit_params(ATT_UNIT(0));
        att::stage_load(st, QB, KB, VB, p, tid, wave, lane);
        for (int i = 0; i < nper; ++i) {
#if defined(PROBE_ATT) && PROBE_ATT == 2
            const unsigned long long tw0_ = __builtin_amdgcn_s_memrealtime();
#endif
            att::stage_write(st, L, tid);
            bf16x8 qf[4];
#pragma unroll
            for (int s = 0; s < 4; ++s) qf[s] = st.q[s];
            asm volatile("s_waitcnt lgkmcnt(0)" ::: "memory"); __builtin_amdgcn_s_barrier(); asm volatile("" ::: "memory");
#if defined(PROBE_ATT) && PROBE_ATT == 2
            if (bx == PROBE_BLK && tid == 0) __hip_atomic_fetch_add((unsigned*)(ws_ + WS_CTL) + 8, (unsigned)(__builtin_amdgcn_s_memrealtime() - tw0_), __ATOMIC_RELAXED, __HIP_MEMORY_SCOPE_AGENT);
#endif
            att::UnitP pn = p;
            if (i + 1 < nper) { pn = att::unit_params(ATT_UNIT(i + 1)); att::stage_load(st, QB, KB, VB, pn, tid, wave, lane); }
#if defined(PROBE_ATT) && PROBE_ATT == 1
            const unsigned long long ta0_ = __builtin_amdgcn_s_memrealtime();
#endif
            att::compute_tile(L, qf, p, OP + (size_t)p.branch * MROWS * ATTW, LP + (size_t)p.branch * MROWS * NHEAD, negM, wave, lane);
#if defined(PROBE_ATT) && PROBE_ATT == 1
            if (bx == PROBE_BLK && tid == 0) __hip_atomic_fetch_add((unsigned*)(ws_ + WS_CTL) + 8, (unsigned)(__builtin_amdgcn_s_memrealtime() - ta0_), __ATOMIC_RELAXED, __HIP_MEMORY_SCOPE_AGENT);
#endif
            asm volatile("s_waitcnt lgkmcnt(0)" ::: "memory"); __builtin_amdgcn_s_barrier(); asm volatile("" ::: "memory");
            p = pn;
        }
    }
    }
}
__device__ __forceinline__ void phase3(LAS unsigned char* L, const int lane, const int wave, const int G, const int bx, const int vcu, const int gw, const int NGW) {
    { PHASE_PTRS
    {
        const int c = 8 * lane;
        float cw0[8], cw1[8], cw2[8], cbv[8], gc[8], ga[8];
        load8f(ARG_IN(I_CONVW) + c, cw0); load8f(ARG_IN(I_CONVW) + CONVW + c, cw1); load8f(ARG_IN(I_CONVW) + 2 * CONVW + c, cw2);
        load8f(ARG_IN(I_CONVB) + c, cbv); load8f(ARG_IN(I_GOC) + c, gc); load8f(ARG_IN(I_GOA) + c, ga);
        for (int ch = gw; ch < MROWS / 16; ch += NGW) {
            const int m0 = ch * 16;
            float u1[8], u2[8];
            if ((m0 & (SEQ - 1)) == 0) {
#pragma unroll
                for (int j = 0; j < 8; ++j) { u1[j] = 0.f; u2[j] = 0.f; }
            } else {
                float a[8], bb[8];
                unpack8(*(const GAS v4u*)(ZC + (size_t)(m0 - 1) * 1536 + 512 + c), a); unpack8(*(const GAS v4u*)(ZC + (size_t)(m0 - 1) * 1536 + 1024 + c), bb);
#pragma unroll
                for (int j = 0; j < 8; ++j) u1[j] = a[j] * bb[j];
                unpack8(*(const GAS v4u*)(ZC + (size_t)(m0 - 2) * 1536 + 512 + c), a); unpack8(*(const GAS v4u*)(ZC + (size_t)(m0 - 2) * 1536 + 1024 + c), bb);
#pragma unroll
                for (int j = 0; j < 8; ++j) u2[j] = a[j] * bb[j];
            }
            for (int tt = 0; tt < 16; ++tt) {
                const size_t m = (size_t)(m0 + tt);
                float zb[8], zc[8], zx[8], y[8];
                unpack8(*(const GAS v4u*)(ZC + m * 1536 + c), zb); unpack8(*(const GAS v4u*)(ZC + m * 1536 + 512 + c), zc); unpack8(*(const GAS v4u*)(ZC + m * 1536 + 1024 + c), zx);
                float o1[8], o2[8], o3[8];
                unpack8(*(const GAS v4u*)(OP + m * ATTW + c), o1); unpack8(*(const GAS v4u*)(OP + ((size_t)MROWS + m) * ATTW + c), o2); unpack8(*(const GAS v4u*)(OP + ((size_t)2 * MROWS + m) * ATTW + c), o3);
                const float lt = LP[m * NHEAD + (lane >> 3)] + LP[((size_t)MROWS + m) * NHEAD + (lane >> 3)] + LP[((size_t)2 * MROWS + m) * NHEAD + (lane >> 3)];
                float ss = 0.f;
#pragma unroll
                for (int j = 0; j < 8; ++j) { const float u0 = zc[j] * zx[j]; y[j] = zb[j] * (cw0[j] * u2[j] + cw1[j] * u1[j] + cw2[j] * u0 + cbv[j]); ss += y[j] * y[j]; u2[j] = u1[j]; u1[j] = u0; }
                const float rc = __builtin_amdgcn_rsqf(wave_sum(ss) * (1.f / CONVW) + EPS);
#pragma unroll
                for (int j = 0; j < 8; ++j) y[j] = y[j] * rc * gc[j];
                *(GAS v4u*)(YB + m * DM + c) = pack8f(y);
                const float rl = 1.0f / lt; float sa = 0.f;
#pragma unroll
                for (int j = 0; j < 8; ++j) { y[j] = (o1[j] + o2[j] + o3[j]) * rl; sa += y[j] * y[j]; }
                const float ra = __builtin_amdgcn_rsqf(wave_sum(sa) * (1.f / ATTW) + EPS);
#pragma unroll
                for (int j = 0; j < 8; ++j) y[j] = y[j] * ra * ga[j];
                *(GAS v4u*)(YB + m * DM + CONVW + c) = pack8f(y);
            }
        }
    }
    }
}
__device__ __forceinline__ void phase4(LAS unsigned char* L, const int lane, const int wave, const int G, const int bx, const int vcu, const int gw, const int NGW) {
    for (int s_ = 0; s_ < 2; ++s_) {
        if (s_ == 0) { PHASE_PTRS
            int kdim_ = DM; asm volatile("" : "+s"(kdim_)); pg8::Gemm g{YB, WOUT, MROWS, DM, kdim_}; PROBE_EPI_SET(4) pg8::StaticOrder S; S.init(MROWS, DM, G, bx, WGM_P4);
            pg8::EpiResNorm<false> E{ARG_IN(I_X), HB, SSB, DM, (LAS float*)(L + XCH_OFF)};
            pg8::gemm_phase<pg8::EpiResNorm<false>, pg8::StaticOrder, true, PG8_SP2>(L, g, S, E);
        } else { PHASE_PTRS
            int kdim_ = PLED; asm volatile("" : "+s"(kdim_)); pg8::Gemm g{PB, WPP, MROWS, DM, kdim_}; PROBE_EPI_SET(4) pg8::StaticOrder S; S.init(MROWS, DM, G, bx, WGM_P4);
            pg8::EpiBf16 E{PP, DM};
            pg8::gemm_phase<pg8::EpiBf16, pg8::StaticOrder, true, PG8_SP2>(L, g, S, E);
        }
    }
}
__device__ __forceinline__ void phase6(LAS unsigned char* L, const int lane, const int wave, const int G, const int bx, const int vcu, const int gw, const int NGW) {
    { PHASE_PTRS
    {
        int kdim_ = DM; asm volatile("" : "+s"(kdim_)); pg8::Gemm g{HB, WGU, MROWS, 2 * DFF, kdim_}; PROBE_EPI_SET(6) pg8::StaticOrder S; S.init(MROWS, 2 * DFF, G, bx, WGM_P6);
        pg8::EpiGUAct E{UB, DFF, SSB, EPS, ARG_IN(I_FCW), ARG_IN(I_FCB), TOPG, BOTG, TOPU, (LAS float*)(L + XCH_OFF)};
        pg8::gemm_phase<pg8::EpiGUAct, pg8::StaticOrder, true, PG8_SP2>(L, g, S, E);
    }
    }
}
__device__ __forceinline__ void ffn_fix_rows(const float* fcw, const float* fcb, const float* TOPG, const float* BOTG, const float* TOPU, bf16* UB, int pm, int c) {
    float w0[8], w1[8], w2[8], bv[8], g0[8], g1[8], gm1[8], gm2[8], u0[8], u1[8], a0[8], a1[8];
    load8f(fcw + c, w0); load8f(fcw + DFF + c, w1); load8f(fcw + 2 * DFF + c, w2); load8f(fcb + c, bv);
    load8f(TOPG + (size_t)(pm * 2) * DFF + c, g0); load8f(TOPG + (size_t)(pm * 2 + 1) * DFF + c, g1);
    load8f(BOTG + (size_t)(pm * 2 - 2) * DFF + c, gm2); load8f(BOTG + (size_t)(pm * 2 - 1) * DFF + c, gm1);
    load8f(TOPU + (size_t)(pm * 2) * DFF + c, u0); load8f(TOPU + (size_t)(pm * 2 + 1) * DFF + c, u1);
#pragma unroll
    for (int j = 0; j < 8; ++j) {
        const float p0 = w0[j] * gm2[j] + w1[j] * gm1[j] + w2[j] * g0[j] + bv[j], p1 = w0[j] * gm1[j] + w1[j] * g0[j] + w2[j] * g1[j] + bv[j];
        a0[j] = p0 * __builtin_amdgcn_rcpf(1.0f + __builtin_amdgcn_exp2f(-LOG2E * p0)) * u0[j];
        a1[j] = p1 * __builtin_amdgcn_rcpf(1.0f + __builtin_amdgcn_exp2f(-LOG2E * p1)) * u1[j];
    }
    *(GAS v4u*)(UB + (size_t)(pm * 256) * DFF + c) = pack8f(a0);
    *(GAS v4u*)(UB + (size_t)(pm * 256 + 1) * DFF + c) = pack8f(a1);
}
__device__ __forceinline__ void phase8(LAS unsigned char* L, const int lane, const int wave, const int G, const int bx, const int vcu, const int gw, const int NGW) {
    { PHASE_PTRS
    {
        int kdim_ = DFF; asm volatile("" : "+s"(kdim_)); pg8::Gemm g{UB, WDN, MROWS, DM, kdim_}; PROBE_EPI_SET(8) pg8::StaticOrder S; S.init(MROWS, DM, G, bx, WGM_P8);
        { const int tid = threadIdx.x; pg8::Unit fu; int prev = -1;
          for (int i = 0; S.next(i, fu); ++i) { if (fu.pm != prev && (fu.pm & 31) != 0 && 8 * tid < DFF) ffn_fix_rows(ARG_IN(I_FCW), ARG_IN(I_FCB), TOPG, BOTG, TOPU, UB, fu.pm, 8 * tid); prev = fu.pm; }
          asm volatile("s_waitcnt vmcnt(0)" ::: "memory"); __syncthreads(); }
        pg8::EpiResNorm<true> E{HB, X2B, SSB, DM, (LAS float*)(L + XCH_OFF)};
        pg8::gemm_phase<pg8::EpiResNorm<true>, pg8::StaticOrder, true, PG8_SP2>(L, g, S, E);
    }
    }
}
__device__ __forceinline__ void phase10(LAS unsigned char* L, const int lane, const int wave, const int G, const int bx, const int vcu, const int gw, const int NGW) {
    { PHASE_PTRS
    {
        int kdim_ = DM; asm volatile("" : "+s"(kdim_)); pg8::Gemm g{X2B, WPG, MROWS, DM, kdim_}; PROBE_EPI_SET(10) pg8::StaticOrder S; S.init(MROWS, DM, G, bx, WGM_P10);
        pg8::EpiPle E{X2B, out, PP, DM, SSB, EPS};
        pg8::gemm_phase<pg8::EpiPle, pg8::StaticOrder, true, PG8_SP2>(L, g, S, E);
    }
    }
}

#if defined(PROBE_CLK)
#define PROBE_T0(n) unsigned long long tp0_##n = 0; if ((n) == PROBE_CLK) tp0_##n = __builtin_amdgcn_s_memtime();
#define PROBE_T1(n) if ((n) == PROBE_CLK && bx == PROBE_BLK && tid == 0) { __hip_atomic_fetch_add((unsigned*)(ctl + 8), (unsigned)((__builtin_amdgcn_s_memtime() - tp0_##n) / 25), __ATOMIC_RELAXED, __HIP_MEMORY_SCOPE_AGENT); }
#elif defined(PROBE_PHASE)
#define PROBE_T0(n) unsigned long long tp0_##n = 0; if ((n) == PROBE_PHASE) tp0_##n = __builtin_amdgcn_s_memrealtime();
#define PROBE_T1(n) if ((n) == PROBE_PHASE && bx == PROBE_BLK && tid == 0) { __hip_atomic_fetch_add((unsigned*)(ctl + 8), (unsigned)(__builtin_amdgcn_s_memrealtime() - tp0_##n), __ATOMIC_RELAXED, __HIP_MEMORY_SCOPE_AGENT); }
#else
#define PROBE_T0(n)
#define PROBE_T1(n)
#endif
#ifdef PROBE_BAR
#define XBAR() do { const unsigned long long tb0_ = __builtin_amdgcn_s_memrealtime(); xcd_barrier(bar); ++nbar_; if ((PROBE_BAR == 99 || nbar_ == PROBE_BAR) && bx == PROBE_BLK && tid == 0) __hip_atomic_fetch_add((unsigned*)(ctl + 8), (unsigned)(__builtin_amdgcn_s_memrealtime() - tb0_), __ATOMIC_RELAXED, __HIP_MEMORY_SCOPE_AGENT); } while (0)
#else
#define XBAR() xcd_barrier(bar)
#endif
__global__ void __launch_bounds__(NWAVES * 64, 2) hybrid_fwd(Args args) {
    extern __shared__ __attribute__((aligned(16))) unsigned char lds[];
    LAS unsigned char* L = (LAS unsigned char*)lds;
    volatile LAS unsigned* MISC = (volatile LAS unsigned*)(L + MISC_OFF);
    const int tid = threadIdx.x, lane = tid & 63, wave = __builtin_amdgcn_readfirstlane(tid >> 6);
    const int G = gridDim.x; const int bx = blockIdx.x;
    const int vcu = (G % 8 == 0) ? (bx % 8) * (G / 8) + bx / 8 : bx;
    const int gw = vcu * NWAVES + wave, NGW = G * NWAVES;
    gu32* ctl; { KARG_DECL ctl = (gu32*)(ARG_WS() + WS_CTL); }
    for (int u = tid; u < (LDS_BYTES - LDSCTL_OFF) / 4; u += NWAVES * 64) ((LAS unsigned*)(L + LDSCTL_OFF))[u] = 0u;
    __syncthreads();
    XcdBarrier bar = xcd_barrier_post((unsigned*)(ctl + CW_BAR), MISC + 8);
#ifdef PROBE_TOTAL
    const unsigned long long tt0_ = __builtin_amdgcn_s_memrealtime();
#endif
#ifdef PROBE_BAR
    int nbar_ = 0;
#endif

#ifndef SKIP_P0
    PROBE_T0(0) phase0(L, lane, wave, G, bx, vcu, gw, NGW); PROBE_T1(0)
#endif
    XBAR();
#if (DUP_MASK >> 0) & 1
    phase0(L, lane, wave, G, bx, vcu, gw, NGW);
    XBAR();
#endif
#ifdef EXTRA_BARRIERS
    { int nb_ = EXTRA_BARRIERS; asm volatile("" : "+s"(nb_)); for (int eb_ = 0; eb_ < nb_; ++eb_) xcd_barrier(bar); }
#endif

#ifndef SKIP_P1
    PROBE_T0(1) phase1(L, lane, wave, G, bx, vcu, gw, NGW); PROBE_T1(1)
#endif
    XBAR();
#if (DUP_MASK >> 1) & 1
    phase1(L, lane, wave, G, bx, vcu, gw, NGW);
    XBAR();
#endif

#ifndef SKIP_P2
    PROBE_T0(2) phase2(L, lane, wave, G, bx, vcu, gw, NGW); PROBE_T1(2)
#endif
    XBAR();
#if (DUP_MASK >> 2) & 1
    phase2(L, lane, wave, G, bx, vcu, gw, NGW);
    XBAR();
#endif

#ifndef SKIP_P3
    PROBE_T0(3) phase3(L, lane, wave, G, bx, vcu, gw, NGW); PROBE_T1(3)
#endif
    XBAR();
#if (DUP_MASK >> 3) & 1
    phase3(L, lane, wave, G, bx, vcu, gw, NGW);
    XBAR();
#endif

#ifndef SKIP_P4
    PROBE_T0(4) phase4(L, lane, wave, G, bx, vcu, gw, NGW); PROBE_T1(4)
#endif
    XBAR();
#if (DUP_MASK >> 4) & 1
    phase4(L, lane, wave, G, bx, vcu, gw, NGW);
    XBAR();
#endif

#ifndef SKIP_P6
    PROBE_T0(6) phase6(L, lane, wave, G, bx, vcu, gw, NGW); PROBE_T1(6)
#endif
    XBAR();
#if (DUP_MASK >> 6) & 1
    phase6(L, lane, wave, G, bx, vcu, gw, NGW);
    XBAR();
#endif


#ifndef SKIP_P8
    PROBE_T0(8) phase8(L, lane, wave, G, bx, vcu, gw, NGW); PROBE_T1(8)
#endif
    XBAR();
#if (DUP_MASK >> 8) & 1
    phase8(L, lane, wave, G, bx, vcu, gw, NGW);
    XBAR();
#endif


#ifndef SKIP_P10
    PROBE_T0(10) phase10(L, lane, wave, G, bx, vcu, gw, NGW); PROBE_T1(10)
#endif
#if (DUP_MASK >> 10) & 1
    XBAR();
    phase10(L, lane, wave, G, bx, vcu, gw, NGW);
#endif
#ifdef PROBE_TOTAL
    if (bx == PROBE_BLK && tid == 0) __hip_atomic_fetch_add((unsigned*)(ctl + 8), (unsigned)(__builtin_amdgcn_s_memrealtime() - tt0_), __ATOMIC_RELAXED, __HIP_MEMORY_SCOPE_AGENT);
#endif
#if defined(PROBE_PHASE) || defined(PROBE_EPI) || defined(PROBE_BAR) || defined(PROBE_CLK) || defined(PROBE_ATT) || defined(PROBE_TOTAL)
    if (bx == PROBE_BLK && tid == 0) { const unsigned tk = __hip_atomic_load((unsigned*)(ctl + 8), __ATOMIC_RELAXED, __HIP_MEMORY_SCOPE_AGENT); const unsigned long long t0 = __builtin_amdgcn_s_memrealtime();
        while (__builtin_amdgcn_s_memrealtime() - t0 < (unsigned long long)tk * PROBE_AMP) __builtin_amdgcn_s_sleep(32); }
#endif
}

extern "C" void kernel_launch(void* const* d_in, const int* in_sizes, int n_in, void* d_out, int out_size, void* d_ws, size_t ws_size, hipStream_t stream) {
    static int grid = 0;
    if (grid == 0) {
        if (n_in != 20 || out_size != MROWS * DM || ws_size < WS_END) { fprintf(stderr, "kernel_launch: unexpected shapes (n_in %d, out %d, ws %zu); nothing launched\n", n_in, out_size, ws_size); grid = -1; return; }
        int dev = 0, cus = 0, per_cu = 0;
        if (hipGetDevice(&dev) != hipSuccess || hipDeviceGetAttribute(&cus, hipDeviceAttributeMultiprocessorCount, dev) != hipSuccess) { grid = -1; return; }
        if (hipFuncSetAttribute((const void*)hybrid_fwd, hipFuncAttributeMaxDynamicSharedMemorySize, LDS_BYTES) != hipSuccess) { fprintf(stderr, "kernel_launch: hipFuncSetAttribute failed\n"); grid = -1; return; }
        if (hipOccupancyMaxActiveBlocksPerMultiprocessor(&per_cu, (const void*)hybrid_fwd, NWAVES * 64, LDS_BYTES) != hipSuccess || per_cu < 1)
            fprintf(stderr, "kernel_launch: note: occupancy query reports %d workgroups per CU\n", per_cu);
        (void)hipGetLastError();
        grid = cus;
        if (grid != 256) fprintf(stderr, "kernel_launch: %d CUs (built for 256)\n", grid);
    }
    if (grid < 0) return;
    if (hipMemsetAsync((char*)d_ws + WS_CTL, 0, CTL_ZERO_BYTES, stream) != hipSuccess) { fprintf(stderr, "kernel_launch: hipMemsetAsync failed\n"); return; }
    Args a{};
    for (int i = 0; i < 20; ++i) a.in[i] = (const float*)d_in[i];
    a.out = (float*)d_out; a.ws = (unsigned char*)d_ws;
    hipLaunchKernelGGL(hybrid_fwd, dim3(grid), dim3(NWAVES * 64), LDS_BYTES, stream, a);
    const hipError_t le = hipPeekAtLastError();
    if (le != hipSuccess) fprintf(stderr, "kernel_launch: launch failed: %s\n", hipGetErrorName(le));
}
```

```cpp
#include <hip/hip_runtime.h>
#include <cstdio>
#include <cstdint>
namespace pg8 {
#define PG8_LAS __attribute__((address_space(3)))
typedef unsigned short bf16_t;
typedef short bf16x8 __attribute__((ext_vector_type(8)));
typedef float f32x4 __attribute__((ext_vector_type(4)));
typedef unsigned u32x4 __attribute__((ext_vector_type(4)));
constexpr int BM = 256, BK = 64, HALF = 128, HTB = HALF * BK * 2  , STAGE_BYTES = 8 * HTB, NXCD = 8;
#ifndef PG8_WGM
#define PG8_WGM 4
#endif
constexpr int WGM = PG8_WGM;

__host__ __device__ __forceinline__ int lds_byte(int r, int c) { const int st = (r >> 4) * 2 + (c >> 5), rr = r & 15, cc = c & 31, ob = rr * 64 + cc * 2; return st * 1024 + (ob ^ (((ob >> 9) & 1) << 5)); }
__host__ __device__ __forceinline__ void stage_rc(int b, int& R, int& C) { const int st = b / 1024, sb = b % 1024, swz = sb ^ (((sb >> 9) & 1) << 5); R = (st >> 1) * 16 + swz / 64; C = (st & 1) * 32 + (swz % 64) / 2; }
__host__ __device__ __forceinline__ int perm32(int rho) { const int n = rho >> 4, i = rho & 15; return 8 * (i >> 2) + 4 * n + (i & 3); }

struct Unit { int pm, pn; };
struct Gemm { const bf16_t* A; const bf16_t* Bt; int M, N, K; unsigned* tacc = nullptr; };

struct StaticOrder {
    int nM, nN, nwg, G, c, wgm;
    __host__ __device__ void init(int M, int N, int G_, int c_, int wgm_ = WGM) { nM = M / BM; nN = N / BM; nwg = nM * nN; G = G_; c = c_; wgm = wgm_; }
    __host__ __device__ bool next(int i, Unit& u) const {
        const long L = (long)i * G + c; if (L >= nwg) return false;
        int wgid = (int)L; { const int q = nwg / NXCD, r = nwg % NXCD, xcd = wgid % NXCD, off = wgid / NXCD; wgid = (xcd < r ? xcd * (q + 1) : r * (q + 1) + (xcd - r) * q) + off; }
        const int nig = wgm * nN, gid = wgid / nig, fm = gid * wgm, gsz = (nM - fm) < wgm ? (nM - fm) : wgm;
        u.pm = fm + ((wgid % nig) % gsz); u.pn = (wgid % nig) / gsz; return true;
    }
    __device__ __forceinline__ void a_ready(const Unit&) const {}
    __device__ __forceinline__ void done(const Unit&) const {}
};

__device__ __forceinline__ unsigned cvt_pk_bf16(float lo, float hi) { unsigned r; asm volatile("v_cvt_pk_bf16_f32 %0, %1, %2" : "=v"(r) : "v"(lo), "v"(hi)); return r; }
__device__ __forceinline__ u32x4 pack8(const f32x4& v0, const f32x4& v1) { u32x4 w; w.x = cvt_pk_bf16(v0[0], v0[1]); w.y = cvt_pk_bf16(v0[2], v0[3]); w.z = cvt_pk_bf16(v1[0], v1[1]); w.w = cvt_pk_bf16(v1[2], v1[3]); return w; }
__device__ __forceinline__ float bf2f(unsigned short h) { return __builtin_bit_cast(float, (unsigned)h << 16); }

struct EpiBf16 {
    static constexpr bool PERM = true, AFTER_DRAIN = false;
    bf16_t* O; int ldc;
    __device__ __forceinline__ void operator()(const f32x4 (&acc)[2][2][4][2], const Unit& u, int wr, int wc, int fr, int fq) const {
        const int row0 = u.pm * BM + wr * 64 + fr, col0 = u.pn * BM + wc * 32 + 8 * fq;
#pragma unroll
        for (int ai = 0; ai < 2; ++ai)
#pragma unroll
            for (int m = 0; m < 4; ++m) { bf16_t* rowp = O + (size_t)(row0 + ai * HALF + m * 16) * ldc + col0;
#pragma unroll
                for (int bj = 0; bj < 2; ++bj) *(u32x4*)(rowp + bj * HALF) = pack8(acc[ai][bj][m][0], acc[ai][bj][m][1]); }
    }
};
__device__ __forceinline__ float rstd4(const f32x4 a, float eps) { return __builtin_amdgcn_rsqf(((a[0] + a[1]) + (a[2] + a[3])) * (1.0f / 1024.0f) + eps); }
struct EpiGU {
    static constexpr bool PERM = true, AFTER_DRAIN = false;
    bf16_t* G; bf16_t* U; int ldc; const float* SS; float eps;
    __device__ __forceinline__ void operator()(const f32x4 (&acc)[2][2][4][2], const Unit& u, int wr, int wc, int fr, int fq) const {
        const int row0 = u.pm * BM + wr * 64 + fr, col0 = u.pn * HALF + wc * 32 + 8 * fq;
        f32x4 sp[2][4];
#pragma unroll
        for (int ai = 0; ai < 2; ++ai)
#pragma unroll
            for (int m = 0; m < 4; ++m) sp[ai][m] = *(const f32x4*)(SS + (size_t)(row0 + ai * HALF + m * 16) * 4);
#pragma unroll
        for (int ai = 0; ai < 2; ++ai)
#pragma unroll
            for (int m = 0; m < 4; ++m) { const int row = row0 + ai * HALF + m * 16; const float rs = rstd4(sp[ai][m], eps); const size_t off = (size_t)row * ldc + col0;
                *(u32x4*)(G + off) = pack8(acc[ai][0][m][0] * rs, acc[ai][0][m][1] * rs);
                *(u32x4*)(U + off) = pack8(acc[ai][1][m][0] * rs, acc[ai][1][m][1] * rs); }
    }
};
__device__ __forceinline__ float dpp_ror1(float v) { return __builtin_bit_cast(float, __builtin_amdgcn_mov_dpp(__builtin_bit_cast(int, v), 0x121, 0xf, 0xf, false)); }
__device__ __forceinline__ float dpp_ror2(float v) { return __builtin_bit_cast(float, __builtin_amdgcn_mov_dpp(__builtin_bit_cast(int, v), 0x122, 0xf, 0xf, false)); }
struct EpiGUAct {
    static constexpr bool PERM = true, AFTER_DRAIN = false;
    bf16_t* ACT; int ldc; const float* SS; float eps; const float* cw; const float* cbias; float* TOPG; float* BOTG; float* TOPU; PG8_LAS float* xch;
    __device__ __forceinline__ void operator()(const f32x4 (&acc_)[2][2][4][2], const Unit& u, int wr, int wc, int fr, int fq) const {
        f32x4 (&acc)[2][2][4][2] = const_cast<f32x4 (&)[2][2][4][2]>(acc_);
        const int row0 = u.pm * BM + wr * 64 + fr, colh = wc * 32 + 8 * fq, col0 = u.pn * HALF + colh;
        {
            f32x4 sp[2][4];
#pragma unroll
            for (int ai = 0; ai < 2; ++ai)
#pragma unroll
                for (int m = 0; m < 4; ++m) sp[ai][m] = *(const f32x4*)(SS + (size_t)(row0 + ai * HALF + m * 16) * 4);
#pragma unroll
            for (int ai = 0; ai < 2; ++ai)
#pragma unroll
                for (int m = 0; m < 4; ++m) { const float rs = rstd4(sp[ai][m], eps);
#pragma unroll
                    for (int bj = 0; bj < 2; ++bj)
#pragma unroll
                        for (int n = 0; n < 2; ++n) acc[ai][bj][m][n] = acc[ai][bj][m][n] * rs; }
        }
        if (fr >= 14) {
#pragma unroll
            for (int ai = 0; ai < 2; ++ai)
#pragma unroll
                for (int n = 0; n < 2; ++n) *(PG8_LAS f32x4*)(xch + (((wr * 2 + ai) * 2 + (fr - 14)) * 128 + colh + 4 * n)) = acc[ai][0][3][n];
            if (wr == 1) {
#pragma unroll
                for (int n = 0; n < 2; ++n) *(f32x4*)(BOTG + (size_t)(u.pm * 2 + fr - 14) * ldc + col0 + 4 * n) = acc[1][0][3][n];
            }
        }
        if (wr == 0 && fr < 2) {
#pragma unroll
            for (int n = 0; n < 2; ++n) { *(f32x4*)(TOPG + (size_t)(u.pm * 2 + fr) * ldc + col0 + 4 * n) = acc[0][0][0][n]; *(f32x4*)(TOPU + (size_t)(u.pm * 2 + fr) * ldc + col0 + 4 * n) = acc[0][1][0][n]; }
        }
        asm volatile("s_waitcnt lgkmcnt(0)" ::: "memory"); __builtin_amdgcn_s_barrier(); asm volatile("" ::: "memory");
        typedef unsigned u32x2v __attribute__((ext_vector_type(2)));
#pragma unroll
        for (int n = 0; n < 2; ++n) {
            const f32x4 w0 = *(const f32x4*)(cw + col0 + 4 * n), w1 = *(const f32x4*)(cw + ldc + col0 + 4 * n), w2 = *(const f32x4*)(cw + 2 * ldc + col0 + 4 * n), bb = *(const f32x4*)(cbias + col0 + 4 * n);
#pragma unroll
            for (int ai = 0; ai < 2; ++ai) {
                f32x4 r1p, r2p;
                if (wr == 0 && ai == 0) { r1p = (f32x4){0.f, 0.f, 0.f, 0.f}; r2p = (f32x4){0.f, 0.f, 0.f, 0.f}; }
                else {
                    const int pw = wr ^ 1, pai = (wr == 1) ? ai : ai - 1;
                    const PG8_LAS float* xb = xch + ((pw * 2 + pai) * 2) * 128 + colh + 4 * n;
                    const f32x4 e2 = *(const PG8_LAS f32x4*)(xb), e1 = *(const PG8_LAS f32x4*)(xb + 128); r1p = e1; r2p = (fr == 0) ? e2 : e1;
                }
#pragma unroll
                for (int m = 0; m < 4; ++m) {
                    const f32x4 g = acc[ai][0][m][n], uu = acc[ai][1][m][n];
                    f32x4 r1, r2, a4;
#pragma unroll
                    for (int j = 0; j < 4; ++j) { r1[j] = dpp_ror1(g[j]); r2[j] = dpp_ror2(g[j]); }
#pragma unroll
                    for (int j = 0; j < 4; ++j) {
                        const float p1 = (fr == 0) ? r1p[j] : r1[j], p2 = (fr < 2) ? r2p[j] : r2[j];
                        const float pre = w0[j] * p2 + w1[j] * p1 + w2[j] * g[j] + bb[j];
                        a4[j] = pre * __builtin_amdgcn_rcpf(1.0f + __builtin_amdgcn_exp2f(-1.4426950408889634f * pre)) * uu[j];
                    }
                    r1p = r1; r2p = r2;
                    u32x2v w; w.x = cvt_pk_bf16(a4[0], a4[1]); w.y = cvt_pk_bf16(a4[2], a4[3]);
                    *(u32x2v*)(ACT + (size_t)(row0 + ai * HALF + m * 16) * ldc + col0 + 4 * n) = w;
                    asm volatile("" ::: "memory");
                }
            }
        }
    }
};
struct EpiInProj {
    static constexpr bool PERM = true, AFTER_DRAIN = false;
    bf16_t* ZC; bf16_t* Q; bf16_t* Kk; bf16_t* V; const float* gq; const float* gk; float qscale; float eps;
    __device__ __forceinline__ void operator()(const f32x4 (&acc)[2][2][4][2], const Unit& u, int wr, int wc, int fr, int fq) const {
        if (u.pn < 6) {
            const int row0 = u.pm * BM + wr * 64 + fr, col0 = u.pn * BM + wc * 32 + 8 * fq;
#pragma unroll
            for (int ai = 0; ai < 2; ++ai)
#pragma unroll
                for (int m = 0; m < 4; ++m) { bf16_t* rowp = ZC + (size_t)(row0 + ai * HALF + m * 16) * 1536 + col0;
#pragma unroll
                    for (int bj = 0; bj < 2; ++bj) *(u32x4*)(rowp + bj * HALF) = pack8(acc[ai][bj][m][0], acc[ai][bj][m][1]); }
        } else {
            const int sec = u.pn - 6, which = sec >> 1, head = 4 * (sec & 1) + wc;
            if (which < 2) {
                bf16_t* base = which == 0 ? Q : Kk;
                const float* g = which == 0 ? gq : gk;
                const float sc = which == 0 ? qscale : 1.f;
                const f32x4 g00 = *(const f32x4*)(g + 8 * fq), g01 = *(const f32x4*)(g + 8 * fq + 4), g10 = *(const f32x4*)(g + 32 + 8 * fq), g11 = *(const f32x4*)(g + 32 + 8 * fq + 4);
#pragma unroll
                for (int ai = 0; ai < 2; ++ai)
#pragma unroll
                    for (int m = 0; m < 4; ++m) {
                        const int row = u.pm * BM + ai * HALF + wr * 64 + m * 16 + fr, b = row >> 13, t = row & 8191;
                        float ss = 0.f;
#pragma unroll
                        for (int bj = 0; bj < 2; ++bj)
#pragma unroll
                            for (int n = 0; n < 2; ++n) { const f32x4 x = acc[ai][bj][m][n]; ss += (x[0] * x[0] + x[1] * x[1]) + (x[2] * x[2] + x[3] * x[3]); }
                        ss += __shfl_xor(ss, 16); ss += __shfl_xor(ss, 32);
                        const float rs = sc * __builtin_amdgcn_rsqf(ss * (1.0f / 64.0f) + eps);
                        bf16_t* dst = base + ((size_t)((b * 8 + head) * 8192 + t)) * 64 + 8 * fq;
                        *(u32x4*)(dst) = pack8(acc[ai][0][m][0] * rs * g00, acc[ai][0][m][1] * rs * g01);
                        *(u32x4*)(dst + 32) = pack8(acc[ai][1][m][0] * rs * g10, acc[ai][1][m][1] * rs * g11);
                    }
            } else {
#pragma unroll
                for (int ai = 0; ai < 2; ++ai)
#pragma unroll
                    for (int m = 0; m < 4; ++m) {
                        const int row = u.pm * BM + ai * HALF + wr * 64 + m * 16 + fr, b = row >> 13, t = row & 8191;
                        bf16_t* dst = V + ((size_t)((b * 8 + head) * 8192 + t)) * 64 + 8 * fq;
                        *(u32x4*)(dst) = pack8(acc[ai][0][m][0], acc[ai][0][m][1]);
                        *(u32x4*)(dst + 32) = pack8(acc[ai][1][m][0], acc[ai][1][m][1]);
                    }
            }
        }
    }
};
template <bool BASE_BF16> struct EpiResNorm {
    static constexpr bool PERM = true, AFTER_DRAIN = false;
    const void* base; bf16_t* XB; float* SS; int ldc; PG8_LAS float* red;
    __device__ __forceinline__ void operator()(const f32x4 (&acc)[2][2][4][2], const Unit& u, int wr, int wc, int fr, int fq) const {
        const int row0 = u.pm * BM + wr * 64 + fr, col0 = u.pn * BM + wc * 32 + 8 * fq;
        constexpr int NB = BASE_BF16 ? 1 : 2, GPB = 8 / NB;
#pragma unroll
        for (int bt = 0; bt < NB; ++bt) {
            u32x4 pb[GPB][2]; f32x4 pf[BASE_BF16 ? 1 : GPB][2][2];
#pragma unroll
            for (int gi = 0; gi < GPB; ++gi) { const int g8 = bt * GPB + gi, ai = g8 >> 2, m = g8 & 3; const size_t off = (size_t)(row0 + ai * HALF + m * 16) * ldc + col0;
#pragma unroll
                for (int bj = 0; bj < 2; ++bj) {
                    if constexpr (BASE_BF16) pb[gi][bj] = *(const u32x4*)((const bf16_t*)base + off + bj * HALF);
                    else { pf[gi][bj][0] = *(const f32x4*)((const float*)base + off + bj * HALF); pf[gi][bj][1] = *(const f32x4*)((const float*)base + off + bj * HALF + 4); } } }
#pragma unroll
            for (int gi = 0; gi < GPB; ++gi) { const int g8 = bt * GPB + gi, ai = g8 >> 2, m = g8 & 3; const int row = row0 + ai * HALF + m * 16; const size_t off = (size_t)row * ldc + col0; float ss = 0.f;
#pragma unroll
                for (int bj = 0; bj < 2; ++bj) {
                    f32x4 b0, b1;
                    if constexpr (BASE_BF16) { const u32x4 w = pb[gi][bj];
                        b0[0] = __builtin_bit_cast(float, w.x << 16); b0[1] = __builtin_bit_cast(float, w.x & 0xffff0000u); b0[2] = __builtin_bit_cast(float, w.y << 16); b0[3] = __builtin_bit_cast(float, w.y & 0xffff0000u);
                        b1[0] = __builtin_bit_cast(float, w.z << 16); b1[1] = __builtin_bit_cast(float, w.z & 0xffff0000u); b1[2] = __builtin_bit_cast(float, w.w << 16); b1[3] = __builtin_bit_cast(float, w.w & 0xffff0000u); }
                    else { b0 = pf[gi][bj][0]; b1 = pf[gi][bj][1]; }
                    const f32x4 x0 = b0 + acc[ai][bj][m][0], x1 = b1 + acc[ai][bj][m][1];
                    *(u32x4*)(XB + off + bj * HALF) = pack8(x0, x1);
                    ss += ((x0[0] * x0[0] + x0[1] * x0[1]) + (x0[2] * x0[2] + x0[3] * x0[3])) + ((x1[0] * x1[0] + x1[1] * x1[1]) + (x1[2] * x1[2] + x1[3] * x1[3]));
                }
                ss += __shfl_xor(ss, 16); ss += __shfl_xor(ss, 32);
                if (fq == 0) red[(ai * HALF + wr * 64 + m * 16 + fr) * 4 + wc] = ss; }
            asm volatile("" ::: "memory");
        }
        asm volatile("s_waitcnt lgkmcnt(0)" ::: "memory"); __builtin_amdgcn_s_barrier(); asm volatile("" ::: "memory");
        { const int t = threadIdx.x; if (t < 256) { const f32x4 v = *(const PG8_LAS f32x4*)(red + t * 4); SS[(size_t)(u.pm * BM + t) * 4 + u.pn] = (v[0] + v[1]) + (v[2] + v[3]); } }
        asm volatile("s_waitcnt lgkmcnt(0)" ::: "memory"); __builtin_amdgcn_s_barrier(); asm volatile("" ::: "memory");
    }
};
struct EpiPle {
    static constexpr bool PERM = true, AFTER_DRAIN = false;
    const bf16_t* xb; float* out; const bf16_t* pp; int ldc; const float* SS; float eps;
    __device__ __forceinline__ void operator()(const f32x4 (&acc)[2][2][4][2], const Unit& u, int wr, int wc, int fr, int fq) const {
        const int row0 = u.pm * BM + wr * 64 + fr, col0 = u.pn * BM + wc * 32 + 8 * fq;
        float rsv[8];
        {
            f32x4 sp[8];
#pragma unroll
            for (int g8 = 0; g8 < 8; ++g8) sp[g8] = *(const f32x4*)(SS + (size_t)(row0 + (g8 >> 2) * HALF + (g8 & 3) * 16) * 4);
#pragma unroll
            for (int g8 = 0; g8 < 8; ++g8) rsv[g8] = -1.4426950408889634f * rstd4(sp[g8], eps);
        }
        asm volatile("" ::: "memory");
#pragma unroll
        for (int bt = 0; bt < 4; ++bt) {
            u32x4 bw[2][2], pw[2][2];
#pragma unroll
            for (int gi = 0; gi < 2; ++gi) { const int g8 = bt * 2 + gi; const size_t off = (size_t)(row0 + (g8 >> 2) * HALF + (g8 & 3) * 16) * ldc + col0;
#pragma unroll
                for (int bj = 0; bj < 2; ++bj) { bw[gi][bj] = *(const u32x4*)(xb + off + bj * HALF); pw[gi][bj] = *(const u32x4*)(pp + off + bj * HALF); } }
#pragma unroll
            for (int gi = 0; gi < 2; ++gi) { const int g8 = bt * 2 + gi, ai = g8 >> 2, m = g8 & 3; const size_t off = (size_t)(row0 + ai * HALF + m * 16) * ldc + col0; const float rs = rsv[g8];
#pragma unroll
                for (int bj = 0; bj < 2; ++bj) { const size_t o2 = off + bj * HALF;
                    const unsigned bws[4] = {bw[gi][bj].x, bw[gi][bj].y, bw[gi][bj].z, bw[gi][bj].w}, pws[4] = {pw[gi][bj].x, pw[gi][bj].y, pw[gi][bj].z, pw[gi][bj].w};
                    f32x4 o[2];
#pragma unroll
                    for (int n = 0; n < 2; ++n)
#pragma unroll
                        for (int e = 0; e < 4; ++e) { const unsigned bb = bws[2 * n + (e >> 1)], pq = pws[2 * n + (e >> 1)];
                            const float bv = (e & 1) ? __builtin_bit_cast(float, bb & 0xffff0000u) : __builtin_bit_cast(float, bb << 16), pv = (e & 1) ? __builtin_bit_cast(float, pq & 0xffff0000u) : __builtin_bit_cast(float, pq << 16);
                            const float sg = __builtin_amdgcn_rcpf(1.0f + __builtin_amdgcn_exp2f(rs * acc[ai][bj][m][n][e])); o[n][e] = bv + sg * pv; }
                    *(f32x4*)(out + o2) = o[0]; *(f32x4*)(out + o2 + 4) = o[1]; } }
            asm volatile("" ::: "memory");
        }
    }
};

template <class Epi, class Sched, bool ALIGN_EPI = false, bool SP2 = false>
__device__ __forceinline__ void gemm_phase(PG8_LAS unsigned char* lds, const Gemm g, const Sched& S, const Epi& E) {
    int tid_ = threadIdx.x; asm volatile("" : "+v"(tid_));
    const int tid = tid_, wid = __builtin_amdgcn_readfirstlane(tid >> 6), lane = tid & 63, wr = wid >> 2, wc = wid & 3, fr = lane & 15, fq = lane >> 4;
    const int K = g.K, nt = K / BK;
    unsigned voffA[2], voffB[2];
#pragma unroll
    for (int i = 0; i < 2; ++i) { int R, C; stage_rc(tid * 16 + i * 8192, R, C); const int Rb = Epi::PERM ? ((R & ~31) + perm32(R & 31)) : R;
        voffA[i] = (unsigned)(R * K + C) * 2u; voffB[i] = (unsigned)(Rb * K + C) * 2u; }
    const size_t kstep = (size_t)(BK * 2);
    const size_t hstep = (size_t)HALF * K * 2;
    const size_t tstep = 2 * hstep;
    const unsigned ldsw = (unsigned)wid * 1024u;
    const int aoff = lds_byte(wr * 64 + fr, fq * 8), boff = lds_byte(wc * 32 + fr, fq * 8);
#define PG8_SA(b, h) (((b) * 2 + (h)) * HTB)
#define PG8_SB(b, h) ((4 + (b) * 2 + (h)) * HTB)
#define PG8_STAGE(bufoff, gbase, voff) do { _Pragma("unroll") for (int _i = 0; _i < 2; ++_i) \
        __builtin_amdgcn_global_load_lds((const unsigned*)((const char*)(gbase) + (voff)[_i]), (PG8_LAS unsigned*)(lds + (bufoff) + ldsw + _i * 8192), 16, 0, 0); } while (0)
#define PG8_LDA(dst, b, h) do { _Pragma("unroll") for (int m = 0; m < 4; ++m) _Pragma("unroll") for (int k = 0; k < 2; ++k) dst[m][k] = *(const PG8_LAS bf16x8*)(lds + PG8_SA(b, h) + aoff + m * 2048 + k * 1024); } while (0)
#define PG8_LDB(dst, b, h) do { _Pragma("unroll") for (int n = 0; n < 2; ++n) _Pragma("unroll") for (int k = 0; k < 2; ++k) dst[n][k] = *(const PG8_LAS bf16x8*)(lds + PG8_SB(b, h) + boff + n * 2048 + k * 1024); } while (0)
#ifndef PG8_BAL
#define PG8_BAL 1
#endif
#ifndef PG8_PRIO
#define PG8_PRIO 1
#endif
#define PG8_MMA(ai, bj, At, Bt) do { if (PG8_PRIO) __builtin_amdgcn_s_setprio(1); _Pragma("unroll") for (int m = 0; m < 4; ++m) _Pragma("unroll") for (int n = 0; n < 2; ++n) _Pragma("unroll") for (int k = 0; k < 2; ++k) \
        acc[ai][bj][m][n] = __builtin_amdgcn_mfma_f32_16x16x32_bf16(Bt[n][k], At[m][k], acc[ai][bj][m][n], 0, 0, 0); if (PG8_PRIO) __builtin_amdgcn_s_setprio(0); } while (0)
#define PG8_WAIT_V(n) asm volatile("s_waitcnt vmcnt(" #n ")" ::: "memory")
#define PG8_WAIT_L(n) asm volatile("s_waitcnt lgkmcnt(" #n ")" ::: "memory")
#define PG8_BAR __builtin_amdgcn_s_barrier()
#define PG8_SCHED __builtin_amdgcn_sched_barrier(0)
    Unit cur, nxt; int ui = 0;
    if (!S.next(0, cur)) return;
    f32x4 acc[2][2][4][2];
#pragma unroll
    for (int a = 0; a < 2; ++a)
#pragma unroll
        for (int b = 0; b < 2; ++b)
#pragma unroll
            for (int m = 0; m < 4; ++m)
#pragma unroll
                for (int n = 0; n < 2; ++n) acc[a][b][m][n] = (f32x4){0.f, 0.f, 0.f, 0.f};
    bf16x8 At[4][2], B0[2][2], B1[2][2];
    const char* cA = (const char*)g.A + (size_t)cur.pm * tstep; const char* cB = (const char*)g.Bt + (size_t)cur.pn * tstep;
    S.a_ready(cur);
    if constexpr (SP2) {
        PG8_STAGE(PG8_SB(0, 0), cB, voffB); PG8_STAGE(PG8_SB(0, 1), cB + hstep, voffB); PG8_STAGE(PG8_SA(0, 0), cA, voffA); PG8_STAGE(PG8_SA(0, 1), cA + hstep, voffA);
        if (wr == 1) PG8_BAR;
        PG8_WAIT_V(2); PG8_BAR;
#if PG8_BAL
        PG8_STAGE(PG8_SB(1, 0), cB + kstep, voffB); PG8_STAGE(PG8_SB(1, 1), cB + hstep + kstep, voffB);
        PG8_WAIT_V(4); PG8_BAR;
#else
        PG8_STAGE(PG8_SB(1, 0), cB + kstep, voffB); PG8_STAGE(PG8_SA(1, 0), cA + kstep, voffA); PG8_STAGE(PG8_SB(1, 1), cB + hstep + kstep, voffB);
        PG8_WAIT_V(6); PG8_BAR;
#endif
    } else {
        PG8_STAGE(PG8_SB(0, 0), cB, voffB); PG8_STAGE(PG8_SA(0, 0), cA, voffA); PG8_STAGE(PG8_SB(0, 1), cB + hstep, voffB); PG8_STAGE(PG8_SA(0, 1), cA + hstep, voffA);
        if (wr == 1) PG8_BAR;
        PG8_WAIT_V(4); PG8_BAR;
        PG8_STAGE(PG8_SB(1, 0), cB + kstep, voffB); PG8_STAGE(PG8_SA(1, 0), cA + kstep, voffA); PG8_STAGE(PG8_SB(1, 1), cB + hstep + kstep, voffB);
        PG8_WAIT_V(6); PG8_BAR;
    }
    for (;;) {
        const bool has_next = S.next(ui + 1, nxt);
        const char* nA = has_next ? (const char*)g.A + (size_t)nxt.pm * tstep : cA; const char* nB = has_next ? (const char*)g.Bt + (size_t)nxt.pn * tstep : cB;
        for (int t = 0; t < nt; t += 2) {
            const bool last = (t == nt - 2);
            const char* a1 = cA + (size_t)(t + 1) * kstep;
            const char* a2 = last ? nA : cA + (size_t)(t + 2) * kstep; const char* b2 = last ? nB : cB + (size_t)(t + 2) * kstep;
            const char* a3 = a2 + kstep; const char* b3 = b2 + kstep;
            if (last && has_next) S.a_ready(nxt);
            if constexpr (SP2) {
#if PG8_BAL
            PG8_LDB(B0, 0, 0); PG8_LDB(B1, 0, 1); PG8_SCHED; PG8_LDA(At, 0, 0); PG8_STAGE(PG8_SA(1, 0), a1, voffA); PG8_STAGE(PG8_SA(1, 1), a1 + hstep, voffA);
            PG8_WAIT_V(8); PG8_WAIT_L(0); PG8_BAR; PG8_MMA(0, 0, At, B0); PG8_MMA(0, 1, At, B1); PG8_BAR; PG8_SCHED;
            PG8_LDA(At, 0, 1); PG8_STAGE(PG8_SB(0, 0), b2, voffB); PG8_STAGE(PG8_SB(0, 1), b2 + hstep, voffB);
            PG8_WAIT_V(6); PG8_WAIT_L(0); PG8_BAR; PG8_MMA(1, 0, At, B0); PG8_MMA(1, 1, At, B1); PG8_BAR; PG8_SCHED;
            PG8_LDB(B0, 1, 0); PG8_LDB(B1, 1, 1); PG8_SCHED; PG8_LDA(At, 1, 0); PG8_STAGE(PG8_SA(0, 0), a2, voffA); PG8_STAGE(PG8_SA(0, 1), a2 + hstep, voffA);
            PG8_WAIT_V(8); PG8_WAIT_L(0); PG8_BAR; PG8_MMA(0, 0, At, B0); PG8_MMA(0, 1, At, B1); PG8_BAR; PG8_SCHED;
            PG8_LDA(At, 1, 1); PG8_STAGE(PG8_SB(1, 0), b3, voffB); PG8_STAGE(PG8_SB(1, 1), b3 + hstep, voffB);
            PG8_WAIT_V(6); PG8_WAIT_L(0); PG8_BAR; PG8_MMA(1, 0, At, B0); PG8_MMA(1, 1, At, B1); PG8_BAR; PG8_SCHED;
            (void)a3;
#else
            PG8_LDB(B0, 0, 0); PG8_LDB(B1, 0, 1); PG8_SCHED; PG8_LDA(At, 0, 0); PG8_STAGE(PG8_SA(1, 1), a1 + hstep, voffA);
            PG8_WAIT_V(8); PG8_WAIT_L(0); PG8_BAR; PG8_MMA(0, 0, At, B0); PG8_MMA(0, 1, At, B1); PG8_BAR; PG8_SCHED;
            PG8_LDA(At, 0, 1); PG8_STAGE(PG8_SB(0, 0), b2, voffB); PG8_STAGE(PG8_SB(0, 1), b2 + hstep, voffB); PG8_STAGE(PG8_SA(0, 0), a2, voffA);
            PG8_WAIT_V(8); PG8_WAIT_L(0); PG8_BAR; PG8_MMA(1, 0, At, B0); PG8_MMA(1, 1, At, B1); PG8_BAR; PG8_SCHED;
            PG8_LDB(B0, 1, 0); PG8_LDB(B1, 1, 1); PG8_SCHED; PG8_LDA(At, 1, 0); PG8_STAGE(PG8_SA(0, 1), a2 + hstep, voffA);
            PG8_WAIT_V(8); PG8_WAIT_L(0); PG8_BAR; PG8_MMA(0, 0, At, B0); PG8_MMA(0, 1, At, B1); PG8_BAR; PG8_SCHED;
            PG8_LDA(At, 1, 1); PG8_STAGE(PG8_SB(1, 0), b3, voffB); PG8_STAGE(PG8_SB(1, 1), b3 + hstep, voffB); PG8_STAGE(PG8_SA(1, 0), a3, voffA);
            PG8_WAIT_V(8); PG8_WAIT_L(0); PG8_BAR; PG8_MMA(1, 0, At, B0); PG8_MMA(1, 1, At, B1); PG8_BAR; PG8_SCHED;
#endif
            } else {
            PG8_LDB(B0, 0, 0); PG8_SCHED; PG8_LDA(At, 0, 0); PG8_STAGE(PG8_SA(1, 1), a1 + hstep, voffA);
            PG8_WAIT_L(8); PG8_BAR; PG8_WAIT_L(0); PG8_MMA(0, 0, At, B0); PG8_BAR; PG8_SCHED;
            PG8_LDB(B1, 0, 1); PG8_STAGE(PG8_SB(0, 0), b2, voffB);
            PG8_BAR; PG8_WAIT_L(0); PG8_MMA(0, 1, At, B1); PG8_BAR;
            PG8_LDA(At, 0, 1); PG8_STAGE(PG8_SA(0, 0), a2, voffA);
            PG8_BAR; PG8_WAIT_L(0); PG8_MMA(1, 0, At, B0); PG8_BAR; PG8_SCHED;
            PG8_STAGE(PG8_SB(0, 1), b2 + hstep, voffB);
            PG8_WAIT_V(6); PG8_BAR; PG8_MMA(1, 1, At, B1); PG8_BAR;
            PG8_LDB(B0, 1, 0); PG8_SCHED; PG8_LDA(At, 1, 0); PG8_STAGE(PG8_SA(0, 1), a2 + hstep, voffA);
            PG8_WAIT_L(8); PG8_BAR; PG8_WAIT_L(0); PG8_MMA(0, 0, At, B0); PG8_BAR; PG8_SCHED;
            PG8_LDB(B1, 1, 1); PG8_STAGE(PG8_SB(1, 0), b3, voffB);
            PG8_BAR; PG8_WAIT_L(0); PG8_MMA(0, 1, At, B1); PG8_BAR;
            PG8_LDA(At, 1, 1); PG8_STAGE(PG8_SA(1, 0), a3, voffA);
            PG8_BAR; PG8_WAIT_L(0); PG8_MMA(1, 0, At, B0); PG8_BAR; PG8_SCHED;
            PG8_STAGE(PG8_SB(1, 1), b3 + hstep, voffB);
            PG8_WAIT_V(6); PG8_BAR; PG8_MMA(1, 1, At, B1); PG8_BAR;
            }
        }
        if constexpr (ALIGN_EPI) { if (wr == 0) PG8_BAR; }
#ifdef PROBE_EPI
        unsigned long long te0_ = 0; if (g.tacc) te0_ = __builtin_amdgcn_s_memrealtime();
#endif
        if constexpr (!Epi::AFTER_DRAIN) { E(acc, cur, wr, wc, fr, fq); S.done(cur); }
#ifdef PROBE_EPI
        if (g.tacc && blockIdx.x == 0 && tid == 0) { *g.tacc += (unsigned)(__builtin_amdgcn_s_memrealtime() - te0_); }
#endif
        if (!has_next) break;
#pragma unroll
        for (int a = 0; a < 2; ++a)
#pragma unroll
            for (int b = 0; b < 2; ++b)
#pragma unroll
                for (int m = 0; m < 4; ++m)
#pragma unroll
                    for (int n = 0; n < 2; ++n) acc[a][b][m][n] = (f32x4){0.f, 0.f, 0.f, 0.f};
        cur = nxt; cA = nA; cB = nB; ++ui;
        if constexpr (ALIGN_EPI) { if (wr == 1) PG8_BAR; }
    }
    PG8_WAIT_V(0);
    if constexpr (!ALIGN_EPI) { if (wr == 0) PG8_BAR; }
    PG8_BAR;
    if constexpr (Epi::AFTER_DRAIN) { E.fused(acc, cur, wr, wc, fr, fq, lds, wid, lane); S.done(cur); }
#undef PG8_SA
#undef PG8_SB
#undef PG8_STAGE
#undef PG8_LDA
#undef PG8_LDB
#undef PG8_MMA
#undef PG8_WAIT_V
#undef PG8_WAIT_L
#undef PG8_BAR
#undef PG8_SCHED
}
}
#define GAS __attribute__((address_space(1)))
#define LAS __attribute__((address_space(3)))
typedef unsigned short bf16;
typedef unsigned v4u __attribute__((ext_vector_type(4)));
typedef float f32x4 __attribute__((ext_vector_type(4)));
typedef short bf16x8 __attribute__((ext_vector_type(8)));
typedef GAS unsigned gu32;
typedef GAS unsigned long long gu64;
#define RLX_AGENT __ATOMIC_RELAXED, __HIP_MEMORY_SCOPE_AGENT
#define LDS_WAIT() asm volatile("s_waitcnt lgkmcnt(0)" ::: "memory")
#define VM_WAIT() asm volatile("s_waitcnt vmcnt(0)" ::: "memory")
__device__ __forceinline__ unsigned long long rt() { return __builtin_amdgcn_s_memrealtime(); }
__device__ __forceinline__ unsigned f2bf(float f) { unsigned u = __builtin_bit_cast(unsigned, f); return (u + 0x7fffu + ((u >> 16) & 1u)) >> 16; }
__device__ __forceinline__ unsigned pk2(float lo, float hi) { return f2bf(lo) | (f2bf(hi) << 16); }

#define XB_TMO      128
#define XB_XCNT(j)  (256  + 64 * (j))
#define XB_XSUB(j)  (1280 + 64 * (j))
#define XB_XGEN(j)  (2304 + 64 * (j))
#define XB_TOP      3328
#define XB_TOPGEN   3392
#define XCD_BAR_WORDS 3456
#define XB_SPIN_CAP (1u << 18)

__device__ __forceinline__ unsigned xb_ld(unsigned* p)              { return __hip_atomic_load(p, __ATOMIC_RELAXED, __HIP_MEMORY_SCOPE_AGENT); }
__device__ __forceinline__ unsigned xb_add(unsigned* p, unsigned v) { return __hip_atomic_fetch_add(p, v, __ATOMIC_RELAXED, __HIP_MEMORY_SCOPE_AGENT); }
__device__ __forceinline__ unsigned xb_xcc_id() { return (unsigned)__builtin_amdgcn_s_getreg((3 << 11) | 20) & 0xFu; }
#define XB_SPIN(cond, bar) do { unsigned _sp = 0; while (cond) { __builtin_amdgcn_s_sleep(1); \
    if ((++_sp & 255u) == 0u) { if (xb_ld(&(bar)[XB_TMO])) break; if (_sp > XB_SPIN_CAP) { atomicAdd(&(bar)[XB_TMO], 1u); break; } } } } while (0)

struct XcdBarrier {
    unsigned* bar; unsigned x;
    volatile LAS unsigned* st;
};

__device__ __forceinline__ XcdBarrier xcd_barrier_post(unsigned* bar, volatile LAS unsigned* st) {
    XcdBarrier b; b.bar = bar; b.x = xb_xcc_id(); b.st = st;
    if (threadIdx.x == 0) (void)xb_add(&bar[XB_XCNT(b.x)], 1u);
    return b;
}
__device__ __forceinline__ void xcd_barrier_complete(unsigned* bar, unsigned x, unsigned& nloc, unsigned& nx) {
    const unsigned G = gridDim.x * gridDim.y * gridDim.z;
    unsigned sum, cnt, mine, sp = 0u;
    for (;;) {
        sum = 0u; cnt = 0u; mine = 0u;
#pragma unroll
        for (unsigned j = 0; j < 16; ++j) { const unsigned c = xb_ld(&bar[XB_XCNT(j)]); sum += c; cnt += (c > 0u) ? 1u : 0u; mine = (j == x) ? c : mine; }
        if (sum == G) break;
        __builtin_amdgcn_s_sleep(1);
        if ((++sp & 255u) == 0u) { if (xb_ld(&bar[XB_TMO])) break; if (sp > XB_SPIN_CAP) { atomicAdd(&bar[XB_TMO], 1u); break; } }
    }
    nloc = mine > 0u ? mine : 1u; nx = cnt > 0u ? cnt : 1u;
}

__device__ __forceinline__ void xcd_barrier(const XcdBarrier& b) {
    asm volatile("s_waitcnt vmcnt(0)" ::: "memory");
    __syncthreads();
    if (threadIdx.x == 0) {
        unsigned* bar = b.bar;
        __builtin_amdgcn_s_waitcnt(0);
        unsigned nloc = b.st[0], nx = b.st[1];
        if (nloc == 0u) { xcd_barrier_complete(bar, b.x, nloc, nx); b.st[0] = nloc; b.st[1] = nx; }
        const unsigned old = xb_add(&bar[XB_XSUB(b.x)], 1u);
        const unsigned gen = old / nloc;
        if (old + 1u == (gen + 1u) * nloc) {
            __builtin_amdgcn_fence(__ATOMIC_RELEASE, "agent");
            asm volatile("s_waitcnt vmcnt(0)" ::: "memory");
            const unsigned og = xb_add(&bar[XB_TOP], 1u);
            const unsigned tg = og / nx;
            if (og + 1u == (tg + 1u) * nx) xb_add(&bar[XB_TOPGEN], 1u);
            else XB_SPIN(xb_ld(&bar[XB_TOPGEN]) == tg, bar);
            __builtin_amdgcn_fence(__ATOMIC_ACQUIRE, "agent");
            xb_add(&bar[XB_XGEN(b.x)], 1u);
            asm volatile("s_waitcnt vmcnt(0)" ::: "memory");
        } else {
            XB_SPIN(xb_ld(&bar[XB_XGEN(b.x)]) == gen, bar);
            __builtin_amdgcn_fence(__ATOMIC_ACQUIRE, "agent");
            asm volatile("s_waitcnt vmcnt(0)" ::: "memory");
        }
    }
    __syncthreads();
}

constexpr int NWAVES = 8;
constexpr int BATCH = 4, SEQ = 8192, DM = 1024, MROWS = BATCH * SEQ, CONVW = 512, NHEAD = 8, HD = 64, ATTW = 512, INCOLS = 3072, DFF = 2816, PLED = 256;
constexpr float EPS = 1e-6f;
constexpr float LOG2E = 1.4426950408889634f;
constexpr size_t MiB = 1u << 20;
constexpr size_t WS_CTL = 0, CTL_ZERO_BYTES = 1 * MiB;
constexpr size_t WS_WIN = 2 * MiB, WS_WOUT = 8 * MiB, WS_WGU = 10 * MiB, WS_WDN = 21 * MiB, WS_WPG = 27 * MiB, WS_WPP = 29 * MiB;
constexpr size_t WS_H = 32 * MiB;
constexpr size_t WS_PB = 96 * MiB;
constexpr size_t WS_ZC = 112 * MiB;
constexpr size_t WS_Q = 208 * MiB, WS_K = 240 * MiB, WS_V = 272 * MiB;
constexpr size_t WS_OP = 304 * MiB;
constexpr size_t WS_LP = 400 * MiB;
constexpr size_t WS_Y = 404 * MiB;
constexpr size_t WS_U = 112 * MiB;
constexpr size_t WS_TOPG = 288 * MiB, WS_BOTG = 291 * MiB, WS_TOPU = 294 * MiB;
constexpr size_t WS_PP = 300 * MiB;
constexpr size_t WS_SS = 30 * MiB;
constexpr size_t WS_X2 = 364 * MiB;
constexpr size_t WS_END = 468 * MiB;
constexpr int CW_BAR = 4096;
constexpr int CW_Q0 = 64;
constexpr int RING_BYTES = 131072, LDSCTL_OFF = RING_BYTES, MISC_OFF = LDSCTL_OFF + 320, XCH_OFF = RING_BYTES + 4096  , LDS_BYTES = 147456;

__device__ __forceinline__ float wave_sum(float v) {
#pragma unroll
    for (int o = 1; o < 64; o <<= 1) v += __shfl_xor(v, o);
    return v;
}
__device__ __forceinline__ float wave_max(float v) {
#pragma unroll
    for (int o = 1; o < 64; o <<= 1) v = fmaxf(v, __shfl_xor(v, o));
    return v;
}
__device__ __forceinline__ unsigned cvtpk(float lo, float hi) { unsigned r; asm volatile("v_cvt_pk_bf16_f32 %0, %1, %2" : "=v"(r) : "v"(lo), "v"(hi)); return r; }
__device__ __forceinline__ float bflo(unsigned w) { return __builtin_bit_cast(float, w << 16); }
__device__ __forceinline__ float bfhi(unsigned w) { return __builtin_bit_cast(float, w & 0xffff0000u); }
__device__ __forceinline__ void unpack8(const v4u w, float (&f)[8]) { f[0] = bflo(w.x); f[1] = bfhi(w.x); f[2] = bflo(w.y); f[3] = bfhi(w.y); f[4] = bflo(w.z); f[5] = bfhi(w.z); f[6] = bflo(w.w); f[7] = bfhi(w.w); }
__device__ __forceinline__ v4u pack8f(const float (&f)[8]) { v4u w; w.x = cvtpk(f[0], f[1]); w.y = cvtpk(f[2], f[3]); w.z = cvtpk(f[4], f[5]); w.w = cvtpk(f[6], f[7]); return w; }
__device__ __forceinline__ void load8f(const float* p, float (&f)[8]) { const f32x4 a = *(const f32x4*)p, b = *(const f32x4*)(p + 4); f[0] = a[0]; f[1] = a[1]; f[2] = a[2]; f[3] = a[3]; f[4] = b[0]; f[5] = b[1]; f[6] = b[2]; f[7] = b[3]; }

__device__ __forceinline__ void p0_transpose_item(const float* W, int K, int N, bf16* WT, int drow0, LAS float* scr, int k0, int n0, int lane, const float* gain = nullptr) {
    f32x4 w[8]; float gk[8];
#pragma unroll
    for (int i = 0; i < 8; ++i) { const int kk = 8 * i + (lane >> 3); w[i] = *(const GAS f32x4*)(W + (size_t)(k0 + kk) * N + n0 + 4 * (lane & 7)); gk[i] = gain ? gain[k0 + kk] : 1.0f; }
#pragma unroll
    for (int i = 0; i < 8; ++i) { const int kk = 8 * i + (lane >> 3); LAS float* d = scr + kk * 33 + 4 * (lane & 7); d[0] = w[i].x * gk[i]; d[1] = w[i].y * gk[i]; d[2] = w[i].z * gk[i]; d[3] = w[i].w * gk[i]; }
    LDS_WAIT(); asm volatile("" ::: "memory");
    const int c = lane & 7;
#pragma unroll
    for (int j = 0; j < 4; ++j) { const int n = (lane >> 3) + 8 * j; const LAS float* s = scr + (8 * c) * 33 + n;
        v4u o; o.x = cvtpk(s[0 * 33], s[1 * 33]); o.y = cvtpk(s[2 * 33], s[3 * 33]); o.z = cvtpk(s[4 * 33], s[5 * 33]); o.w = cvtpk(s[6 * 33], s[7 * 33]);
        *(GAS v4u*)(WT + (size_t)(drow0 + n) * K + k0 + 8 * c) = o; }
    LDS_WAIT(); asm volatile("" ::: "memory");
}
__device__ __forceinline__ int map_in_row(int n0) {
    if (n0 < 1536) return n0;
    const int w = n0 - 1536, sec = w >> 8, within = w & 255, hl = within >> 6, dim = within & 63;
    return 1536 + 256 * sec + 128 * (dim >> 5) + 32 * hl + (dim & 31);
}
__device__ __forceinline__ void rms_row(const float* srow, const float* g, bf16* drow, int lane) {
    const GAS f32x4* xr = (const GAS f32x4*)srow + lane;
    f32x4 v[4]; float s = 0.f;
#pragma unroll
    for (int j = 0; j < 4; ++j) { v[j] = xr[64 * j]; s += (v[j].x * v[j].x + v[j].y * v[j].y) + (v[j].z * v[j].z + v[j].w * v[j].w); }
    const float rstd = __builtin_amdgcn_rsqf(wave_sum(s) * (1.f / DM) + EPS);
    GAS unsigned long long* o8 = (GAS unsigned long long*)drow + lane;
#pragma unroll
    for (int j = 0; j < 4; ++j) { const f32x4 gg = ((const GAS f32x4*)g)[lane + 64 * j];
        o8[64 * j] = (unsigned long long)cvtpk(v[j].x * rstd * gg.x, v[j].y * rstd * gg.y) | ((unsigned long long)cvtpk(v[j].z * rstd * gg.z, v[j].w * rstd * gg.w) << 32); }
}
__device__ __forceinline__ void rms_rows(const float* src, const float* g, bf16* dst, int gw, int NGW, int lane) {
    f32x4 gg[4];
#pragma unroll
    for (int j = 0; j < 4; ++j) gg[j] = ((const GAS f32x4*)g)[lane + 64 * j];
    for (int m = gw * 4; m < MROWS; m += NGW * 4) {
        f32x4 v[4][4]; float s[4];
#pragma unroll
        for (int r = 0; r < 4; ++r)
#pragma unroll
            for (int j = 0; j < 4; ++j) v[r][j] = ((const GAS f32x4*)(src + (size_t)(m + r) * DM))[lane + 64 * j];
#pragma unroll
        for (int r = 0; r < 4; ++r) { s[r] = 0.f;
#pragma unroll
            for (int j = 0; j < 4; ++j) s[r] += (v[r][j].x * v[r][j].x + v[r][j].y * v[r][j].y) + (v[r][j].z * v[r][j].z + v[r][j].w * v[r][j].w); }
#pragma unroll
        for (int o = 1; o < 64; o <<= 1) {
#pragma unroll
            for (int r = 0; r < 4; ++r) s[r] += __shfl_xor(s[r], o); }
#pragma unroll
        for (int r = 0; r < 4; ++r) { const float rstd = __builtin_amdgcn_rsqf(s[r] * (1.f / DM) + EPS);
            GAS unsigned long long* o8 = (GAS unsigned long long*)(dst + (size_t)(m + r) * DM) + lane;
#pragma unroll
            for (int j = 0; j < 4; ++j) o8[64 * j] = (unsigned long long)cvtpk(v[r][j].x * rstd * gg[j].x, v[r][j].y * rstd * gg[j].y) | ((unsigned long long)cvtpk(v[r][j].z * rstd * gg[j].z, v[r][j].w * rstd * gg[j].w) << 32); }
    }
}

namespace att {
typedef float f32x16 __attribute__((ext_vector_type(16)));
typedef short s16x4 __attribute__((ext_vector_type(4)));
typedef short v4i16_t __attribute__((ext_vector_type(4)));
__device__ __forceinline__ constexpr int cr(int r) { return (r & 3) + 8 * (r >> 2); }
__device__ __forceinline__ s16x4 vtr(LAS const unsigned char* p) { return __builtin_bit_cast(s16x4, __builtin_amdgcn_ds_read_tr16_b64_v4i16((LAS v4i16_t*)p)); }

constexpr int K_OFF = 0, V_OFF = 49152, O_OFF = 98304;
struct UnitP { int b, h, d, r, blk, branch; float cb; };
__device__ __forceinline__ UnitP unit_params(int u) {
    UnitP p; const int bh = u / 96, u96 = u % 96, within = u96 & 31; p.branch = u96 >> 5;
    p.d = 1 << (2 * p.branch); const int nblk = 32 >> (2 * p.branch); p.r = within / nblk; p.blk = within % nblk; p.b = bh >> 3; p.h = bh & 7;
    p.cb = __builtin_amdgcn_exp2f(-(float)(p.h + 1)) * (float)p.d * LOG2E; return p;
}
struct Stage { v4u k[6], v[6]; bf16x8 q[4]; };
__device__ __forceinline__ void stage_load(Stage& st, const bf16* Qg, const bf16* Kg, const bf16* Vg, const UnitP& p, int tid, int wave, int lane) {
    const size_t hb = (size_t)(p.b * NHEAD + p.h) * SEQ * HD; const bf16* Kh = Kg + hb; const bf16* Vh = Vg + hb; const bf16* Qh = Qg + hb;
    const int lbase = p.blk * 256 - 128;
#pragma unroll
    for (int it = 0; it < 6; ++it) { const int idx = tid + 512 * it, row = idx >> 3, c = idx & 7; int l = lbase + row; l = l < 0 ? 0 : l;
        const size_t off = (size_t)(p.r + p.d * l) * HD + 8 * c; st.k[it] = *(const GAS v4u*)(Kh + off); st.v[it] = *(const GAS v4u*)(Vh + off); }
    const int pq = p.r + p.d * (p.blk * 256 + 32 * wave + (lane & 31));
#pragma unroll
    for (int s = 0; s < 4; ++s) st.q[s] = *(const GAS bf16x8*)(Qh + (size_t)pq * HD + 16 * s + 8 * (lane >> 5));
}
__device__ __forceinline__ void stage_write(const Stage& st, LAS unsigned char* L, int tid) {
#pragma unroll
    for (int it = 0; it < 6; ++it) { const int idx = tid + 512 * it, row = idx >> 3, c = idx & 7;
        *(LAS v4u*)(L + K_OFF + row * 128 + ((c ^ (row & 7)) << 4)) = st.k[it];
        *(LAS v4u*)(L + V_OFF + ((row >> 4) * 2 + (c >> 2)) * 1024 + (row & 15) * 64 + (c & 3) * 16) = st.v[it]; }
}
__device__ __forceinline__ void compute_tile(LAS unsigned char* L, const bf16x8 (&qf)[4], const UnitP& p, bf16* OPb, float* LPb, float negM, int wave, int lane) {
    const int r32 = lane & 31, hi = lane >> 5;
    const int l0 = p.blk * 256 + 32 * wave, d = p.d, r = p.r; const float cb = p.cb;
    const int pq = r + d * (l0 + r32);
    const int kb0 = l0 >= 128 ? 0 : ((128 - l0) >> 5);
    f32x16 o0, o1;
#pragma unroll
    for (int i = 0; i < 16; ++i) { o0[i] = 0.f; o1[i] = 0.f; }
    float lsum = 0.f;
    const int i4 = r32 - 4 * hi;
    const int laneoff = ((lane >> 4) & 1) * 32 + (lane & 3) * 8 + (4 * hi + ((lane & 15) >> 2)) * 64;
#pragma unroll
    for (int kb = 0; kb < 5; ++kb) if (kb >= kb0) {
        const int row = 32 * (wave + kb) + r32;
        bf16x8 kf[4];
#pragma unroll
        for (int s = 0; s < 4; ++s) kf[s] = *(LAS const bf16x8*)(L + K_OFF + row * 128 + (((2 * s + hi) ^ (row & 7)) << 4));
        const float lt = negM - cb * (float)(128 + r32 - 32 * kb - 4 * hi);
        f32x16 sacc;
#pragma unroll
        for (int i = 0; i < 16; ++i) sacc[i] = __builtin_fmaf(cb, (float)cr(i), lt);
#if ATT_PRIO == 2
        __builtin_amdgcn_s_setprio(1);
#endif
#pragma unroll
        for (int s = 0; s < 4; ++s) sacc = __builtin_amdgcn_mfma_f32_32x32x16_bf16(kf[s], qf[s], sacc, 0, 0, 0);
#if ATT_PRIO == 2
        __builtin_amdgcn_s_setprio(0);
#endif
        float pe[16];
#pragma unroll
        for (int i = 0; i < 16; ++i) pe[i] = __builtin_amdgcn_exp2f(sacc[i]);
        if (kb == 0) {
#pragma unroll
            for (int i = 0; i < 16; ++i) pe[i] = (cr(i) >= i4) ? pe[i] : 0.f;
        }
        if (kb == 4) {
#pragma unroll
            for (int i = 0; i < 16; ++i) pe[i] = (cr(i) <= i4) ? pe[i] : 0.f;
        }
        float ps = 0.f;
#pragma unroll
        for (int i = 0; i < 16; ++i) ps += pe[i];
        lsum += ps;
        v4u pw0, pw1;
        pw0.x = cvtpk(pe[0], pe[1]); pw0.y = cvtpk(pe[2], pe[3]); pw0.z = cvtpk(pe[4], pe[5]); pw0.w = cvtpk(pe[6], pe[7]);
        pw1.x = cvtpk(pe[8], pe[9]); pw1.y = cvtpk(pe[10], pe[11]); pw1.z = cvtpk(pe[12], pe[13]); pw1.w = cvtpk(pe[14], pe[15]);
        const bf16x8 pa0 = __builtin_bit_cast(bf16x8, pw0), pa1 = __builtin_bit_cast(bf16x8, pw1);
        LAS const unsigned char* vb = L + V_OFF + (wave + kb) * 4096 + laneoff;
#pragma unroll
        for (int d0 = 0; d0 < 2; ++d0) {
            const s16x4 a_lo = vtr(vb + d0 * 1024), a_hi = vtr(vb + d0 * 1024 + 512), b_lo = vtr(vb + 2048 + d0 * 1024), b_hi = vtr(vb + 2048 + d0 * 1024 + 512);
            const bf16x8 v0 = (bf16x8){a_lo[0], a_lo[1], a_lo[2], a_lo[3], a_hi[0], a_hi[1], a_hi[2], a_hi[3]};
            const bf16x8 v1 = (bf16x8){b_lo[0], b_lo[1], b_lo[2], b_lo[3], b_hi[0], b_hi[1], b_hi[2], b_hi[3]};
            if (d0 == 0) { o0 = __builtin_amdgcn_mfma_f32_32x32x16_bf16(pa0, v0, o0, 0, 0, 0); o0 = __builtin_amdgcn_mfma_f32_32x32x16_bf16(pa1, v1, o0, 0, 0, 0); }
            else         { o1 = __builtin_amdgcn_mfma_f32_32x32x16_bf16(pa0, v0, o1, 0, 0, 0); o1 = __builtin_amdgcn_mfma_f32_32x32x16_bf16(pa1, v1, o1, 0, 0, 0); }
        }
    }
    lsum += __shfl_xor(lsum, 32);
    if (hi == 0) LPb[(size_t)(p.b * SEQ + pq) * NHEAD + p.h] = lsum;
    LAS unsigned short* stg = (LAS unsigned short*)(L + O_OFF + wave * 4096);
#pragma unroll
    for (int i = 0; i < 16; ++i) { const int q = cr(i) + 4 * hi;
        stg[q * 64 + r32] = (unsigned short)(cvtpk(o0[i], o0[i]) & 0xffffu); stg[q * 64 + 32 + r32] = (unsigned short)(cvtpk(o1[i], o1[i]) & 0xffffu); }
    LDS_WAIT(); asm volatile("" ::: "memory");
#pragma unroll
    for (int it = 0; it < 4; ++it) { const int row = it * 8 + (lane >> 3), ch = lane & 7;
        const v4u v = *(LAS const v4u*)(stg + row * 64 + ch * 8);
        *(GAS v4u*)(OPb + (size_t)(p.b * SEQ + r + d * (l0 + row)) * ATTW + p.h * HD + ch * 8) = v; }
    LDS_WAIT(); asm volatile("" ::: "memory");
}
}

#ifndef DUP_MASK
#define DUP_MASK 0
#endif
#ifndef ATT_PRIO
#define ATT_PRIO 1
#endif
#ifndef WGM_P1
#define WGM_P1 4
#endif
#ifndef WGM_P4
#define WGM_P4 4
#endif
#ifndef WGM_P6
#define WGM_P6 4
#endif
#ifndef WGM_P8
#define WGM_P8 4
#endif
#ifndef WGM_P10
#define WGM_P10 4
#endif
#ifndef PROBE_AMP
#define PROBE_AMP 4
#endif
#ifndef PROBE_BLK
#define PROBE_BLK 0
#endif
#ifdef PROBE_EPI
#define PROBE_EPI_SET(n) if ((n) == PROBE_EPI) g.tacc = (unsigned*)(ws_ + WS_CTL) + 8;
#else
#define PROBE_EPI_SET(n)
#endif
#ifndef PG8_SP2
#define PG8_SP2 true
#endif
struct Args { const float* in[20]; float* out; unsigned char* ws; };
enum { I_X = 0, I_P, I_GMIX, I_WIN, I_CONVW, I_CONVB, I_QG, I_KG, I_GOC, I_GOA, I_WOUT, I_GFFN, I_WGATE, I_WUP, I_FCW, I_FCB, I_WDOWN, I_GPLE, I_WPG, I_WPP };

#define PHASE_PTRS KARG_DECL unsigned char* const ws_ = ARG_WS(); float* const out = ARG_OUT(); (void)out; \
    bf16* const WIN = (bf16*)(ws_ + WS_WIN); bf16* const WOUT = (bf16*)(ws_ + WS_WOUT); bf16* const WGU = (bf16*)(ws_ + WS_WGU); bf16* const WDN = (bf16*)(ws_ + WS_WDN); bf16* const WPG = (bf16*)(ws_ + WS_WPG); bf16* const WPP = (bf16*)(ws_ + WS_WPP); \
    bf16* const HB = (bf16*)(ws_ + WS_H); bf16* const PB = (bf16*)(ws_ + WS_PB); bf16* const ZC = (bf16*)(ws_ + WS_ZC); bf16* const QB = (bf16*)(ws_ + WS_Q); bf16* const KB = (bf16*)(ws_ + WS_K); bf16* const VB = (bf16*)(ws_ + WS_V); \
    bf16* const OP = (bf16*)(ws_ + WS_OP); float* const LP = (float*)(ws_ + WS_LP); bf16* const YB = (bf16*)(ws_ + WS_Y); bf16* const UB = (bf16*)(ws_ + WS_U); float* const TOPG = (float*)(ws_ + WS_TOPG); float* const BOTG = (float*)(ws_ + WS_BOTG); float* const TOPU = (float*)(ws_ + WS_TOPU); (void)TOPG; (void)BOTG; (void)TOPU; bf16* const PP = (bf16*)(ws_ + WS_PP); float* const SSB = (float*)(ws_ + WS_SS); (void)SSB; bf16* const X2B = (bf16*)(ws_ + WS_X2); (void)X2B; \
    (void)WIN; (void)WOUT; (void)WGU; (void)WDN; (void)WPG; (void)WPP; (void)HB; (void)PB; (void)ZC; (void)QB; (void)KB; (void)VB; (void)OP; (void)LP; (void)YB; (void)UB; (void)PP;
#define CAS __attribute__((address_space(4)))
#define ARG_IN(i) (*(const float* const CAS*)(ka_ + 8 * (i)))
#define ARG_OUT() (*(float* const CAS*)(ka_ + 8 * 20))
#define ARG_WS() (*(unsigned char* const CAS*)(ka_ + 8 * 21))
#define KARG_DECL const CAS unsigned char* ka_ = (const CAS unsigned char*)__builtin_amdgcn_kernarg_segment_ptr(); asm volatile("" : "+s"(ka_));
__device__ __forceinline__ int wave_pull(unsigned* ctr, int lane) {
    unsigned v = 0u;
    if (lane == 0) v = __hip_atomic_fetch_add(ctr, 1u, __ATOMIC_RELAXED, __HIP_MEMORY_SCOPE_AGENT);
    return (int)__builtin_amdgcn_readfirstlane((int)v);
}
__device__ __forceinline__ void phase_stagger(int g, int ng, unsigned ticks) {
    if (g > 0) { const unsigned long long t0 = __builtin_amdgcn_s_memrealtime(); const unsigned long long wait = (unsigned long long)ticks * (unsigned)g / (unsigned)ng;
        while (__builtin_amdgcn_s_memrealtime() - t0 < wait) __builtin_amdgcn_s_sleep(16); }
}
#ifndef STAG6
#define STAG6 1000
#endif
#ifndef STAG6_NG
#define STAG6_NG 2
#endif
__device__ __forceinline__ void phase0(LAS unsigned char* L, const int lane, const int wave, const int G, const int bx, const int vcu, const int gw, const int NGW) {
    { PHASE_PTRS
    {
        LAS float* scr = (LAS float*)(L + wave * 16384);
        constexpr int I_IN = 16 * 96, I_OUT = 16 * 32, I_GT = 16 * 88, I_DN = 44 * 32, I_PG = 16 * 32, I_PPJ = 4 * 32;
        constexpr int NITEMS = I_IN + I_OUT + 2 * I_GT + I_DN + I_PG + I_PPJ;
        for (int it = gw; it < NITEMS; it += NGW) {
            int r = it;
            if (r < I_IN) { const int kb = r / 96, n0 = 32 * (r % 96); p0_transpose_item(ARG_IN(I_WIN), DM, INCOLS, WIN, map_in_row(n0), scr, 64 * kb, n0, lane); continue; } r -= I_IN;
            if (r < I_OUT) { const int kb = r / 32, n0 = 32 * (r % 32); p0_transpose_item(ARG_IN(I_WOUT), DM, DM, WOUT, n0, scr, 64 * kb, n0, lane); continue; } r -= I_OUT;
            if (r < I_GT) { const int kb = r / 88, n0 = 32 * (r % 88); p0_transpose_item(ARG_IN(I_WGATE), DM, DFF, WGU, 256 * (n0 >> 7) + (n0 & 127), scr, 64 * kb, n0, lane, ARG_IN(I_GFFN)); continue; } r -= I_GT;
            if (r < I_GT) { const int kb = r / 88, n0 = 32 * (r % 88); p0_transpose_item(ARG_IN(I_WUP), DM, DFF, WGU, 256 * (n0 >> 7) + 128 + (n0 & 127), scr, 64 * kb, n0, lane, ARG_IN(I_GFFN)); continue; } r -= I_GT;
            if (r < I_DN) { const int kb = r / 32, n0 = 32 * (r % 32); p0_transpose_item(ARG_IN(I_WDOWN), DFF, DM, WDN, n0, scr, 64 * kb, n0, lane); continue; } r -= I_DN;
            if (r < I_PG) { const int kb = r / 32, n0 = 32 * (r % 32); p0_transpose_item(ARG_IN(I_WPG), DM, DM, WPG, n0, scr, 64 * kb, n0, lane, ARG_IN(I_GPLE)); continue; } r -= I_PG;
            { const int kb = r / 32, n0 = 32 * (r % 32); p0_transpose_item(ARG_IN(I_WPP), PLED, DM, WPP, n0, scr, 64 * kb, n0, lane); }
        }
        rms_rows(ARG_IN(I_X), ARG_IN(I_GMIX), HB, gw, NGW, lane);
        for (int m = gw * 8; m < MROWS; m += NGW * 8) {
            f32x4 v[8];
#pragma unroll
            for (int r = 0; r < 8; ++r) v[r] = ((const GAS f32x4*)(ARG_IN(I_P) + (size_t)(m + r) * PLED))[lane];
#pragma unroll
            for (int r = 0; r < 8; ++r) ((GAS unsigned long long*)(PB + (size_t)(m + r) * PLED))[lane] = (unsigned long long)cvtpk(v[r].x, v[r].y) | ((unsigned long long)cvtpk(v[r].z, v[r].w) << 32);
        }
    }
    }
}
__device__ __forceinline__ void phase1(LAS unsigned char* L, const int lane, const int wave, const int G, const int bx, const int vcu, const int gw, const int NGW) {
    { PHASE_PTRS
    {
        int kdim_ = DM; asm volatile("" : "+s"(kdim_)); pg8::Gemm g{HB, WIN, MROWS, INCOLS, kdim_}; PROBE_EPI_SET(1) pg8::StaticOrder S; S.init(MROWS, INCOLS, G, bx, WGM_P1);
        pg8::EpiInProj E{ZC, QB, KB, VB, ARG_IN(I_QG), ARG_IN(I_KG), 0.125f * LOG2E, EPS};
        pg8::gemm_phase<pg8::EpiInProj, pg8::StaticOrder, true, PG8_SP2>(L, g, S, E);
    }
    }
}
__device__ __forceinline__ void phase2(LAS unsigned char* L, const int lane, const int wave, const int G, const int bx, const int vcu, const int gw, const int NGW) {
    { PHASE_PTRS
    {
        const float mq = wave_max(fabsf(ARG_IN(I_QG)[lane])), mk = wave_max(fabsf(ARG_IN(I_KG)[lane]));
        const float negM = -8.0f * mq * mk * LOG2E;
        const int nper = 3072 / G, tid = threadIdx.x;
#define ATT_UNIT(i) ((G == 256) ? ((4 * (vcu >> 5) + (i) / 3) * 96 + ((i) % 3) * 32 + (vcu & 31)) : (vcu * nper + (i)))
#if ATT_PRIO == 1
        if (wave >= 4) __builtin_amdgcn_s_setprio(1);
#endif
        att::Stage st; att::UnitP p = att::unit_params(ATT_UNIT(0));
        att::stage_load(st, QB, KB, VB, p, tid, wave, lane);
        for (int i = 0; i < nper; ++i) {
#if defined(PROBE_ATT) && PROBE_ATT == 2
            const unsigned long long tw0_ = __builtin_amdgcn_s_memrealtime();
#endif
            att::stage_write(st, L, tid);
            bf16x8 qf[4];
#pragma unroll
            for (int s = 0; s < 4; ++s) qf[s] = st.q[s];
            asm volatile("s_waitcnt lgkmcnt(0)" ::: "memory"); __builtin_amdgcn_s_barrier(); asm volatile("" ::: "memory");
#if defined(PROBE_ATT) && PROBE_ATT == 2
            if (bx == PROBE_BLK && tid == 0) __hip_atomic_fetch_add((unsigned*)(ws_ + WS_CTL) + 8, (unsigned)(__builtin_amdgcn_s_memrealtime() - tw0_), __ATOMIC_RELAXED, __HIP_MEMORY_SCOPE_AGENT);
#endif
            att::UnitP pn = p;
            if (i + 1 < nper) { pn = att::unit_params(ATT_UNIT(i + 1)); att::stage_load(st, QB, KB, VB, pn, tid, wave, lane); }
#if defined(PROBE_ATT) && PROBE_ATT == 1
            const unsigned long long ta0_ = __builtin_amdgcn_s_memrealtime();
#endif
            att::compute_tile(L, qf, p, OP + (size_t)p.branch * MROWS * ATTW, LP + (size_t)p.branch * MROWS * NHEAD, negM, wave, lane);
#if defined(PROBE_ATT) && PROBE_ATT == 1
            if (bx == PROBE_BLK && tid == 0) __hip_atomic_fetch_add((unsigned*)(ws_ + WS_CTL) + 8, (unsigned)(__builtin_amdgcn_s_memrealtime() - ta0_), __ATOMIC_RELAXED, __HIP_MEMORY_SCOPE_AGENT);
#endif
            asm volatile("s_waitcnt lgkmcnt(0)" ::: "memory"); __builtin_amdgcn_s_barrier(); asm volatile("" ::: "memory");
            p = pn;
        }
#if ATT_PRIO == 1
        __builtin_amdgcn_s_setprio(0);
#endif
    }
    }
}
__device__ __forceinline__ void phase3(LAS unsigned char* L, const int lane, const int wave, const int G, const int bx, const int vcu, const int gw, const int NGW) {
    { PHASE_PTRS
    {
        const int c = 8 * lane;
        float cw0[8], cw1[8], cw2[8], cbv[8], gc[8], ga[8];
        load8f(ARG_IN(I_CONVW) + c, cw0); load8f(ARG_IN(I_CONVW) + CONVW + c, cw1); load8f(ARG_IN(I_CONVW) + 2 * CONVW + c, cw2);
        load8f(ARG_IN(I_CONVB) + c, cbv); load8f(ARG_IN(I_GOC) + c, gc); load8f(ARG_IN(I_GOA) + c, ga);
        for (int ch = gw; ch < MROWS / 16; ch += NGW) {
            const int m0 = ch * 16;
            float u1[8], u2[8];
            if ((m0 & (SEQ - 1)) == 0) {
#pragma unroll
                for (int j = 0; j < 8; ++j) { u1[j] = 0.f; u2[j] = 0.f; }
            } else {
                float a[8], bb[8];
                unpack8(*(const GAS v4u*)(ZC + (size_t)(m0 - 1) * 1536 + 512 + c), a); unpack8(*(const GAS v4u*)(ZC + (size_t)(m0 - 1) * 1536 + 1024 + c), bb);
#pragma unroll
                for (int j = 0; j < 8; ++j) u1[j] = a[j] * bb[j];
                unpack8(*(const GAS v4u*)(ZC + (size_t)(m0 - 2) * 1536 + 512 + c), a); unpack8(*(const GAS v4u*)(ZC + (size_t)(m0 - 2) * 1536 + 1024 + c), bb);
#pragma unroll
                for (int j = 0; j < 8; ++j) u2[j] = a[j] * bb[j];
            }
            for (int tt = 0; tt < 16; ++tt) {
                const size_t m = (size_t)(m0 + tt);
                float zb[8], zc[8], zx[8], y[8];
                unpack8(*(const GAS v4u*)(ZC + m * 1536 + c), zb); unpack8(*(const GAS v4u*)(ZC + m * 1536 + 512 + c), zc); unpack8(*(const GAS v4u*)(ZC + m * 1536 + 1024 + c), zx);
                float o1[8], o2[8], o3[8];
                unpack8(*(const GAS v4u*)(OP + m * ATTW + c), o1); unpack8(*(const GAS v4u*)(OP + ((size_t)MROWS + m) * ATTW + c), o2); unpack8(*(const GAS v4u*)(OP + ((size_t)2 * MROWS + m) * ATTW + c), o3);
                const float lt = LP[m * NHEAD + (lane >> 3)] + LP[((size_t)MROWS + m) * NHEAD + (lane >> 3)] + LP[((size_t)2 * MROWS + m) * NHEAD + (lane >> 3)];
                float ss = 0.f;
#pragma unroll
                for (int j = 0; j < 8; ++j) { const float u0 = zc[j] * zx[j]; y[j] = zb[j] * (cw0[j] * u2[j] + cw1[j] * u1[j] + cw2[j] * u0 + cbv[j]); ss += y[j] * y[j]; u2[j] = u1[j]; u1[j] = u0; }
                const float rc = __builtin_amdgcn_rsqf(wave_sum(ss) * (1.f / CONVW) + EPS);
#pragma unroll
                for (int j = 0; j < 8; ++j) y[j] = y[j] * rc * gc[j];
                *(GAS v4u*)(YB + m * DM + c) = pack8f(y);
                const float rl = 1.0f / lt; float sa = 0.f;
#pragma unroll
                for (int j = 0; j < 8; ++j) { y[j] = (o1[j] + o2[j] + o3[j]) * rl; sa += y[j] * y[j]; }
                const float ra = __builtin_amdgcn_rsqf(wave_sum(sa) * (1.f / ATTW) + EPS);
#pragma unroll
                for (int j = 0; j < 8; ++j) y[j] = y[j] * ra * ga[j];
                *(GAS v4u*)(YB + m * DM + CONVW + c) = pack8f(y);
            }
        }
    }
    }
}
__device__ __forceinline__ void phase4(LAS unsigned char* L, const int lane, const int wave, const int G, const int bx, const int vcu, const int gw, const int NGW) {
    for (int s_ = 0; s_ < 2; ++s_) {
        if (s_ == 0) { PHASE_PTRS
            int kdim_ = DM; asm volatile("" : "+s"(kdim_)); pg8::Gemm g{YB, WOUT, MROWS, DM, kdim_}; PROBE_EPI_SET(4) pg8::StaticOrder S; S.init(MROWS, DM, G, bx, WGM_P4);
            pg8::EpiResNorm<false> E{ARG_IN(I_X), HB, SSB, DM, (LAS float*)(L + XCH_OFF)};
            pg8::gemm_phase<pg8::EpiResNorm<false>, pg8::StaticOrder, true, PG8_SP2>(L, g, S, E);
        } else { PHASE_PTRS
            int kdim_ = PLED; asm volatile("" : "+s"(kdim_)); pg8::Gemm g{PB, WPP, MROWS, DM, kdim_}; PROBE_EPI_SET(4) pg8::StaticOrder S; S.init(MROWS, DM, G, bx, WGM_P4);
            pg8::EpiBf16 E{PP, DM};
            pg8::gemm_phase<pg8::EpiBf16, pg8::StaticOrder, true, PG8_SP2>(L, g, S, E);
        }
    }
}
__device__ __forceinline__ void phase6(LAS unsigned char* L, const int lane, const int wave, const int G, const int bx, const int vcu, const int gw, const int NGW) {
    { PHASE_PTRS
    {
        int kdim_ = DM; asm volatile("" : "+s"(kdim_)); pg8::Gemm g{HB, WGU, MROWS, 2 * DFF, kdim_}; PROBE_EPI_SET(6) pg8::StaticOrder S; S.init(MROWS, 2 * DFF, G, bx, WGM_P6);
        pg8::EpiGUAct E{UB, DFF, SSB, EPS, ARG_IN(I_FCW), ARG_IN(I_FCB), TOPG, BOTG, TOPU, (LAS float*)(L + XCH_OFF)};
        pg8::gemm_phase<pg8::EpiGUAct, pg8::StaticOrder, true, PG8_SP2>(L, g, S, E);
    }
    }
}
__device__ __forceinline__ void ffn_fix_rows(const float* fcw, const float* fcb, const float* TOPG, const float* BOTG, const float* TOPU, bf16* UB, int pm, int c) {
    float w0[8], w1[8], w2[8], bv[8], g0[8], g1[8], gm1[8], gm2[8], u0[8], u1[8], a0[8], a1[8];
    load8f(fcw + c, w0); load8f(fcw + DFF + c, w1); load8f(fcw + 2 * DFF + c, w2); load8f(fcb + c, bv);
    load8f(TOPG + (size_t)(pm * 2) * DFF + c, g0); load8f(TOPG + (size_t)(pm * 2 + 1) * DFF + c, g1);
    load8f(BOTG + (size_t)(pm * 2 - 2) * DFF + c, gm2); load8f(BOTG + (size_t)(pm * 2 - 1) * DFF + c, gm1);
    load8f(TOPU + (size_t)(pm * 2) * DFF + c, u0); load8f(TOPU + (size_t)(pm * 2 + 1) * DFF + c, u1);
#pragma unroll
    for (int j = 0; j < 8; ++j) {
        const float p0 = w0[j] * gm2[j] + w1[j] * gm1[j] + w2[j] * g0[j] + bv[j], p1 = w0[j] * gm1[j] + w1[j] * g0[j] + w2[j] * g1[j] + bv[j];
        a0[j] = p0 * __builtin_amdgcn_rcpf(1.0f + __builtin_amdgcn_exp2f(-LOG2E * p0)) * u0[j];
        a1[j] = p1 * __builtin_amdgcn_rcpf(1.0f + __builtin_amdgcn_exp2f(-LOG2E * p1)) * u1[j];
    }
    *(GAS v4u*)(UB + (size_t)(pm * 256) * DFF + c) = pack8f(a0);
    *(GAS v4u*)(UB + (size_t)(pm * 256 + 1) * DFF + c) = pack8f(a1);
}
__device__ __forceinline__ void phase8(LAS unsigned char* L, const int lane, const int wave, const int G, const int bx, const int vcu, const int gw, const int NGW) {
    { PHASE_PTRS
    {
        int kdim_ = DFF; asm volatile("" : "+s"(kdim_)); pg8::Gemm g{UB, WDN, MROWS, DM, kdim_}; PROBE_EPI_SET(8) pg8::StaticOrder S; S.init(MROWS, DM, G, bx, WGM_P8);
        { const int tid = threadIdx.x; pg8::Unit fu; int prev = -1;
          for (int i = 0; S.next(i, fu); ++i) { if (fu.pm != prev && (fu.pm & 31) != 0 && 8 * tid < DFF) ffn_fix_rows(ARG_IN(I_FCW), ARG_IN(I_FCB), TOPG, BOTG, TOPU, UB, fu.pm, 8 * tid); prev = fu.pm; }
          asm volatile("s_waitcnt vmcnt(0)" ::: "memory"); __syncthreads(); }
        pg8::EpiResNorm<true> E{HB, X2B, SSB, DM, (LAS float*)(L + XCH_OFF)};
        pg8::gemm_phase<pg8::EpiResNorm<true>, pg8::StaticOrder, true, PG8_SP2>(L, g, S, E);
    }
    }
}
__device__ __forceinline__ void phase10(LAS unsigned char* L, const int lane, const int wave, const int G, const int bx, const int vcu, const int gw, const int NGW) {
    { PHASE_PTRS
    {
        int kdim_ = DM; asm volatile("" : "+s"(kdim_)); pg8::Gemm g{X2B, WPG, MROWS, DM, kdim_}; PROBE_EPI_SET(10) pg8::StaticOrder S; S.init(MROWS, DM, G, bx, WGM_P10);
        pg8::EpiPle E{X2B, out, PP, DM, SSB, EPS};
        pg8::gemm_phase<pg8::EpiPle, pg8::StaticOrder, true, PG8_SP2>(L, g, S, E);
    }
    }
}

#if defined(PROBE_CLK)
#define PROBE_T0(n) unsigned long long tp0_##n = 0; if ((n) == PROBE_CLK) tp0_##n = __builtin_amdgcn_s_memtime();
#define PROBE_T1(n) if ((n) == PROBE_CLK && bx == PROBE_BLK && tid == 0) { __hip_atomic_fetch_add((unsigned*)(ctl + 8), (unsigned)((__builtin_amdgcn_s_memtime() - tp0_##n) / 25), __ATOMIC_RELAXED, __HIP_MEMORY_SCOPE_AGENT); }
#elif defined(PROBE_PHASE)
#define PROBE_T0(n) unsigned long long tp0_##n = 0; if ((n) == PROBE_PHASE) tp0_##n = __builtin_amdgcn_s_memrealtime();
#define PROBE_T1(n) if ((n) == PROBE_PHASE && bx == PROBE_BLK && tid == 0) { __hip_atomic_fetch_add((unsigned*)(ctl + 8), (unsigned)(__builtin_amdgcn_s_memrealtime() - tp0_##n), __ATOMIC_RELAXED, __HIP_MEMORY_SCOPE_AGENT); }
#else
#define PROBE_T0(n)
#define PROBE_T1(n)
#endif
#ifdef PROBE_BAR
#define XBAR() do { const unsigned long long tb0_ = __builtin_amdgcn_s_memrealtime(); xcd_barrier(bar); ++nbar_; if ((PROBE_BAR == 99 || nbar_ == PROBE_BAR) && bx == PROBE_BLK && tid == 0) __hip_atomic_fetch_add((unsigned*)(ctl + 8), (unsigned)(__builtin_amdgcn_s_memrealtime() - tb0_), __ATOMIC_RELAXED, __HIP_MEMORY_SCOPE_AGENT); } while (0)
#else
#define XBAR() xcd_barrier(bar)
#endif
__global__ void __launch_bounds__(NWAVES * 64, 2) hybrid_fwd(Args args) {
    extern __shared__ __attribute__((aligned(16))) unsigned char lds[];
    LAS unsigned char* L = (LAS unsigned char*)lds;
    volatile LAS unsigned* MISC = (volatile LAS unsigned*)(L + MISC_OFF);
    const int tid = threadIdx.x, lane = tid & 63, wave = __builtin_amdgcn_readfirstlane(tid >> 6);
    const int G = gridDim.x; const int bx = blockIdx.x;
    const int vcu = (G % 8 == 0) ? (bx % 8) * (G / 8) + bx / 8 : bx;
    const int gw = vcu * NWAVES + wave, NGW = G * NWAVES;
    gu32* ctl; { KARG_DECL ctl = (gu32*)(ARG_WS() + WS_CTL); }
    for (int u = tid; u < (LDS_BYTES - LDSCTL_OFF) / 4; u += NWAVES * 64) ((LAS unsigned*)(L + LDSCTL_OFF))[u] = 0u;
    __syncthreads();
    XcdBarrier bar = xcd_barrier_post((unsigned*)(ctl + CW_BAR), MISC + 8);
#ifdef PROBE_TOTAL
    const unsigned long long tt0_ = __builtin_amdgcn_s_memrealtime();
#endif
#ifdef PROBE_BAR
    int nbar_ = 0;
#endif

#ifndef SKIP_P0
    PROBE_T0(0) phase0(L, lane, wave, G, bx, vcu, gw, NGW); PROBE_T1(0)
#endif
    XBAR();
#if (DUP_MASK >> 0) & 1
    phase0(L, lane, wave, G, bx, vcu, gw, NGW);
    XBAR();
#endif
#ifdef EXTRA_BARRIERS
    { int nb_ = EXTRA_BARRIERS; asm volatile("" : "+s"(nb_)); for (int eb_ = 0; eb_ < nb_; ++eb_) xcd_barrier(bar); }
#endif

#ifndef SKIP_P1
    PROBE_T0(1) phase1(L, lane, wave, G, bx, vcu, gw, NGW); PROBE_T1(1)
#endif
    XBAR();
#if (DUP_MASK >> 1) & 1
    phase1(L, lane, wave, G, bx, vcu, gw, NGW);
    XBAR();
#endif

#ifndef SKIP_P2
    PROBE_T0(2) phase2(L, lane, wave, G, bx, vcu, gw, NGW); PROBE_T1(2)
#endif
    XBAR();
#if (DUP_MASK >> 2) & 1
    phase2(L, lane, wave, G, bx, vcu, gw, NGW);
    XBAR();
#endif

#ifndef SKIP_P3
    PROBE_T0(3) phase3(L, lane, wave, G, bx, vcu, gw, NGW); PROBE_T1(3)
#endif
    XBAR();
#if (DUP_MASK >> 3) & 1
    phase3(L, lane, wave, G, bx, vcu, gw, NGW);
    XBAR();
#endif

#ifndef SKIP_P4
    PROBE_T0(4) phase4(L, lane, wave, G, bx, vcu, gw, NGW); PROBE_T1(4)
#endif
    XBAR();
#if (DUP_MASK >> 4) & 1
    phase4(L, lane, wave, G, bx, vcu, gw, NGW);
    XBAR();
#endif

#ifndef SKIP_P6
    PROBE_T0(6) phase6(L, lane, wave, G, bx, vcu, gw, NGW); PROBE_T1(6)
#endif
    XBAR();
#if (DUP_MASK >> 6) & 1
    phase6(L, lane, wave, G, bx, vcu, gw, NGW);
    XBAR();
#endif


#ifndef SKIP_P8
    PROBE_T0(8) phase8(L, lane, wave, G, bx, vcu, gw, NGW); PROBE_T1(8)
#endif
    XBAR();
#if (DUP_MASK >> 8) & 1
    phase8(L, lane, wave, G, bx, vcu, gw, NGW);
    XBAR();
#endif


#ifndef SKIP_P10
    PROBE_T0(10) phase10(L, lane, wave, G, bx, vcu, gw, NGW); PROBE_T1(10)
#endif
#if (DUP_MASK >> 10) & 1
    XBAR();
    phase10(L, lane, wave, G, bx, vcu, gw, NGW);
#endif
#ifdef PROBE_TOTAL
    if (bx == PROBE_BLK && tid == 0) __hip_atomic_fetch_add((unsigned*)(ctl + 8), (unsigned)(__builtin_amdgcn_s_memrealtime() - tt0_), __ATOMIC_RELAXED, __HIP_MEMORY_SCOPE_AGENT);
#endif
#if defined(PROBE_PHASE) || defined(PROBE_EPI) || defined(PROBE_BAR) || defined(PROBE_CLK) || defined(PROBE_ATT) || defined(PROBE_TOTAL)
    if (bx == PROBE_BLK && tid == 0) { const unsigned tk = __hip_atomic_load((unsigned*)(ctl + 8), __ATOMIC_RELAXED, __HIP_MEMORY_SCOPE_AGENT); const unsigned long long t0 = __builtin_amdgcn_s_memrealtime();
        while (__builtin_amdgcn_s_memrealtime() - t0 < (unsigned long long)tk * PROBE_AMP) __builtin_amdgcn_s_sleep(32); }
#endif
}

extern "C" void kernel_launch(void* const* d_in, const int* in_sizes, int n_in, void* d_out, int out_size, void* d_ws, size_t ws_size, hipStream_t stream) {
    static int grid = 0;
    if (grid == 0) {
        if (n_in != 20 || out_size != MROWS * DM || ws_size < WS_END) { fprintf(stderr, "kernel_launch: unexpected shapes (n_in %d, out %d, ws %zu); nothing launched\n", n_in, out_size, ws_size); grid = -1; return; }
        int dev = 0, cus = 0, per_cu = 0;
        if (hipGetDevice(&dev) != hipSuccess || hipDeviceGetAttribute(&cus, hipDeviceAttributeMultiprocessorCount, dev) != hipSuccess) { grid = -1; return; }
        if (hipFuncSetAttribute((const void*)hybrid_fwd, hipFuncAttributeMaxDynamicSharedMemorySize, LDS_BYTES) != hipSuccess) { fprintf(stderr, "kernel_launch: hipFuncSetAttribute failed\n"); grid = -1; return; }
        if (hipOccupancyMaxActiveBlocksPerMultiprocessor(&per_cu, (const void*)hybrid_fwd, NWAVES * 64, LDS_BYTES) != hipSuccess || per_cu < 1)
            fprintf(stderr, "kernel_launch: note: occupancy query reports %d workgroups per CU\n", per_cu);
        (void)hipGetLastError();
        grid = cus;
        if (grid != 256) fprintf(stderr, "kernel_launch: %d CUs (built for 256)\n", grid);
    }
    if (grid < 0) return;
    if (hipMemsetAsync((char*)d_ws + WS_CTL, 0, CTL_ZERO_BYTES, stream) != hipSuccess) { fprintf(stderr, "kernel_launch: hipMemsetAsync failed\n"); return; }
    Args a{};
    for (int i = 0; i < 20; ++i) a.in[i] = (const float*)d_in[i];
    a.out = (float*)d_out; a.ws = (unsigned char*)d_ws;
    hipLaunchKernelGGL(hybrid_fwd, dim3(grid), dim3(NWAVES * 64), LDS_BYTES, stream, a);
    const hipError_t le = hipPeekAtLastError();
    if (le != hipSuccess) fprintf(stderr, "kernel_launch: launch failed: %s\n", hipGetErrorName(le));
}
```

```cpp
#include <hip/hip_runtime.h>
#include <cstdio>
#include <cstdint>
namespace pg8 {
#define PG8_LAS __attribute__((address_space(3)))
typedef unsigned short bf16_t;
typedef short bf16x8 __attribute__((ext_vector_type(8)));
typedef float f32x4 __attribute__((ext_vector_type(4)));
typedef unsigned u32x4 __attribute__((ext_vector_type(4)));
constexpr int BM = 256, BK = 64, HALF = 128, HTB = HALF * BK * 2  , STAGE_BYTES = 8 * HTB, NXCD = 8;
#ifndef PG8_WGM
#define PG8_WGM 4
#endif
constexpr int WGM = PG8_WGM;

__host__ __device__ __forceinline__ int lds_byte(int r, int c) { const int st = (r >> 4) * 2 + (c >> 5), rr = r & 15, cc = c & 31, ob = rr * 64 + cc * 2; return st * 1024 + (ob ^ (((ob >> 9) & 1) << 5)); }
__host__ __device__ __forceinline__ void stage_rc(int b, int& R, int& C) { const int st = b / 1024, sb = b % 1024, swz = sb ^ (((sb >> 9) & 1) << 5); R = (st >> 1) * 16 + swz / 64; C = (st & 1) * 32 + (swz % 64) / 2; }
__host__ __device__ __forceinline__ int perm32(int rho) { const int n = rho >> 4, i = rho & 15; return 8 * (i >> 2) + 4 * n + (i & 3); }

struct Unit { int pm, pn; };
struct Gemm { const bf16_t* A; const bf16_t* Bt; int M, N, K; unsigned* tacc = nullptr; };

struct StaticOrder {
    int nM, nN, nwg, G, c, wgm;
    __host__ __device__ void init(int M, int N, int G_, int c_, int wgm_ = WGM) { nM = M / BM; nN = N / BM; nwg = nM * nN; G = G_; c = c_; wgm = wgm_; }
    __host__ __device__ bool next(int i, Unit& u) const {
        const long L = (long)i * G + c; if (L >= nwg) return false;
        int wgid = (int)L; { const int q = nwg / NXCD, r = nwg % NXCD, xcd = wgid % NXCD, off = wgid / NXCD; wgid = (xcd < r ? xcd * (q + 1) : r * (q + 1) + (xcd - r) * q) + off; }
        const int nig = wgm * nN, gid = wgid / nig, fm = gid * wgm, gsz = (nM - fm) < wgm ? (nM - fm) : wgm;
        u.pm = fm + ((wgid % nig) % gsz); u.pn = (wgid % nig) / gsz; return true;
    }
    __device__ __forceinline__ void a_ready(const Unit&) const {}
    __device__ __forceinline__ void done(const Unit&) const {}
};

#ifndef EPI_NT
#define EPI_NT 0
#endif
__device__ __forceinline__ unsigned cvt_pk_bf16(float lo, float hi) { unsigned r; asm volatile("v_cvt_pk_bf16_f32 %0, %1, %2" : "=v"(r) : "v"(lo), "v"(hi)); return r; }
__device__ __forceinline__ u32x4 pack8(const f32x4& v0, const f32x4& v1) { u32x4 w; w.x = cvt_pk_bf16(v0[0], v0[1]); w.y = cvt_pk_bf16(v0[2], v0[3]); w.z = cvt_pk_bf16(v1[0], v1[1]); w.w = cvt_pk_bf16(v1[2], v1[3]); return w; }
__device__ __forceinline__ float bf2f(unsigned short h) { return __builtin_bit_cast(float, (unsigned)h << 16); }

struct EpiBf16 {
    static constexpr bool PERM = true, AFTER_DRAIN = false;
    bf16_t* O; int ldc;
    __device__ __forceinline__ void operator()(const f32x4 (&acc)[2][2][4][2], const Unit& u, int wr, int wc, int fr, int fq) const {
        const int row0 = u.pm * BM + wr * 64 + fr, col0 = u.pn * BM + wc * 32 + 8 * fq;
#pragma unroll
        for (int ai = 0; ai < 2; ++ai)
#pragma unroll
            for (int m = 0; m < 4; ++m) { bf16_t* rowp = O + (size_t)(row0 + ai * HALF + m * 16) * ldc + col0;
#pragma unroll
                for (int bj = 0; bj < 2; ++bj) *(u32x4*)(rowp + bj * HALF) = pack8(acc[ai][bj][m][0], acc[ai][bj][m][1]); }
    }
};
__device__ __forceinline__ float rstd4(const f32x4 a, float eps) { return __builtin_amdgcn_rsqf(((a[0] + a[1]) + (a[2] + a[3])) * (1.0f / 1024.0f) + eps); }
struct EpiGU {
    static constexpr bool PERM = true, AFTER_DRAIN = false;
    bf16_t* G; bf16_t* U; int ldc; const float* SS; float eps;
    __device__ __forceinline__ void operator()(const f32x4 (&acc)[2][2][4][2], const Unit& u, int wr, int wc, int fr, int fq) const {
        const int row0 = u.pm * BM + wr * 64 + fr, col0 = u.pn * HALF + wc * 32 + 8 * fq;
        f32x4 sp[2][4];
#pragma unroll
        for (int ai = 0; ai < 2; ++ai)
#pragma unroll
            for (int m = 0; m < 4; ++m) sp[ai][m] = *(const f32x4*)(SS + (size_t)(row0 + ai * HALF + m * 16) * 4);
#pragma unroll
        for (int ai = 0; ai < 2; ++ai)
#pragma unroll
            for (int m = 0; m < 4; ++m) { const int row = row0 + ai * HALF + m * 16; const float rs = rstd4(sp[ai][m], eps); const size_t off = (size_t)row * ldc + col0;
                *(u32x4*)(G + off) = pack8(acc[ai][0][m][0] * rs, acc[ai][0][m][1] * rs);
                *(u32x4*)(U + off) = pack8(acc[ai][1][m][0] * rs, acc[ai][1][m][1] * rs); }
    }
};
__device__ __forceinline__ float dpp_ror1(float v) { return __builtin_bit_cast(float, __builtin_amdgcn_mov_dpp(__builtin_bit_cast(int, v), 0x121, 0xf, 0xf, false)); }
__device__ __forceinline__ float dpp_ror2(float v) { return __builtin_bit_cast(float, __builtin_amdgcn_mov_dpp(__builtin_bit_cast(int, v), 0x122, 0xf, 0xf, false)); }
struct EpiGUAct {
    static constexpr bool PERM = true, AFTER_DRAIN = false;
    bf16_t* ACT; int ldc; const float* SS; float eps; const float* cw; const float* cbias; float* TOPG; float* BOTG; float* TOPU; PG8_LAS float* xch;
    __device__ __forceinline__ void operator()(const f32x4 (&acc_)[2][2][4][2], const Unit& u, int wr, int wc, int fr, int fq) const {
        f32x4 (&acc)[2][2][4][2] = const_cast<f32x4 (&)[2][2][4][2]>(acc_);
        const int row0 = u.pm * BM + wr * 64 + fr, colh = wc * 32 + 8 * fq, col0 = u.pn * HALF + colh;
        {
            f32x4 sp[2][4];
#pragma unroll
            for (int ai = 0; ai < 2; ++ai)
#pragma unroll
                for (int m = 0; m < 4; ++m) sp[ai][m] = *(const f32x4*)(SS + (size_t)(row0 + ai * HALF + m * 16) * 4);
#pragma unroll
            for (int ai = 0; ai < 2; ++ai)
#pragma unroll
                for (int m = 0; m < 4; ++m) { const float rs = rstd4(sp[ai][m], eps);
#pragma unroll
                    for (int bj = 0; bj < 2; ++bj)
#pragma unroll
                        for (int n = 0; n < 2; ++n) acc[ai][bj][m][n] = acc[ai][bj][m][n] * rs; }
        }
        if (fr >= 14) {
#pragma unroll
            for (int ai = 0; ai < 2; ++ai)
#pragma unroll
                for (int n = 0; n < 2; ++n) *(PG8_LAS f32x4*)(xch + (((wr * 2 + ai) * 2 + (fr - 14)) * 128 + colh + 4 * n)) = acc[ai][0][3][n];
            if (wr == 1) {
#pragma unroll
                for (int n = 0; n < 2; ++n) *(f32x4*)(BOTG + (size_t)(u.pm * 2 + fr - 14) * ldc + col0 + 4 * n) = acc[1][0][3][n];
            }
        }
        if (wr == 0 && fr < 2) {
#pragma unroll
            for (int n = 0; n < 2; ++n) { *(f32x4*)(TOPG + (size_t)(u.pm * 2 + fr) * ldc + col0 + 4 * n) = acc[0][0][0][n]; *(f32x4*)(TOPU + (size_t)(u.pm * 2 + fr) * ldc + col0 + 4 * n) = acc[0][1][0][n]; }
        }
        asm volatile("s_waitcnt lgkmcnt(0)" ::: "memory"); __builtin_amdgcn_s_barrier(); asm volatile("" ::: "memory");
        typedef unsigned u32x2v __attribute__((ext_vector_type(2)));
#pragma unroll
        for (int n = 0; n < 2; ++n) {
            const f32x4 w0 = *(const f32x4*)(cw + col0 + 4 * n), w1 = *(const f32x4*)(cw + ldc + col0 + 4 * n), w2 = *(const f32x4*)(cw + 2 * ldc + col0 + 4 * n), bb = *(const f32x4*)(cbias + col0 + 4 * n);
#pragma unroll
            for (int ai = 0; ai < 2; ++ai) {
                f32x4 r1p, r2p;
                if (wr == 0 && ai == 0) { r1p = (f32x4){0.f, 0.f, 0.f, 0.f}; r2p = (f32x4){0.f, 0.f, 0.f, 0.f}; }
                else {
                    const int pw = wr ^ 1, pai = (wr == 1) ? ai : ai - 1;
                    const PG8_LAS float* xb = xch + ((pw * 2 + pai) * 2) * 128 + colh + 4 * n;
                    const f32x4 e2 = *(const PG8_LAS f32x4*)(xb), e1 = *(const PG8_LAS f32x4*)(xb + 128); r1p = e1; r2p = (fr == 0) ? e2 : e1;
                }
#pragma unroll
                for (int m = 0; m < 4; ++m) {
                    const f32x4 g = acc[ai][0][m][n], uu = acc[ai][1][m][n];
                    f32x4 r1, r2, a4;
#pragma unroll
                    for (int j = 0; j < 4; ++j) { r1[j] = dpp_ror1(g[j]); r2[j] = dpp_ror2(g[j]); }
#pragma unroll
                    for (int j = 0; j < 4; ++j) {
                        const float p1 = (fr == 0) ? r1p[j] : r1[j], p2 = (fr < 2) ? r2p[j] : r2[j];
                        const float pre = w0[j] * p2 + w1[j] * p1 + w2[j] * g[j] + bb[j];
                        a4[j] = pre * __builtin_amdgcn_rcpf(1.0f + __builtin_amdgcn_exp2f(-1.4426950408889634f * pre)) * uu[j];
                    }
                    r1p = r1; r2p = r2;
                    u32x2v w; w.x = cvt_pk_bf16(a4[0], a4[1]); w.y = cvt_pk_bf16(a4[2], a4[3]);
#if EPI_NT
                    __builtin_nontemporal_store(w, (u32x2v*)(ACT + (size_t)(row0 + ai * HALF + m * 16) * ldc + col0 + 4 * n));
#else
                    *(u32x2v*)(ACT + (size_t)(row0 + ai * HALF + m * 16) * ldc + col0 + 4 * n) = w;
#endif
                    asm volatile("" ::: "memory");
                }
            }
        }
    }
};
struct EpiInProj {
    static constexpr bool PERM = true, AFTER_DRAIN = false;
    bf16_t* ZC; bf16_t* Q; bf16_t* Kk; bf16_t* V; const float* gq; const float* gk; float qscale; float eps;
    __device__ __forceinline__ void operator()(const f32x4 (&acc)[2][2][4][2], const Unit& u, int wr, int wc, int fr, int fq) const {
        if (u.pn < 6) {
            const int row0 = u.pm * BM + wr * 64 + fr, col0 = u.pn * BM + wc * 32 + 8 * fq;
#pragma unroll
            for (int ai = 0; ai < 2; ++ai)
#pragma unroll
                for (int m = 0; m < 4; ++m) { bf16_t* rowp = ZC + (size_t)(row0 + ai * HALF + m * 16) * 1536 + col0;
#pragma unroll
                    for (int bj = 0; bj < 2; ++bj) *(u32x4*)(rowp + bj * HALF) = pack8(acc[ai][bj][m][0], acc[ai][bj][m][1]); }
        } else {
            const int sec = u.pn - 6, which = sec >> 1, head = 4 * (sec & 1) + wc;
            if (which < 2) {
                bf16_t* base = which == 0 ? Q : Kk;
                const float* g = which == 0 ? gq : gk;
                const float sc = which == 0 ? qscale : 1.f;
                const f32x4 g00 = *(const f32x4*)(g + 8 * fq), g01 = *(const f32x4*)(g + 8 * fq + 4), g10 = *(const f32x4*)(g + 32 + 8 * fq), g11 = *(const f32x4*)(g + 32 + 8 * fq + 4);
#pragma unroll
                for (int ai = 0; ai < 2; ++ai)
#pragma unroll
                    for (int m = 0; m < 4; ++m) {
                        const int row = u.pm * BM + ai * HALF + wr * 64 + m * 16 + fr, b = row >> 13, t = row & 8191;
                        float ss = 0.f;
#pragma unroll
                        for (int bj = 0; bj < 2; ++bj)
#pragma unroll
                            for (int n = 0; n < 2; ++n) { const f32x4 x = acc[ai][bj][m][n]; ss += (x[0] * x[0] + x[1] * x[1]) + (x[2] * x[2] + x[3] * x[3]); }
                        ss += __shfl_xor(ss, 16); ss += __shfl_xor(ss, 32);
                        const float rs = sc * __builtin_amdgcn_rsqf(ss * (1.0f / 64.0f) + eps);
                        bf16_t* dst = base + ((size_t)((b * 8 + head) * 8192 + t)) * 64 + 8 * fq;
                        *(u32x4*)(dst) = pack8(acc[ai][0][m][0] * rs * g00, acc[ai][0][m][1] * rs * g01);
                        *(u32x4*)(dst + 32) = pack8(acc[ai][1][m][0] * rs * g10, acc[ai][1][m][1] * rs * g11);
                    }
            } else {
#pragma unroll
                for (int ai = 0; ai < 2; ++ai)
#pragma unroll
                    for (int m = 0; m < 4; ++m) {
                        const int row = u.pm * BM + ai * HALF + wr * 64 + m * 16 + fr, b = row >> 13, t = row & 8191;
                        bf16_t* dst = V + ((size_t)((b * 8 + head) * 8192 + t)) * 64 + 8 * fq;
                        *(u32x4*)(dst) = pack8(acc[ai][0][m][0], acc[ai][0][m][1]);
                        *(u32x4*)(dst + 32) = pack8(acc[ai][1][m][0], acc[ai][1][m][1]);
                    }
            }
        }
    }
};
template <bool BASE_BF16> struct EpiResNorm {
    static constexpr bool PERM = true, AFTER_DRAIN = false;
    const void* base; bf16_t* XB; float* SS; int ldc; PG8_LAS float* red;
    __device__ __forceinline__ void operator()(const f32x4 (&acc)[2][2][4][2], const Unit& u, int wr, int wc, int fr, int fq) const {
        const int row0 = u.pm * BM + wr * 64 + fr, col0 = u.pn * BM + wc * 32 + 8 * fq;
        constexpr int NB = BASE_BF16 ? 1 : 2, GPB = 8 / NB;
#pragma unroll
        for (int bt = 0; bt < NB; ++bt) {
            u32x4 pb[GPB][2]; f32x4 pf[BASE_BF16 ? 1 : GPB][2][2];
#pragma unroll
            for (int gi = 0; gi < GPB; ++gi) { const int g8 = bt * GPB + gi, ai = g8 >> 2, m = g8 & 3; const size_t off = (size_t)(row0 + ai * HALF + m * 16) * ldc + col0;
#pragma unroll
                for (int bj = 0; bj < 2; ++bj) {
                    if constexpr (BASE_BF16) pb[gi][bj] = *(const u32x4*)((const bf16_t*)base + off + bj * HALF);
                    else { pf[gi][bj][0] = *(const f32x4*)((const float*)base + off + bj * HALF); pf[gi][bj][1] = *(const f32x4*)((const float*)base + off + bj * HALF + 4); } } }
#pragma unroll
            for (int gi = 0; gi < GPB; ++gi) { const int g8 = bt * GPB + gi, ai = g8 >> 2, m = g8 & 3; const int row = row0 + ai * HALF + m * 16; const size_t off = (size_t)row * ldc + col0; float ss = 0.f;
#pragma unroll
                for (int bj = 0; bj < 2; ++bj) {
                    f32x4 b0, b1;
                    if constexpr (BASE_BF16) { const u32x4 w = pb[gi][bj];
                        b0[0] = __builtin_bit_cast(float, w.x << 16); b0[1] = __builtin_bit_cast(float, w.x & 0xffff0000u); b0[2] = __builtin_bit_cast(float, w.y << 16); b0[3] = __builtin_bit_cast(float, w.y & 0xffff0000u);
                        b1[0] = __builtin_bit_cast(float, w.z << 16); b1[1] = __builtin_bit_cast(float, w.z & 0xffff0000u); b1[2] = __builtin_bit_cast(float, w.w << 16); b1[3] = __builtin_bit_cast(float, w.w & 0xffff0000u); }
                    else { b0 = pf[gi][bj][0]; b1 = pf[gi][bj][1]; }
                    const f32x4 x0 = b0 + acc[ai][bj][m][0], x1 = b1 + acc[ai][bj][m][1];
                    *(u32x4*)(XB + off + bj * HALF) = pack8(x0, x1);
                    ss += ((x0[0] * x0[0] + x0[1] * x0[1]) + (x0[2] * x0[2] + x0[3] * x0[3])) + ((x1[0] * x1[0] + x1[1] * x1[1]) + (x1[2] * x1[2] + x1[3] * x1[3]));
                }
                ss += __shfl_xor(ss, 16); ss += __shfl_xor(ss, 32);
                if (fq == 0) red[(ai * HALF + wr * 64 + m * 16 + fr) * 4 + wc] = ss; }
            asm volatile("" ::: "memory");
        }
        asm volatile("s_waitcnt lgkmcnt(0)" ::: "memory"); __builtin_amdgcn_s_barrier(); asm volatile("" ::: "memory");
        { const int t = threadIdx.x; if (t < 256) { const f32x4 v = *(const PG8_LAS f32x4*)(red + t * 4); SS[(size_t)(u.pm * BM + t) * 4 + u.pn] = (v[0] + v[1]) + (v[2] + v[3]); } }
        asm volatile("s_waitcnt lgkmcnt(0)" ::: "memory"); __builtin_amdgcn_s_barrier(); asm volatile("" ::: "memory");
    }
};
struct EpiPle {
    static constexpr bool PERM = true, AFTER_DRAIN = false;
    const bf16_t* xb; float* out; const bf16_t* pp; int ldc; const float* SS; float eps;
    __device__ __forceinline__ void operator()(const f32x4 (&acc)[2][2][4][2], const Unit& u, int wr, int wc, int fr, int fq) const {
        const int row0 = u.pm * BM + wr * 64 + fr, col0 = u.pn * BM + wc * 32 + 8 * fq;
        float rsv[8];
        {
            f32x4 sp[8];
#pragma unroll
            for (int g8 = 0; g8 < 8; ++g8) sp[g8] = *(const f32x4*)(SS + (size_t)(row0 + (g8 >> 2) * HALF + (g8 & 3) * 16) * 4);
#pragma unroll
            for (int g8 = 0; g8 < 8; ++g8) rsv[g8] = -1.4426950408889634f * rstd4(sp[g8], eps);
        }
        asm volatile("" ::: "memory");
#pragma unroll
        for (int bt = 0; bt < 4; ++bt) {
            u32x4 bw[2][2], pw[2][2];
#pragma unroll
            for (int gi = 0; gi < 2; ++gi) { const int g8 = bt * 2 + gi; const size_t off = (size_t)(row0 + (g8 >> 2) * HALF + (g8 & 3) * 16) * ldc + col0;
#pragma unroll
                for (int bj = 0; bj < 2; ++bj) { bw[gi][bj] = *(const u32x4*)(xb + off + bj * HALF); pw[gi][bj] = *(const u32x4*)(pp + off + bj * HALF); } }
#pragma unroll
            for (int gi = 0; gi < 2; ++gi) { const int g8 = bt * 2 + gi, ai = g8 >> 2, m = g8 & 3; const size_t off = (size_t)(row0 + ai * HALF + m * 16) * ldc + col0; const float rs = rsv[g8];
#pragma unroll
                for (int bj = 0; bj < 2; ++bj) { const size_t o2 = off + bj * HALF;
                    const unsigned bws[4] = {bw[gi][bj].x, bw[gi][bj].y, bw[gi][bj].z, bw[gi][bj].w}, pws[4] = {pw[gi][bj].x, pw[gi][bj].y, pw[gi][bj].z, pw[gi][bj].w};
                    f32x4 o[2];
#pragma unroll
                    for (int n = 0; n < 2; ++n)
#pragma unroll
                        for (int e = 0; e < 4; ++e) { const unsigned bb = bws[2 * n + (e >> 1)], pq = pws[2 * n + (e >> 1)];
                            const float bv = (e & 1) ? __builtin_bit_cast(float, bb & 0xffff0000u) : __builtin_bit_cast(float, bb << 16), pv = (e & 1) ? __builtin_bit_cast(float, pq & 0xffff0000u) : __builtin_bit_cast(float, pq << 16);
                            const float sg = __builtin_amdgcn_rcpf(1.0f + __builtin_amdgcn_exp2f(rs * acc[ai][bj][m][n][e])); o[n][e] = bv + sg * pv; }
                    *(f32x4*)(out + o2) = o[0]; *(f32x4*)(out + o2 + 4) = o[1]; } }
            asm volatile("" ::: "memory");
        }
    }
};

template <class Epi, class Sched, bool ALIGN_EPI = false, bool SP2 = false>
__device__ __forceinline__ void gemm_phase(PG8_LAS unsigned char* lds, const Gemm g, const Sched& S, const Epi& E) {
    int tid_ = threadIdx.x; asm volatile("" : "+v"(tid_));
    const int tid = tid_, wid = __builtin_amdgcn_readfirstlane(tid >> 6), lane = tid & 63, wr = wid >> 2, wc = wid & 3, fr = lane & 15, fq = lane >> 4;
    const int K = g.K, nt = K / BK;
    unsigned voffA[2], voffB[2];
#pragma unroll
    for (int i = 0; i < 2; ++i) { int R, C; stage_rc(tid * 16 + i * 8192, R, C); const int Rb = Epi::PERM ? ((R & ~31) + perm32(R & 31)) : R;
        voffA[i] = (unsigned)(R * K + C) * 2u; voffB[i] = (unsigned)(Rb * K + C) * 2u; }
    const size_t kstep = (size_t)(BK * 2);
    const size_t hstep = (size_t)HALF * K * 2;
    const size_t tstep = 2 * hstep;
    const unsigned ldsw = (unsigned)wid * 1024u;
    const int aoff = lds_byte(wr * 64 + fr, fq * 8), boff = lds_byte(wc * 32 + fr, fq * 8);
#define PG8_SA(b, h) (((b) * 2 + (h)) * HTB)
#define PG8_SB(b, h) ((4 + (b) * 2 + (h)) * HTB)
#define PG8_STAGE(bufoff, gbase, voff) do { _Pragma("unroll") for (int _i = 0; _i < 2; ++_i) \
        __builtin_amdgcn_global_load_lds((const unsigned*)((const char*)(gbase) + (voff)[_i]), (PG8_LAS unsigned*)(lds + (bufoff) + ldsw + _i * 8192), 16, 0, 0); } while (0)
#define PG8_LDA(dst, b, h) do { _Pragma("unroll") for (int m = 0; m < 4; ++m) _Pragma("unroll") for (int k = 0; k < 2; ++k) dst[m][k] = *(const PG8_LAS bf16x8*)(lds + PG8_SA(b, h) + aoff + m * 2048 + k * 1024); } while (0)
#define PG8_LDB(dst, b, h) do { _Pragma("unroll") for (int n = 0; n < 2; ++n) _Pragma("unroll") for (int k = 0; k < 2; ++k) dst[n][k] = *(const PG8_LAS bf16x8*)(lds + PG8_SB(b, h) + boff + n * 2048 + k * 1024); } while (0)
#ifndef PG8_KOUT
#define PG8_KOUT 0
#endif
#ifndef PG8_ORD
#define PG8_ORD 0
#endif
#ifndef PG8_BAL
#define PG8_BAL 1
#endif
#ifndef PG8_PRIO_LOAD
#define PG8_PRIO_LOAD 0
#endif
#ifndef PG8_PRIO
#define PG8_PRIO 1
#endif
#if PG8_KOUT
#define PG8_MMA(ai, bj, At, Bt) do { if (PG8_PRIO) __builtin_amdgcn_s_setprio(PG8_PRIO); _Pragma("unroll") for (int k = 0; k < 2; ++k) _Pragma("unroll") for (int m = 0; m < 4; ++m) _Pragma("unroll") for (int n = 0; n < 2; ++n) \
        acc[ai][bj][m][n] = __builtin_amdgcn_mfma_f32_16x16x32_bf16(Bt[n][k], At[m][k], acc[ai][bj][m][n], 0, 0, 0); if (PG8_PRIO) __builtin_amdgcn_s_setprio(PG8_PRIO_LOAD); } while (0)
#else
#define PG8_MMA(ai, bj, At, Bt) do { if (PG8_PRIO) __builtin_amdgcn_s_setprio(PG8_PRIO); _Pragma("unroll") for (int m = 0; m < 4; ++m) _Pragma("unroll") for (int n = 0; n < 2; ++n) _Pragma("unroll") for (int k = 0; k < 2; ++k) \
        acc[ai][bj][m][n] = __builtin_amdgcn_mfma_f32_16x16x32_bf16(Bt[n][k], At[m][k], acc[ai][bj][m][n], 0, 0, 0); if (PG8_PRIO) __builtin_amdgcn_s_setprio(PG8_PRIO_LOAD); } while (0)
#endif
#define PG8_WAIT_V(n) asm volatile("s_waitcnt vmcnt(" #n ")" ::: "memory")
#define PG8_WAIT_L(n) asm volatile("s_waitcnt lgkmcnt(" #n ")" ::: "memory")
#define PG8_BAR __builtin_amdgcn_s_barrier()
#define PG8_SCHED __builtin_amdgcn_sched_barrier(0)
    Unit cur, nxt; int ui = 0;
    if (!S.next(0, cur)) return;
    f32x4 acc[2][2][4][2];
#pragma unroll
    for (int a = 0; a < 2; ++a)
#pragma unroll
        for (int b = 0; b < 2; ++b)
#pragma unroll
            for (int m = 0; m < 4; ++m)
#pragma unroll
                for (int n = 0; n < 2; ++n) acc[a][b][m][n] = (f32x4){0.f, 0.f, 0.f, 0.f};
    bf16x8 At[4][2], B0[2][2], B1[2][2];
    const char* cA = (const char*)g.A + (size_t)cur.pm * tstep; const char* cB = (const char*)g.Bt + (size_t)cur.pn * tstep;
    S.a_ready(cur);
    if constexpr (SP2) {
        PG8_STAGE(PG8_SB(0, 0), cB, voffB); PG8_STAGE(PG8_SB(0, 1), cB + hstep, voffB); PG8_STAGE(PG8_SA(0, 0), cA, voffA); PG8_STAGE(PG8_SA(0, 1), cA + hstep, voffA);
        if (wr == 1) PG8_BAR;
        PG8_WAIT_V(2); PG8_BAR;
#if PG8_BAL
        PG8_STAGE(PG8_SB(1, 0), cB + kstep, voffB); PG8_STAGE(PG8_SB(1, 1), cB + hstep + kstep, voffB);
        PG8_WAIT_V(4); PG8_BAR;
#else
        PG8_STAGE(PG8_SB(1, 0), cB + kstep, voffB); PG8_STAGE(PG8_SA(1, 0), cA + kstep, voffA); PG8_STAGE(PG8_SB(1, 1), cB + hstep + kstep, voffB);
        PG8_WAIT_V(6); PG8_BAR;
#endif
    } else {
        PG8_STAGE(PG8_SB(0, 0), cB, voffB); PG8_STAGE(PG8_SA(0, 0), cA, voffA); PG8_STAGE(PG8_SB(0, 1), cB + hstep, voffB); PG8_STAGE(PG8_SA(0, 1), cA + hstep, voffA);
        if (wr == 1) PG8_BAR;
        PG8_WAIT_V(4); PG8_BAR;
        PG8_STAGE(PG8_SB(1, 0), cB + kstep, voffB); PG8_STAGE(PG8_SA(1, 0), cA + kstep, voffA); PG8_STAGE(PG8_SB(1, 1), cB + hstep + kstep, voffB);
        PG8_WAIT_V(6); PG8_BAR;
    }
    for (;;) {
        const bool has_next = S.next(ui + 1, nxt);
        const char* nA = has_next ? (const char*)g.A + (size_t)nxt.pm * tstep : cA; const char* nB = has_next ? (const char*)g.Bt + (size_t)nxt.pn * tstep : cB;
        for (int t = 0; t < nt; t += 2) {
            const bool last = (t == nt - 2);
            const char* a1 = cA + (size_t)(t + 1) * kstep;
            const char* a2 = last ? nA : cA + (size_t)(t + 2) * kstep; const char* b2 = last ? nB : cB + (size_t)(t + 2) * kstep;
            const char* a3 = a2 + kstep; const char* b3 = b2 + kstep;
            if (last && has_next) S.a_ready(nxt);
            if constexpr (SP2) {
#if PG8_BAL
#if PG8_ORD == 1
            PG8_STAGE(PG8_SA(1, 0), a1, voffA); PG8_STAGE(PG8_SA(1, 1), a1 + hstep, voffA); PG8_SCHED; PG8_LDB(B0, 0, 0); PG8_LDB(B1, 0, 1); PG8_SCHED; PG8_LDA(At, 0, 0);
            PG8_WAIT_V(8); PG8_WAIT_L(0); PG8_BAR; PG8_MMA(0, 0, At, B0); PG8_MMA(0, 1, At, B1); PG8_BAR; PG8_SCHED;
            PG8_STAGE(PG8_SB(0, 0), b2, voffB); PG8_STAGE(PG8_SB(0, 1), b2 + hstep, voffB); PG8_SCHED; PG8_LDA(At, 0, 1);
            PG8_WAIT_V(6); PG8_WAIT_L(0); PG8_BAR; PG8_MMA(1, 0, At, B0); PG8_MMA(1, 1, At, B1); PG8_BAR; PG8_SCHED;
            PG8_STAGE(PG8_SA(0, 0), a2, voffA); PG8_STAGE(PG8_SA(0, 1), a2 + hstep, voffA); PG8_SCHED; PG8_LDB(B0, 1, 0); PG8_LDB(B1, 1, 1); PG8_SCHED; PG8_LDA(At, 1, 0);
            PG8_WAIT_V(8); PG8_WAIT_L(0); PG8_BAR; PG8_MMA(0, 0, At, B0); PG8_MMA(0, 1, At, B1); PG8_BAR; PG8_SCHED;
            PG8_STAGE(PG8_SB(1, 0), b3, voffB); PG8_STAGE(PG8_SB(1, 1), b3 + hstep, voffB); PG8_SCHED; PG8_LDA(At, 1, 1);
            PG8_WAIT_V(6); PG8_WAIT_L(0); PG8_BAR; PG8_MMA(1, 0, At, B0); PG8_MMA(1, 1, At, B1); PG8_BAR; PG8_SCHED;
#elif PG8_ORD == 2
            PG8_LDB(B0, 0, 0); PG8_SCHED; PG8_STAGE(PG8_SA(1, 0), a1, voffA); PG8_SCHED; PG8_LDB(B1, 0, 1); PG8_SCHED; PG8_STAGE(PG8_SA(1, 1), a1 + hstep, voffA); PG8_SCHED; PG8_LDA(At, 0, 0);
            PG8_WAIT_V(8); PG8_WAIT_L(0); PG8_BAR; PG8_MMA(0, 0, At, B0); PG8_MMA(0, 1, At, B1); PG8_BAR; PG8_SCHED;
            PG8_STAGE(PG8_SB(0, 0), b2, voffB); PG8_SCHED; PG8_LDA(At, 0, 1); PG8_SCHED; PG8_STAGE(PG8_SB(0, 1), b2 + hstep, voffB);
            PG8_WAIT_V(6); PG8_WAIT_L(0); PG8_BAR; PG8_MMA(1, 0, At, B0); PG8_MMA(1, 1, At, B1); PG8_BAR; PG8_SCHED;
            PG8_LDB(B0, 1, 0); PG8_SCHED; PG8_STAGE(PG8_SA(0, 0), a2, voffA); PG8_SCHED; PG8_LDB(B1, 1, 1); PG8_SCHED; PG8_STAGE(PG8_SA(0, 1), a2 + hstep, voffA); PG8_SCHED; PG8_LDA(At, 1, 0);
            PG8_WAIT_V(8); PG8_WAIT_L(0); PG8_BAR; PG8_MMA(0, 0, At, B0); PG8_MMA(0, 1, At, B1); PG8_BAR; PG8_SCHED;
            PG8_STAGE(PG8_SB(1, 0), b3, voffB); PG8_SCHED; PG8_LDA(At, 1, 1); PG8_SCHED; PG8_STAGE(PG8_SB(1, 1), b3 + hstep, voffB);
            PG8_WAIT_V(6); PG8_WAIT_L(0); PG8_BAR; PG8_MMA(1, 0, At, B0); PG8_MMA(1, 1, At, B1); PG8_BAR; PG8_SCHED;
#else
            PG8_LDB(B0, 0, 0); PG8_LDB(B1, 0, 1); PG8_SCHED; PG8_LDA(At, 0, 0); PG8_STAGE(PG8_SA(1, 0), a1, voffA); PG8_STAGE(PG8_SA(1, 1), a1 + hstep, voffA);
            PG8_WAIT_V(8); PG8_WAIT_L(0); PG8_BAR; PG8_MMA(0, 0, At, B0); PG8_MMA(0, 1, At, B1); PG8_BAR; PG8_SCHED;
            PG8_LDA(At, 0, 1); PG8_STAGE(PG8_SB(0, 0), b2, voffB); PG8_STAGE(PG8_SB(0, 1), b2 + hstep, voffB);
            PG8_WAIT_V(6); PG8_WAIT_L(0); PG8_BAR; PG8_MMA(1, 0, At, B0); PG8_MMA(1, 1, At, B1); PG8_BAR; PG8_SCHED;
            PG8_LDB(B0, 1, 0); PG8_LDB(B1, 1, 1); PG8_SCHED; PG8_LDA(At, 1, 0); PG8_STAGE(PG8_SA(0, 0), a2, voffA); PG8_STAGE(PG8_SA(0, 1), a2 + hstep, voffA);
            PG8_WAIT_V(8); PG8_WAIT_L(0); PG8_BAR; PG8_MMA(0, 0, At, B0); PG8_MMA(0, 1, At, B1); PG8_BAR; PG8_SCHED;
            PG8_LDA(At, 1, 1); PG8_STAGE(PG8_SB(1, 0), b3, voffB); PG8_STAGE(PG8_SB(1, 1), b3 + hstep, voffB);
            PG8_WAIT_V(6); PG8_WAIT_L(0); PG8_BAR; PG8_MMA(1, 0, At, B0); PG8_MMA(1, 1, At, B1); PG8_BAR; PG8_SCHED;
#endif
            (void)a3;
#else
            PG8_LDB(B0, 0, 0); PG8_LDB(B1, 0, 1); PG8_SCHED; PG8_LDA(At, 0, 0); PG8_STAGE(PG8_SA(1, 1), a1 + hstep, voffA);
            PG8_WAIT_V(8); PG8_WAIT_L(0); PG8_BAR; PG8_MMA(0, 0, At, B0); PG8_MMA(0, 1, At, B1); PG8_BAR; PG8_SCHED;
            PG8_LDA(At, 0, 1); PG8_STAGE(PG8_SB(0, 0), b2, voffB); PG8_STAGE(PG8_SB(0, 1), b2 + hstep, voffB); PG8_STAGE(PG8_SA(0, 0), a2, voffA);
            PG8_WAIT_V(8); PG8_WAIT_L(0); PG8_BAR; PG8_MMA(1, 0, At, B0); PG8_MMA(1, 1, At, B1); PG8_BAR; PG8_SCHED;
            PG8_LDB(B0, 1, 0); PG8_LDB(B1, 1, 1); PG8_SCHED; PG8_LDA(At, 1, 0); PG8_STAGE(PG8_SA(0, 1), a2 + hstep, voffA);
            PG8_WAIT_V(8); PG8_WAIT_L(0); PG8_BAR; PG8_MMA(0, 0, At, B0); PG8_MMA(0, 1, At, B1); PG8_BAR; PG8_SCHED;
            PG8_LDA(At, 1, 1); PG8_STAGE(PG8_SB(1, 0), b3, voffB); PG8_STAGE(PG8_SB(1, 1), b3 + hstep, voffB); PG8_STAGE(PG8_SA(1, 0), a3, voffA);
            PG8_WAIT_V(8); PG8_WAIT_L(0); PG8_BAR; PG8_MMA(1, 0, At, B0); PG8_MMA(1, 1, At, B1); PG8_BAR; PG8_SCHED;
#endif
            } else {
            PG8_LDB(B0, 0, 0); PG8_SCHED; PG8_LDA(At, 0, 0); PG8_STAGE(PG8_SA(1, 1), a1 + hstep, voffA);
            PG8_WAIT_L(8); PG8_BAR; PG8_WAIT_L(0); PG8_MMA(0, 0, At, B0); PG8_BAR; PG8_SCHED;
            PG8_LDB(B1, 0, 1); PG8_STAGE(PG8_SB(0, 0), b2, voffB);
            PG8_BAR; PG8_WAIT_L(0); PG8_MMA(0, 1, At, B1); PG8_BAR;
            PG8_LDA(At, 0, 1); PG8_STAGE(PG8_SA(0, 0), a2, voffA);
            PG8_BAR; PG8_WAIT_L(0); PG8_MMA(1, 0, At, B0); PG8_BAR; PG8_SCHED;
            PG8_STAGE(PG8_SB(0, 1), b2 + hstep, voffB);
            PG8_WAIT_V(6); PG8_BAR; PG8_MMA(1, 1, At, B1); PG8_BAR;
            PG8_LDB(B0, 1, 0); PG8_SCHED; PG8_LDA(At, 1, 0); PG8_STAGE(PG8_SA(0, 1), a2 + hstep, voffA);
            PG8_WAIT_L(8); PG8_BAR; PG8_WAIT_L(0); PG8_MMA(0, 0, At, B0); PG8_BAR; PG8_SCHED;
            PG8_LDB(B1, 1, 1); PG8_STAGE(PG8_SB(1, 0), b3, voffB);
            PG8_BAR; PG8_WAIT_L(0); PG8_MMA(0, 1, At, B1); PG8_BAR;
            PG8_LDA(At, 1, 1); PG8_STAGE(PG8_SA(1, 0), a3, voffA);
            PG8_BAR; PG8_WAIT_L(0); PG8_MMA(1, 0, At, B0); PG8_BAR; PG8_SCHED;
            PG8_STAGE(PG8_SB(1, 1), b3 + hstep, voffB);
            PG8_WAIT_V(6); PG8_BAR; PG8_MMA(1, 1, At, B1); PG8_BAR;
            }
        }
        if constexpr (ALIGN_EPI) { if (wr == 0) PG8_BAR; }
#ifdef PROBE_EPI
        unsigned long long te0_ = 0; if (g.tacc) te0_ = __builtin_amdgcn_s_memrealtime();
#endif
        if constexpr (!Epi::AFTER_DRAIN) { E(acc, cur, wr, wc, fr, fq); S.done(cur); }
#ifdef PROBE_EPI
        if (g.tacc && blockIdx.x == 0 && tid == 0) { *g.tacc += (unsigned)(__builtin_amdgcn_s_memrealtime() - te0_); }
#endif
        if (!has_next) break;
#pragma unroll
        for (int a = 0; a < 2; ++a)
#pragma unroll
            for (int b = 0; b < 2; ++b)
#pragma unroll
                for (int m = 0; m < 4; ++m)
#pragma unroll
                    for (int n = 0; n < 2; ++n) acc[a][b][m][n] = (f32x4){0.f, 0.f, 0.f, 0.f};
        cur = nxt; cA = nA; cB = nB; ++ui;
        if constexpr (ALIGN_EPI) { if (wr == 1) PG8_BAR; }
    }
    PG8_WAIT_V(0);
    if constexpr (!ALIGN_EPI) { if (wr == 0) PG8_BAR; }
    PG8_BAR;
    if constexpr (Epi::AFTER_DRAIN) { E.fused(acc, cur, wr, wc, fr, fq, lds, wid, lane); S.done(cur); }
#undef PG8_SA
#undef PG8_SB
#undef PG8_STAGE
#undef PG8_LDA
#undef PG8_LDB
#undef PG8_MMA
#undef PG8_WAIT_V
#undef PG8_WAIT_L
#undef PG8_BAR
#undef PG8_SCHED
}
}
#define GAS __attribute__((address_space(1)))
#define LAS __attribute__((address_space(3)))
typedef unsigned short bf16;
typedef unsigned v4u __attribute__((ext_vector_type(4)));
typedef float f32x4 __attribute__((ext_vector_type(4)));
typedef short bf16x8 __attribute__((ext_vector_type(8)));
typedef GAS unsigned gu32;
typedef GAS unsigned long long gu64;
#define RLX_AGENT __ATOMIC_RELAXED, __HIP_MEMORY_SCOPE_AGENT
#define LDS_WAIT() asm volatile("s_waitcnt lgkmcnt(0)" ::: "memory")
#define VM_WAIT() asm volatile("s_waitcnt vmcnt(0)" ::: "memory")
__device__ __forceinline__ unsigned long long rt() { return __builtin_amdgcn_s_memrealtime(); }
__device__ __forceinline__ unsigned f2bf(float f) { unsigned u = __builtin_bit_cast(unsigned, f); return (u + 0x7fffu + ((u >> 16) & 1u)) >> 16; }
__device__ __forceinline__ unsigned pk2(float lo, float hi) { return f2bf(lo) | (f2bf(hi) << 16); }

#define XB_TMO      128
#define XB_XCNT(j)  (256  + 64 * (j))
#define XB_XSUB(j)  (1280 + 64 * (j))
#define XB_XGEN(j)  (2304 + 64 * (j))
#define XB_TOP      3328
#define XB_TOPGEN   3392
#define XCD_BAR_WORDS 3456
#define XB_SPIN_CAP (1u << 18)

__device__ __forceinline__ unsigned xb_ld(unsigned* p)              { return __hip_atomic_load(p, __ATOMIC_RELAXED, __HIP_MEMORY_SCOPE_AGENT); }
__device__ __forceinline__ unsigned xb_add(unsigned* p, unsigned v) { return __hip_atomic_fetch_add(p, v, __ATOMIC_RELAXED, __HIP_MEMORY_SCOPE_AGENT); }
__device__ __forceinline__ unsigned xb_xcc_id() { return (unsigned)__builtin_amdgcn_s_getreg((3 << 11) | 20) & 0xFu; }
#define XB_SPIN(cond, bar) do { unsigned _sp = 0; while (cond) { __builtin_amdgcn_s_sleep(1); \
    if ((++_sp & 255u) == 0u) { if (xb_ld(&(bar)[XB_TMO])) break; if (_sp > XB_SPIN_CAP) { atomicAdd(&(bar)[XB_TMO], 1u); break; } } } } while (0)

struct XcdBarrier {
    unsigned* bar; unsigned x;
    volatile LAS unsigned* st;
};

__device__ __forceinline__ XcdBarrier xcd_barrier_post(unsigned* bar, volatile LAS unsigned* st) {
    XcdBarrier b; b.bar = bar; b.x = xb_xcc_id(); b.st = st;
    if (threadIdx.x == 0) (void)xb_add(&bar[XB_XCNT(b.x)], 1u);
    return b;
}
__device__ __forceinline__ void xcd_barrier_complete(unsigned* bar, unsigned x, unsigned& nloc, unsigned& nx) {
    const unsigned G = gridDim.x * gridDim.y * gridDim.z;
    unsigned sum, cnt, mine, sp = 0u;
    for (;;) {
        sum = 0u; cnt = 0u; mine = 0u;
#pragma unroll
        for (unsigned j = 0; j < 16; ++j) { const unsigned c = xb_ld(&bar[XB_XCNT(j)]); sum += c; cnt += (c > 0u) ? 1u : 0u; mine = (j == x) ? c : mine; }
        if (sum == G) break;
        __builtin_amdgcn_s_sleep(1);
        if ((++sp & 255u) == 0u) { if (xb_ld(&bar[XB_TMO])) break; if (sp > XB_SPIN_CAP) { atomicAdd(&bar[XB_TMO], 1u); break; } }
    }
    nloc = mine > 0u ? mine : 1u; nx = cnt > 0u ? cnt : 1u;
}

__device__ __forceinline__ void xcd_barrier(const XcdBarrier& b) {
    asm volatile("s_waitcnt vmcnt(0)" ::: "memory");
    __syncthreads();
    if (threadIdx.x == 0) {
        unsigned* bar = b.bar;
        __builtin_amdgcn_s_waitcnt(0);
        unsigned nloc = b.st[0], nx = b.st[1];
        if (nloc == 0u) { xcd_barrier_complete(bar, b.x, nloc, nx); b.st[0] = nloc; b.st[1] = nx; }
        const unsigned old = xb_add(&bar[XB_XSUB(b.x)], 1u);
        const unsigned gen = old / nloc;
        if (old + 1u == (gen + 1u) * nloc) {
            __builtin_amdgcn_fence(__ATOMIC_RELEASE, "agent");
            asm volatile("s_waitcnt vmcnt(0)" ::: "memory");
            const unsigned og = xb_add(&bar[XB_TOP], 1u);
            const unsigned tg = og / nx;
            if (og + 1u == (tg + 1u) * nx) xb_add(&bar[XB_TOPGEN], 1u);
            else XB_SPIN(xb_ld(&bar[XB_TOPGEN]) == tg, bar);
            __builtin_amdgcn_fence(__ATOMIC_ACQUIRE, "agent");
            xb_add(&bar[XB_XGEN(b.x)], 1u);
            asm volatile("s_waitcnt vmcnt(0)" ::: "memory");
        } else {
            XB_SPIN(xb_ld(&bar[XB_XGEN(b.x)]) == gen, bar);
            __builtin_amdgcn_fence(__ATOMIC_ACQUIRE, "agent");
            asm volatile("s_waitcnt vmcnt(0)" ::: "memory");
        }
    }
    __syncthreads();
}

constexpr int NWAVES = 8;
constexpr int BATCH = 4, SEQ = 8192, DM = 1024, MROWS = BATCH * SEQ, CONVW = 512, NHEAD = 8, HD = 64, ATTW = 512, INCOLS = 3072, DFF = 2816, PLED = 256;
constexpr float EPS = 1e-6f;
constexpr float LOG2E = 1.4426950408889634f;
constexpr size_t MiB = 1u << 20;
constexpr size_t WS_CTL = 0, CTL_ZERO_BYTES = 32768;
constexpr size_t WS_WIN = 2 * MiB, WS_WOUT = 8 * MiB, WS_WGU = 10 * MiB, WS_WDN = 21 * MiB, WS_WPG = 27 * MiB, WS_WPP = 29 * MiB;
constexpr size_t WS_H = 32 * MiB;
constexpr size_t WS_PB = 96 * MiB;
constexpr size_t WS_ZC = 112 * MiB;
constexpr size_t WS_Q = 208 * MiB, WS_K = 240 * MiB, WS_V = 272 * MiB;
constexpr size_t WS_OP = 304 * MiB;
constexpr size_t WS_LP = 400 * MiB;
constexpr size_t WS_Y = 404 * MiB;
constexpr size_t WS_U = 112 * MiB;
constexpr size_t WS_TOPG = 288 * MiB, WS_BOTG = 291 * MiB, WS_TOPU = 294 * MiB;
constexpr size_t WS_PP = 300 * MiB;
constexpr size_t WS_SS = 30 * MiB;
constexpr size_t WS_X2 = 364 * MiB;
constexpr size_t WS_END = 468 * MiB;
constexpr int CW_BAR = 4096;
constexpr int CW_Q0 = 64;
constexpr int RING_BYTES = 131072, LDSCTL_OFF = RING_BYTES, MISC_OFF = LDSCTL_OFF + 320, XCH_OFF = RING_BYTES + 4096  , LDS_BYTES = 147456;

__device__ __forceinline__ float wave_sum(float v) {
#pragma unroll
    for (int o = 1; o < 64; o <<= 1) v += __shfl_xor(v, o);
    return v;
}
__device__ __forceinline__ float wave_max(float v) {
#pragma unroll
    for (int o = 1; o < 64; o <<= 1) v = fmaxf(v, __shfl_xor(v, o));
    return v;
}
__device__ __forceinline__ unsigned cvtpk(float lo, float hi) { unsigned r; asm volatile("v_cvt_pk_bf16_f32 %0, %1, %2" : "=v"(r) : "v"(lo), "v"(hi)); return r; }
__device__ __forceinline__ float bflo(unsigned w) { return __builtin_bit_cast(float, w << 16); }
__device__ __forceinline__ float bfhi(unsigned w) { return __builtin_bit_cast(float, w & 0xffff0000u); }
__device__ __forceinline__ void unpack8(const v4u w, float (&f)[8]) { f[0] = bflo(w.x); f[1] = bfhi(w.x); f[2] = bflo(w.y); f[3] = bfhi(w.y); f[4] = bflo(w.z); f[5] = bfhi(w.z); f[6] = bflo(w.w); f[7] = bfhi(w.w); }
__device__ __forceinline__ v4u pack8f(const float (&f)[8]) { v4u w; w.x = cvtpk(f[0], f[1]); w.y = cvtpk(f[2], f[3]); w.z = cvtpk(f[4], f[5]); w.w = cvtpk(f[6], f[7]); return w; }
__device__ __forceinline__ void load8f(const float* p, float (&f)[8]) { const f32x4 a = *(const f32x4*)p, b = *(const f32x4*)(p + 4); f[0] = a[0]; f[1] = a[1]; f[2] = a[2]; f[3] = a[3]; f[4] = b[0]; f[5] = b[1]; f[6] = b[2]; f[7] = b[3]; }

__device__ __forceinline__ void p0_transpose_item(const float* W, int K, int N, bf16* WT, int drow0, LAS float* scr, int k0, int n0, int lane, const float* gain = nullptr) {
    f32x4 w[8]; float gk[8];
#pragma unroll
    for (int i = 0; i < 8; ++i) { const int kk = 8 * i + (lane >> 3); w[i] = *(const GAS f32x4*)(W + (size_t)(k0 + kk) * N + n0 + 4 * (lane & 7)); gk[i] = gain ? gain[k0 + kk] : 1.0f; }
#pragma unroll
    for (int i = 0; i < 8; ++i) { const int kk = 8 * i + (lane >> 3); LAS float* d = scr + kk * 33 + 4 * (lane & 7); d[0] = w[i].x * gk[i]; d[1] = w[i].y * gk[i]; d[2] = w[i].z * gk[i]; d[3] = w[i].w * gk[i]; }
    LDS_WAIT(); asm volatile("" ::: "memory");
    const int c = lane & 7;
#pragma unroll
    for (int j = 0; j < 4; ++j) { const int n = (lane >> 3) + 8 * j; const LAS float* s = scr + (8 * c) * 33 + n;
        v4u o; o.x = cvtpk(s[0 * 33], s[1 * 33]); o.y = cvtpk(s[2 * 33], s[3 * 33]); o.z = cvtpk(s[4 * 33], s[5 * 33]); o.w = cvtpk(s[6 * 33], s[7 * 33]);
        *(GAS v4u*)(WT + (size_t)(drow0 + n) * K + k0 + 8 * c) = o; }
    LDS_WAIT(); asm volatile("" ::: "memory");
}
__device__ __forceinline__ int map_in_row(int n0) {
    if (n0 < 1536) return n0;
    const int w = n0 - 1536, sec = w >> 8, within = w & 255, hl = within >> 6, dim = within & 63;
    return 1536 + 256 * sec + 128 * (dim >> 5) + 32 * hl + (dim & 31);
}
__device__ __forceinline__ void rms_row(const float* srow, const float* g, bf16* drow, int lane) {
    const GAS f32x4* xr = (const GAS f32x4*)srow + lane;
    f32x4 v[4]; float s = 0.f;
#pragma unroll
    for (int j = 0; j < 4; ++j) { v[j] = xr[64 * j]; s += (v[j].x * v[j].x + v[j].y * v[j].y) + (v[j].z * v[j].z + v[j].w * v[j].w); }
    const float rstd = __builtin_amdgcn_rsqf(wave_sum(s) * (1.f / DM) + EPS);
    GAS unsigned long long* o8 = (GAS unsigned long long*)drow + lane;
#pragma unroll
    for (int j = 0; j < 4; ++j) { const f32x4 gg = ((const GAS f32x4*)g)[lane + 64 * j];
        o8[64 * j] = (unsigned long long)cvtpk(v[j].x * rstd * gg.x, v[j].y * rstd * gg.y) | ((unsigned long long)cvtpk(v[j].z * rstd * gg.z, v[j].w * rstd * gg.w) << 32); }
}
__device__ __forceinline__ int wave_pull(unsigned* ctr, int lane) {
    unsigned v = 0u;
    if (lane == 0) v = __hip_atomic_fetch_add(ctr, 1u, __ATOMIC_RELAXED, __HIP_MEMORY_SCOPE_AGENT);
    return (int)__builtin_amdgcn_readfirstlane((int)v);
}
#ifndef RMS_NR
#define RMS_NR 4
#endif
__device__ __forceinline__ void rms_rows(const float* src, const float* g, bf16* dst, int gw, int NGW, int lane, int mend = MROWS, unsigned* pool = nullptr) {
    f32x4 gg[4];
#pragma unroll
    for (int j = 0; j < 4; ++j) gg[j] = ((const GAS f32x4*)g)[lane + 64 * j];
    int m = gw * RMS_NR, pooled = 0;
    for (;;) {
        if (!pooled && m >= mend) { if (!pool) break; pooled = 1; }
        if (pooled) { const int k = wave_pull(pool, lane); m = mend + 16 * k; if (m >= MROWS) break; }
      for (int sub = 0; sub < (pooled ? 16 / RMS_NR : 1); ++sub, m += (pooled ? RMS_NR : 0)) {
        f32x4 v[RMS_NR][4]; float s[RMS_NR];
#pragma unroll
        for (int r = 0; r < RMS_NR; ++r)
#pragma unroll
            for (int j = 0; j < 4; ++j) v[r][j] = ((const GAS f32x4*)(src + (size_t)(m + r) * DM))[lane + 64 * j];
#pragma unroll
        for (int r = 0; r < RMS_NR; ++r) { s[r] = 0.f;
#pragma unroll
            for (int j = 0; j < 4; ++j) s[r] += (v[r][j].x * v[r][j].x + v[r][j].y * v[r][j].y) + (v[r][j].z * v[r][j].z + v[r][j].w * v[r][j].w); }
#pragma unroll
        for (int o = 1; o < 64; o <<= 1) {
#pragma unroll
            for (int r = 0; r < RMS_NR; ++r) s[r] += __shfl_xor(s[r], o); }
#pragma unroll
        for (int r = 0; r < RMS_NR; ++r) { const float rstd = __builtin_amdgcn_rsqf(s[r] * (1.f / DM) + EPS);
            GAS unsigned long long* o8 = (GAS unsigned long long*)(dst + (size_t)(m + r) * DM) + lane;
#pragma unroll
            for (int j = 0; j < 4; ++j) o8[64 * j] = (unsigned long long)cvtpk(v[r][j].x * rstd * gg[j].x, v[r][j].y * rstd * gg[j].y) | ((unsigned long long)cvtpk(v[r][j].z * rstd * gg[j].z, v[r][j].w * rstd * gg[j].w) << 32); }
      }
        if (!pooled) m += NGW * RMS_NR;
    }
}

namespace att {
typedef float f32x16 __attribute__((ext_vector_type(16)));
typedef short s16x4 __attribute__((ext_vector_type(4)));
typedef short v4i16_t __attribute__((ext_vector_type(4)));
__device__ __forceinline__ constexpr int cr(int r) { return (r & 3) + 8 * (r >> 2); }
__device__ __forceinline__ s16x4 vtr(LAS const unsigned char* p) { return __builtin_bit_cast(s16x4, __builtin_amdgcn_ds_read_tr16_b64_v4i16((LAS v4i16_t*)p)); }

constexpr int K_OFF = 0, V_OFF = 49152, O_OFF = 98304;
struct UnitP { int b, h, d, r, blk, branch; float cb; };
__device__ __forceinline__ UnitP unit_params(int u) {
    UnitP p; const int bh = u / 96, u96 = u % 96, within = u96 & 31; p.branch = u96 >> 5;
    p.d = 1 << (2 * p.branch); const int nblk = 32 >> (2 * p.branch); p.r = within / nblk; p.blk = within % nblk; p.b = bh >> 3; p.h = bh & 7;
    p.cb = __builtin_amdgcn_exp2f(-(float)(p.h + 1)) * (float)p.d * LOG2E; return p;
}
struct Stage { v4u k[6], v[6]; bf16x8 q[4]; };
__device__ __forceinline__ void stage_load(Stage& st, const bf16* Qg, const bf16* Kg, const bf16* Vg, const UnitP& p, int tid, int wave, int lane) {
    const size_t hb = (size_t)(p.b * NHEAD + p.h) * SEQ * HD; const bf16* Kh = Kg + hb; const bf16* Vh = Vg + hb; const bf16* Qh = Qg + hb;
    const int lbase = p.blk * 256 - 128;
#pragma unroll
    for (int it = 0; it < 6; ++it) { const int idx = tid + 512 * it, row = idx >> 3, c = idx & 7; int l = lbase + row; l = l < 0 ? 0 : l;
        const size_t off = (size_t)(p.r + p.d * l) * HD + 8 * c; st.k[it] = *(const GAS v4u*)(Kh + off); st.v[it] = *(const GAS v4u*)(Vh + off); }
    const int pq = p.r + p.d * (p.blk * 256 + 32 * wave + (lane & 31));
#pragma unroll
    for (int s = 0; s < 4; ++s) st.q[s] = *(const GAS bf16x8*)(Qh + (size_t)pq * HD + 16 * s + 8 * (lane >> 5));
}
__device__ __forceinline__ void stage_write(const Stage& st, LAS unsigned char* L, int tid) {
#pragma unroll
    for (int it = 0; it < 6; ++it) { const int idx = tid + 512 * it, row = idx >> 3, c = idx & 7;
        *(LAS v4u*)(L + K_OFF + row * 128 + ((c ^ (row & 7)) << 4)) = st.k[it];
        *(LAS v4u*)(L + V_OFF + ((row >> 4) * 2 + (c >> 2)) * 1024 + (row & 15) * 64 + (c & 3) * 16) = st.v[it]; }
}
__device__ __forceinline__ void compute_tile(LAS unsigned char* L, const bf16x8 (&qf)[4], const UnitP& p, bf16* OPb, float* LPb, float negM, int wave, int lane) {
    const int r32 = lane & 31, hi = lane >> 5;
    const int l0 = p.blk * 256 + 32 * wave, d = p.d, r = p.r; const float cb = p.cb;
    const int pq = r + d * (l0 + r32);
    const int kb0 = l0 >= 128 ? 0 : ((128 - l0) >> 5);
    f32x16 o0, o1;
#pragma unroll
    for (int i = 0; i < 16; ++i) { o0[i] = 0.f; o1[i] = 0.f; }
    float lsum = 0.f;
    const int i4 = r32 - 4 * hi;
    const int laneoff = ((lane >> 4) & 1) * 32 + (lane & 3) * 8 + (4 * hi + ((lane & 15) >> 2)) * 64;
    bf16x8 kf[4];
    LAS const unsigned char* kbase = L + K_OFF + (32 * wave + r32) * 128;
    const int ksw = r32 & 7;
#pragma unroll
    for (int kb = 0; kb < 5; ++kb) if (kb >= kb0) {
        if (kb == kb0) {
#pragma unroll
            for (int s = 0; s < 4; ++s) kf[s] = *(LAS const bf16x8*)(kbase + kb * 4096 + (((2 * s + hi) ^ ksw) << 4));
        }
        const float lt = negM - cb * (float)(128 + r32 - 32 * kb - 4 * hi);
        f32x16 sacc;
#pragma unroll
        for (int i = 0; i < 16; ++i) sacc[i] = __builtin_fmaf(cb, (float)cr(i), lt);
#if ATT_PRIO == 2
        __builtin_amdgcn_s_setprio(1);
#endif
#pragma unroll
        for (int s = 0; s < 4; ++s) sacc = __builtin_amdgcn_mfma_f32_32x32x16_bf16(kf[s], qf[s], sacc, 0, 0, 0);
#if ATT_PRIO == 2
        __builtin_amdgcn_s_setprio(0);
#endif
        if (kb < 4) {
#pragma unroll
            for (int s = 0; s < 4; ++s) kf[s] = *(LAS const bf16x8*)(kbase + (kb + 1) * 4096 + (((2 * s + hi) ^ ksw) << 4));
        }
        float pe[16];
#pragma unroll
        for (int i = 0; i < 16; ++i) pe[i] = __builtin_amdgcn_exp2f(sacc[i]);
        if (kb == 0) {
#pragma unroll
            for (int i = 0; i < 16; ++i) pe[i] = (cr(i) >= i4) ? pe[i] : 0.f;
        }
        if (kb == 4) {
#pragma unroll
            for (int i = 0; i < 16; ++i) pe[i] = (cr(i) <= i4) ? pe[i] : 0.f;
        }
        float ps = 0.f;
#pragma unroll
        for (int i = 0; i < 16; ++i) ps += pe[i];
        lsum += ps;
        v4u pw0, pw1;
        pw0.x = cvtpk(pe[0], pe[1]); pw0.y = cvtpk(pe[2], pe[3]); pw0.z = cvtpk(pe[4], pe[5]); pw0.w = cvtpk(pe[6], pe[7]);
        pw1.x = cvtpk(pe[8], pe[9]); pw1.y = cvtpk(pe[10], pe[11]); pw1.z = cvtpk(pe[12], pe[13]); pw1.w = cvtpk(pe[14], pe[15]);
        const bf16x8 pa0 = __builtin_bit_cast(bf16x8, pw0), pa1 = __builtin_bit_cast(bf16x8, pw1);
        LAS const unsigned char* vb = L + V_OFF + (wave + kb) * 4096 + laneoff;
#pragma unroll
        for (int d0 = 0; d0 < 2; ++d0) {
            const s16x4 a_lo = vtr(vb + d0 * 1024), a_hi = vtr(vb + d0 * 1024 + 512), b_lo = vtr(vb + 2048 + d0 * 1024), b_hi = vtr(vb + 2048 + d0 * 1024 + 512);
            const bf16x8 v0 = (bf16x8){a_lo[0], a_lo[1], a_lo[2], a_lo[3], a_hi[0], a_hi[1], a_hi[2], a_hi[3]};
            const bf16x8 v1 = (bf16x8){b_lo[0], b_lo[1], b_lo[2], b_lo[3], b_hi[0], b_hi[1], b_hi[2], b_hi[3]};
            if (d0 == 0) { o0 = __builtin_amdgcn_mfma_f32_32x32x16_bf16(pa0, v0, o0, 0, 0, 0); o0 = __builtin_amdgcn_mfma_f32_32x32x16_bf16(pa1, v1, o0, 0, 0, 0); }
            else         { o1 = __builtin_amdgcn_mfma_f32_32x32x16_bf16(pa0, v0, o1, 0, 0, 0); o1 = __builtin_amdgcn_mfma_f32_32x32x16_bf16(pa1, v1, o1, 0, 0, 0); }
        }
    }
    lsum += __shfl_xor(lsum, 32);
    if (hi == 0) LPb[(size_t)(p.b * SEQ + pq) * NHEAD + p.h] = lsum;
    LAS unsigned short* stg = (LAS unsigned short*)(L + O_OFF + wave * 4096);
#pragma unroll
    for (int i = 0; i < 16; ++i) { const int q = cr(i) + 4 * hi;
        stg[q * 64 + r32] = (unsigned short)(cvtpk(o0[i], o0[i]) & 0xffffu); stg[q * 64 + 32 + r32] = (unsigned short)(cvtpk(o1[i], o1[i]) & 0xffffu); }
    LDS_WAIT(); asm volatile("" ::: "memory");
#pragma unroll
    for (int it = 0; it < 4; ++it) { const int row = it * 8 + (lane >> 3), ch = lane & 7;
        const v4u v = *(LAS const v4u*)(stg + row * 64 + ch * 8);
        *(GAS v4u*)(OPb + (size_t)(p.b * SEQ + r + d * (l0 + row)) * ATTW + p.h * HD + ch * 8) = v; }
    LDS_WAIT(); asm volatile("" ::: "memory");
}
}

#ifndef DUP_MASK
#define DUP_MASK 0
#endif
#ifndef PP_IN_P8
#define PP_IN_P8 1
#endif
#ifndef P0_STATIC_ROWS
#define P0_STATIC_ROWS MROWS
#endif
#ifndef ATT_PRIO
#define ATT_PRIO 1
#endif
#ifndef WGM_P1
#define WGM_P1 4
#endif
#ifndef WGM_P4
#define WGM_P4 4
#endif
#ifndef WGM_P6
#define WGM_P6 4
#endif
#ifndef WGM_P8
#define WGM_P8 4
#endif
#ifndef WGM_P10
#define WGM_P10 4
#endif
#ifndef PROBE_AMP
#define PROBE_AMP 4
#endif
#ifndef PROBE_BLK
#define PROBE_BLK 0
#endif
#ifdef PROBE_EPI
#define PROBE_EPI_SET(n) if ((n) == PROBE_EPI) g.tacc = (unsigned*)(ws_ + WS_CTL) + 8;
#else
#define PROBE_EPI_SET(n)
#endif
#ifndef PG8_SP2
#define PG8_SP2 true
#endif
struct Args { const float* in[20]; float* out; unsigned char* ws; };
enum { I_X = 0, I_P, I_GMIX, I_WIN, I_CONVW, I_CONVB, I_QG, I_KG, I_GOC, I_GOA, I_WOUT, I_GFFN, I_WGATE, I_WUP, I_FCW, I_FCB, I_WDOWN, I_GPLE, I_WPG, I_WPP };

#define PHASE_PTRS KARG_DECL unsigned char* const ws_ = ARG_WS(); float* const out = ARG_OUT(); (void)out; \
    bf16* const WIN = (bf16*)(ws_ + WS_WIN); bf16* const WOUT = (bf16*)(ws_ + WS_WOUT); bf16* const WGU = (bf16*)(ws_ + WS_WGU); bf16* const WDN = (bf16*)(ws_ + WS_WDN); bf16* const WPG = (bf16*)(ws_ + WS_WPG); bf16* const WPP = (bf16*)(ws_ + WS_WPP); \
    bf16* const HB = (bf16*)(ws_ + WS_H); bf16* const PB = (bf16*)(ws_ + WS_PB); bf16* const ZC = (bf16*)(ws_ + WS_ZC); bf16* const QB = (bf16*)(ws_ + WS_Q); bf16* const KB = (bf16*)(ws_ + WS_K); bf16* const VB = (bf16*)(ws_ + WS_V); \
    bf16* const OP = (bf16*)(ws_ + WS_OP); float* const LP = (float*)(ws_ + WS_LP); bf16* const YB = (bf16*)(ws_ + WS_Y); bf16* const UB = (bf16*)(ws_ + WS_U); float* const TOPG = (float*)(ws_ + WS_TOPG); float* const BOTG = (float*)(ws_ + WS_BOTG); float* const TOPU = (float*)(ws_ + WS_TOPU); (void)TOPG; (void)BOTG; (void)TOPU; bf16* const PP = (bf16*)(ws_ + WS_PP); float* const SSB = (float*)(ws_ + WS_SS); (void)SSB; bf16* const X2B = (bf16*)(ws_ + WS_X2); (void)X2B; \
    (void)WIN; (void)WOUT; (void)WGU; (void)WDN; (void)WPG; (void)WPP; (void)HB; (void)PB; (void)ZC; (void)QB; (void)KB; (void)VB; (void)OP; (void)LP; (void)YB; (void)UB; (void)PP;
#define CAS __attribute__((address_space(4)))
#define ARG_IN(i) (*(const float* const CAS*)(ka_ + 8 * (i)))
#define ARG_OUT() (*(float* const CAS*)(ka_ + 8 * 20))
#define ARG_WS() (*(unsigned char* const CAS*)(ka_ + 8 * 21))
#define KARG_DECL const CAS unsigned char* ka_ = (const CAS unsigned char*)__builtin_amdgcn_kernarg_segment_ptr(); asm volatile("" : "+s"(ka_));
__device__ __forceinline__ void phase_stagger(int g, int ng, unsigned ticks) {
    if (g > 0) { const unsigned long long t0 = __builtin_amdgcn_s_memrealtime(); const unsigned long long wait = (unsigned long long)ticks * (unsigned)g / (unsigned)ng;
        while (__builtin_amdgcn_s_memrealtime() - t0 < wait) __builtin_amdgcn_s_sleep(16); }
}
#ifndef STAG6
#define STAG6 1000
#endif
#ifndef STAG6_NG
#define STAG6_NG 2
#endif
__device__ __forceinline__ void phase0(LAS unsigned char* L, const int lane, const int wave, const int G, const int bx, const int vcu, const int gw, const int NGW) {
    { PHASE_PTRS
    {
        LAS float* scr = (LAS float*)(L + wave * 16384);
        constexpr int I_IN = 16 * 96, I_OUT = 16 * 32, I_GT = 16 * 88, I_DN = 44 * 32, I_PG = 16 * 32, I_PPJ = 4 * 32;
        constexpr int NITEMS = I_IN + I_OUT + 2 * I_GT + I_DN + I_PG + I_PPJ;
        for (int it = gw; it < NITEMS; it += NGW) {
            int r = it;
            if (r < I_IN) { const int kb = r / 96, n0 = 32 * (r % 96); p0_transpose_item(ARG_IN(I_WIN), DM, INCOLS, WIN, map_in_row(n0), scr, 64 * kb, n0, lane); continue; } r -= I_IN;
            if (r < I_OUT) { const int kb = r / 32, n0 = 32 * (r % 32); p0_transpose_item(ARG_IN(I_WOUT), DM, DM, WOUT, n0, scr, 64 * kb, n0, lane); continue; } r -= I_OUT;
            if (r < I_GT) { const int kb = r / 88, n0 = 32 * (r % 88); p0_transpose_item(ARG_IN(I_WGATE), DM, DFF, WGU, 256 * (n0 >> 7) + (n0 & 127), scr, 64 * kb, n0, lane, ARG_IN(I_GFFN)); continue; } r -= I_GT;
            if (r < I_GT) { const int kb = r / 88, n0 = 32 * (r % 88); p0_transpose_item(ARG_IN(I_WUP), DM, DFF, WGU, 256 * (n0 >> 7) + 128 + (n0 & 127), scr, 64 * kb, n0, lane, ARG_IN(I_GFFN)); continue; } r -= I_GT;
            if (r < I_DN) { const int kb = r / 32, n0 = 32 * (r % 32); p0_transpose_item(ARG_IN(I_WDOWN), DFF, DM, WDN, n0, scr, 64 * kb, n0, lane); continue; } r -= I_DN;
            if (r < I_PG) { const int kb = r / 32, n0 = 32 * (r % 32); p0_transpose_item(ARG_IN(I_WPG), DM, DM, WPG, n0, scr, 64 * kb, n0, lane, ARG_IN(I_GPLE)); continue; } r -= I_PG;
            { const int kb = r / 32, n0 = 32 * (r % 32); p0_transpose_item(ARG_IN(I_WPP), PLED, DM, WPP, n0, scr, 64 * kb, n0, lane); }
        }
        rms_rows(ARG_IN(I_X), ARG_IN(I_GMIX), HB, gw, NGW, lane, P0_STATIC_ROWS, (P0_STATIC_ROWS < MROWS) ? (unsigned*)(ws_ + WS_CTL) + CW_Q0 : nullptr);
        for (int m = gw * 8; m < MROWS; m += NGW * 8) {
            f32x4 v[8];
#pragma unroll
            for (int r = 0; r < 8; ++r) v[r] = ((const GAS f32x4*)(ARG_IN(I_P) + (size_t)(m + r) * PLED))[lane];
#pragma unroll
            for (int r = 0; r < 8; ++r) ((GAS unsigned long long*)(PB + (size_t)(m + r) * PLED))[lane] = (unsigned long long)cvtpk(v[r].x, v[r].y) | ((unsigned long long)cvtpk(v[r].z, v[r].w) << 32);
        }
    }
    }
}
__device__ __forceinline__ void phase1(LAS unsigned char* L, const int lane, const int wave, const int G, const int bx, const int vcu, const int gw, const int NGW) {
    { PHASE_PTRS
    {
        int kdim_ = DM; asm volatile("" : "+s"(kdim_)); pg8::Gemm g{HB, WIN, MROWS, INCOLS, kdim_}; PROBE_EPI_SET(1) pg8::StaticOrder S; S.init(MROWS, INCOLS, G, bx, WGM_P1);
        pg8::EpiInProj E{ZC, QB, KB, VB, ARG_IN(I_QG), ARG_IN(I_KG), 0.125f * LOG2E, EPS};
        pg8::gemm_phase<pg8::EpiInProj, pg8::StaticOrder, true, PG8_SP2>(L, g, S, E);
    }
    }
}
__device__ __forceinline__ void phase2(LAS unsigned char* L, const int lane, const int wave, const int G, const int bx, const int vcu, const int gw, const int NGW) {
    { PHASE_PTRS
    {
        const float mq = wave_max(fabsf(ARG_IN(I_QG)[lane])), mk = wave_max(fabsf(ARG_IN(I_KG)[lane]));
        const float negM = -8.0f * mq * mk * LOG2E;
        const int nper = 3072 / G, tid = threadIdx.x;
#define ATT_UNIT(i) ((G == 256) ? ((4 * (vcu >> 5) + (i) / 3) * 96 + ((i) % 3) * 32 + (vcu & 31)) : (vcu * nper + (i)))
#if ATT_PRIO == 1
        if (wave >= 4) __builtin_amdgcn_s_setprio(1);
#endif
        att::Stage st; att::UnitP p = att::unit_params(ATT_UNIT(0));
        att::stage_load(st, QB, KB, VB, p, tid, wave, lane);
        for (int i = 0; i < nper; ++i) {
#if defined(PROBE_ATT) && PROBE_ATT == 2
            const unsigned long long tw0_ = __builtin_amdgcn_s_memrealtime();
#endif
            att::stage_write(st, L, tid);
            bf16x8 qf[4];
#pragma unroll
            for (int s = 0; s < 4; ++s) qf[s] = st.q[s];
            asm volatile("s_waitcnt lgkmcnt(0)" ::: "memory"); __builtin_amdgcn_s_barrier(); asm volatile("" ::: "memory");
#if defined(PROBE_ATT) && PROBE_ATT == 2
            if (bx == PROBE_BLK && tid == 0) __hip_atomic_fetch_add((unsigned*)(ws_ + WS_CTL) + 8, (unsigned)(__builtin_amdgcn_s_memrealtime() - tw0_), __ATOMIC_RELAXED, __HIP_MEMORY_SCOPE_AGENT);
#endif
            att::UnitP pn = p;
            if (i + 1 < nper) { pn = att::unit_params(ATT_UNIT(i + 1)); att::stage_load(st, QB, KB, VB, pn, tid, wave, lane); }
#if defined(PROBE_ATT) && PROBE_ATT == 1
            const unsigned long long ta0_ = __builtin_amdgcn_s_memrealtime();
#endif
            att::compute_tile(L, qf, p, OP + (size_t)p.branch * MROWS * ATTW, LP + (size_t)p.branch * MROWS * NHEAD, negM, wave, lane);
#if defined(PROBE_ATT) && PROBE_ATT == 1
            if (bx == PROBE_BLK && tid == 0) __hip_atomic_fetch_add((unsigned*)(ws_ + WS_CTL) + 8, (unsigned)(__builtin_amdgcn_s_memrealtime() - ta0_), __ATOMIC_RELAXED, __HIP_MEMORY_SCOPE_AGENT);
#endif
            asm volatile("s_waitcnt lgkmcnt(0)" ::: "memory"); __builtin_amdgcn_s_barrier(); asm volatile("" ::: "memory");
            p = pn;
        }
#if ATT_PRIO == 1
        __builtin_amdgcn_s_setprio(0);
#endif
    }
    }
}
__device__ __forceinline__ void phase3(LAS unsigned char* L, const int lane, const int wave, const int G, const int bx, const int vcu, const int gw, const int NGW) {
    { PHASE_PTRS
    {
        const int c = 8 * lane;
        float cw0[8], cw1[8], cw2[8], cbv[8], gc[8], ga[8];
        load8f(ARG_IN(I_CONVW) + c, cw0); load8f(ARG_IN(I_CONVW) + CONVW + c, cw1); load8f(ARG_IN(I_CONVW) + 2 * CONVW + c, cw2);
        load8f(ARG_IN(I_CONVB) + c, cbv); load8f(ARG_IN(I_GOC) + c, gc); load8f(ARG_IN(I_GOA) + c, ga);
        for (int ch = gw; ch < MROWS / 16; ch += NGW) {
            const int m0 = ch * 16;
            float u1[8], u2[8];
            if ((m0 & (SEQ - 1)) == 0) {
#pragma unroll
                for (int j = 0; j < 8; ++j) { u1[j] = 0.f; u2[j] = 0.f; }
            } else {
                float a[8], bb[8];
                unpack8(*(const GAS v4u*)(ZC + (size_t)(m0 - 1) * 1536 + 512 + c), a); unpack8(*(const GAS v4u*)(ZC + (size_t)(m0 - 1) * 1536 + 1024 + c), bb);
#pragma unroll
                for (int j = 0; j < 8; ++j) u1[j] = a[j] * bb[j];
                unpack8(*(const GAS v4u*)(ZC + (size_t)(m0 - 2) * 1536 + 512 + c), a); unpack8(*(const GAS v4u*)(ZC + (size_t)(m0 - 2) * 1536 + 1024 + c), bb);
#pragma unroll
                for (int j = 0; j < 8; ++j) u2[j] = a[j] * bb[j];
            }
            for (int tt = 0; tt < 16; ++tt) {
                const size_t m = (size_t)(m0 + tt);
                float zb[8], zc[8], zx[8], y[8];
                unpack8(*(const GAS v4u*)(ZC + m * 1536 + c), zb); unpack8(*(const GAS v4u*)(ZC + m * 1536 + 512 + c), zc); unpack8(*(const GAS v4u*)(ZC + m * 1536 + 1024 + c), zx);
                float o1[8], o2[8], o3[8];
                unpack8(*(const GAS v4u*)(OP + m * ATTW + c), o1); unpack8(*(const GAS v4u*)(OP + ((size_t)MROWS + m) * ATTW + c), o2); unpack8(*(const GAS v4u*)(OP + ((size_t)2 * MROWS + m) * ATTW + c), o3);
                const float lt = LP[m * NHEAD + (lane >> 3)] + LP[((size_t)MROWS + m) * NHEAD + (lane >> 3)] + LP[((size_t)2 * MROWS + m) * NHEAD + (lane >> 3)];
                float ss = 0.f;
#pragma unroll
                for (int j = 0; j < 8; ++j) { const float u0 = zc[j] * zx[j]; y[j] = zb[j] * (cw0[j] * u2[j] + cw1[j] * u1[j] + cw2[j] * u0 + cbv[j]); ss += y[j] * y[j]; u2[j] = u1[j]; u1[j] = u0; }
                const float rc = __builtin_amdgcn_rsqf(wave_sum(ss) * (1.f / CONVW) + EPS);
#pragma unroll
                for (int j = 0; j < 8; ++j) y[j] = y[j] * rc * gc[j];
                *(GAS v4u*)(YB + m * DM + c) = pack8f(y);
                const float rl = 1.0f / lt; float sa = 0.f;
#pragma unroll
                for (int j = 0; j < 8; ++j) { y[j] = (o1[j] + o2[j] + o3[j]) * rl; sa += y[j] * y[j]; }
                const float ra = __builtin_amdgcn_rsqf(wave_sum(sa) * (1.f / ATTW) + EPS);
#pragma unroll
                for (int j = 0; j < 8; ++j) y[j] = y[j] * ra * ga[j];
                *(GAS v4u*)(YB + m * DM + CONVW + c) = pack8f(y);
            }
        }
    }
    }
}
__device__ __forceinline__ void phase4(LAS unsigned char* L, const int lane, const int wave, const int G, const int bx, const int vcu, const int gw, const int NGW) {
    for (int s_ = 0; s_ < (PP_IN_P8 ? 1 : 2); ++s_) {
        if (s_ == 0) { PHASE_PTRS
            int kdim_ = DM; asm volatile("" : "+s"(kdim_)); pg8::Gemm g{YB, WOUT, MROWS, DM, kdim_}; PROBE_EPI_SET(4) pg8::StaticOrder S; S.init(MROWS, DM, G, bx, WGM_P4);
            pg8::EpiResNorm<false> E{ARG_IN(I_X), HB, SSB, DM, (LAS float*)(L + XCH_OFF)};
            pg8::gemm_phase<pg8::EpiResNorm<false>, pg8::StaticOrder, true, PG8_SP2>(L, g, S, E);
        } else { PHASE_PTRS
            int kdim_ = PLED; asm volatile("" : "+s"(kdim_)); pg8::Gemm g{PB, WPP, MROWS, DM, kdim_}; PROBE_EPI_SET(4) pg8::StaticOrder S; S.init(MROWS, DM, G, bx, WGM_P4);
            pg8::EpiBf16 E{PP, DM};
            pg8::gemm_phase<pg8::EpiBf16, pg8::StaticOrder, true, PG8_SP2>(L, g, S, E);
        }
    }
}
__device__ __forceinline__ void phase6(LAS unsigned char* L, const int lane, const int wave, const int G, const int bx, const int vcu, const int gw, const int NGW) {
    { PHASE_PTRS
    {
        int kdim_ = DM; asm volatile("" : "+s"(kdim_)); pg8::Gemm g{HB, WGU, MROWS, 2 * DFF, kdim_}; PROBE_EPI_SET(6) pg8::StaticOrder S; S.init(MROWS, 2 * DFF, G, bx, WGM_P6);
        pg8::EpiGUAct E{UB, DFF, SSB, EPS, ARG_IN(I_FCW), ARG_IN(I_FCB), TOPG, BOTG, TOPU, (LAS float*)(L + XCH_OFF)};
        pg8::gemm_phase<pg8::EpiGUAct, pg8::StaticOrder, true, PG8_SP2>(L, g, S, E);
    }
    }
}
__device__ __forceinline__ void ffn_fix_rows(const float* fcw, const float* fcb, const float* TOPG, const float* BOTG, const float* TOPU, bf16* UB, int pm, int c) {
    float w0[8], w1[8], w2[8], bv[8], g0[8], g1[8], gm1[8], gm2[8], u0[8], u1[8], a0[8], a1[8];
    load8f(fcw + c, w0); load8f(fcw + DFF + c, w1); load8f(fcw + 2 * DFF + c, w2); load8f(fcb + c, bv);
    load8f(TOPG + (size_t)(pm * 2) * DFF + c, g0); load8f(TOPG + (size_t)(pm * 2 + 1) * DFF + c, g1);
    load8f(BOTG + (size_t)(pm * 2 - 2) * DFF + c, gm2); load8f(BOTG + (size_t)(pm * 2 - 1) * DFF + c, gm1);
    load8f(TOPU + (size_t)(pm * 2) * DFF + c, u0); load8f(TOPU + (size_t)(pm * 2 + 1) * DFF + c, u1);
#pragma unroll
    for (int j = 0; j < 8; ++j) {
        const float p0 = w0[j] * gm2[j] + w1[j] * gm1[j] + w2[j] * g0[j] + bv[j], p1 = w0[j] * gm1[j] + w1[j] * g0[j] + w2[j] * g1[j] + bv[j];
        a0[j] = p0 * __builtin_amdgcn_rcpf(1.0f + __builtin_amdgcn_exp2f(-LOG2E * p0)) * u0[j];
        a1[j] = p1 * __builtin_amdgcn_rcpf(1.0f + __builtin_amdgcn_exp2f(-LOG2E * p1)) * u1[j];
    }
    *(GAS v4u*)(UB + (size_t)(pm * 256) * DFF + c) = pack8f(a0);
    *(GAS v4u*)(UB + (size_t)(pm * 256 + 1) * DFF + c) = pack8f(a1);
}
__device__ __forceinline__ void phase8(LAS unsigned char* L, const int lane, const int wave, const int G, const int bx, const int vcu, const int gw, const int NGW) {
    { PHASE_PTRS
    {
        int kdim_ = DFF; asm volatile("" : "+s"(kdim_)); pg8::Gemm g{UB, WDN, MROWS, DM, kdim_}; PROBE_EPI_SET(8) pg8::StaticOrder S; S.init(MROWS, DM, G, bx, WGM_P8);
        { const int tid = threadIdx.x; pg8::Unit fu; int prev = -1;
          for (int i = 0; S.next(i, fu); ++i) { if (fu.pm != prev && (fu.pm & 31) != 0 && 8 * tid < DFF) ffn_fix_rows(ARG_IN(I_FCW), ARG_IN(I_FCB), TOPG, BOTG, TOPU, UB, fu.pm, 8 * tid); prev = fu.pm; }
          asm volatile("s_waitcnt vmcnt(0)" ::: "memory"); __syncthreads(); }
        pg8::EpiResNorm<true> E{HB, X2B, SSB, DM, (LAS float*)(L + XCH_OFF)};
        pg8::gemm_phase<pg8::EpiResNorm<true>, pg8::StaticOrder, true, PG8_SP2>(L, g, S, E);
    }
    }
#if PP_IN_P8
    { PHASE_PTRS
        int kdim_ = PLED; asm volatile("" : "+s"(kdim_)); pg8::Gemm g{PB, WPP, MROWS, DM, kdim_}; pg8::StaticOrder S; S.init(MROWS, DM, G, bx, WGM_P8);
        pg8::EpiBf16 E{PP, DM};
        pg8::gemm_phase<pg8::EpiBf16, pg8::StaticOrder, true, PG8_SP2>(L, g, S, E);
    }
#endif
}
__device__ __forceinline__ void phase10(LAS unsigned char* L, const int lane, const int wave, const int G, const int bx, const int vcu, const int gw, const int NGW) {
    { PHASE_PTRS
    {
        int kdim_ = DM; asm volatile("" : "+s"(kdim_)); pg8::Gemm g{X2B, WPG, MROWS, DM, kdim_}; PROBE_EPI_SET(10) pg8::StaticOrder S; S.init(MROWS, DM, G, bx, WGM_P10);
        pg8::EpiPle E{X2B, out, PP, DM, SSB, EPS};
        pg8::gemm_phase<pg8::EpiPle, pg8::StaticOrder, true, PG8_SP2>(L, g, S, E);
    }
    }
}

#if defined(PROBE_CLK)
#define PROBE_T0(n) unsigned long long tp0_##n = 0; if ((n) == PROBE_CLK) tp0_##n = __builtin_amdgcn_s_memtime();
#define PROBE_T1(n) if ((n) == PROBE_CLK && bx == PROBE_BLK && tid == 0) { __hip_atomic_fetch_add((unsigned*)(ctl + 8), (unsigned)((__builtin_amdgcn_s_memtime() - tp0_##n) / 25), __ATOMIC_RELAXED, __HIP_MEMORY_SCOPE_AGENT); }
#elif defined(PROBE_PHASE)
#define PROBE_T0(n) unsigned long long tp0_##n = 0; if ((n) == PROBE_PHASE) tp0_##n = __builtin_amdgcn_s_memrealtime();
#define PROBE_T1(n) if ((n) == PROBE_PHASE && bx == PROBE_BLK && tid == 0) { __hip_atomic_fetch_add((unsigned*)(ctl + 8), (unsigned)(__builtin_amdgcn_s_memrealtime() - tp0_##n), __ATOMIC_RELAXED, __HIP_MEMORY_SCOPE_AGENT); }
#else
#define PROBE_T0(n)
#define PROBE_T1(n)
#endif
#ifdef PROBE_BAR
#define XBAR() do { const unsigned long long tb0_ = __builtin_amdgcn_s_memrealtime(); xcd_barrier(bar); ++nbar_; if ((PROBE_BAR == 99 || nbar_ == PROBE_BAR) && bx == PROBE_BLK && tid == 0) __hip_atomic_fetch_add((unsigned*)(ctl + 8), (unsigned)(__builtin_amdgcn_s_memrealtime() - tb0_), __ATOMIC_RELAXED, __HIP_MEMORY_SCOPE_AGENT); } while (0)
#else
#define XBAR() xcd_barrier(bar)
#endif
__global__ void __launch_bounds__(NWAVES * 64, 2) hybrid_fwd(Args args) {
    extern __shared__ __attribute__((aligned(16))) unsigned char lds[];
    LAS unsigned char* L = (LAS unsigned char*)lds;
    volatile LAS unsigned* MISC = (volatile LAS unsigned*)(L + MISC_OFF);
    const int tid = threadIdx.x, lane = tid & 63, wave = __builtin_amdgcn_readfirstlane(tid >> 6);
    const int G = gridDim.x; const int bx = blockIdx.x;
    const int vcu = (G % 8 == 0) ? (bx % 8) * (G / 8) + bx / 8 : bx;
    const int gw = vcu * NWAVES + wave, NGW = G * NWAVES;
    gu32* ctl; { KARG_DECL ctl = (gu32*)(ARG_WS() + WS_CTL); }
    for (int u = tid; u < (LDS_BYTES - LDSCTL_OFF) / 4; u += NWAVES * 64) ((LAS unsigned*)(L + LDSCTL_OFF))[u] = 0u;
    __syncthreads();
    XcdBarrier bar = xcd_barrier_post((unsigned*)(ctl + CW_BAR), MISC + 8);
#ifdef PROBE_TOTAL
    const unsigned long long tt0_ = __builtin_amdgcn_s_memrealtime();
#endif
#ifdef PROBE_BAR
    int nbar_ = 0;
#endif

#ifndef SKIP_P0
    PROBE_T0(0) phase0(L, lane, wave, G, bx, vcu, gw, NGW); PROBE_T1(0)
#endif
    XBAR();
#if (DUP_MASK >> 0) & 1
    phase0(L, lane, wave, G, bx, vcu, gw, NGW);
    XBAR();
#endif
#ifdef EXTRA_BARRIERS
    { int nb_ = EXTRA_BARRIERS; asm volatile("" : "+s"(nb_)); for (int eb_ = 0; eb_ < nb_; ++eb_) xcd_barrier(bar); }
#endif

#ifndef SKIP_P1
    PROBE_T0(1) phase1(L, lane, wave, G, bx, vcu, gw, NGW); PROBE_T1(1)
#endif
    XBAR();
#if (DUP_MASK >> 1) & 1
    phase1(L, lane, wave, G, bx, vcu, gw, NGW);
    XBAR();
#endif

#ifndef SKIP_P2
    PROBE_T0(2) phase2(L, lane, wave, G, bx, vcu, gw, NGW); PROBE_T1(2)
#endif
    XBAR();
#if (DUP_MASK >> 2) & 1
    phase2(L, lane, wave, G, bx, vcu, gw, NGW);
    XBAR();
#endif

#ifndef SKIP_P3
    PROBE_T0(3) phase3(L, lane, wave, G, bx, vcu, gw, NGW); PROBE_T1(3)
#endif
    XBAR();
#if (DUP_MASK >> 3) & 1
    phase3(L, lane, wave, G, bx, vcu, gw, NGW);
    XBAR();
#endif

#ifndef SKIP_P4
    PROBE_T0(4) phase4(L, lane, wave, G, bx, vcu, gw, NGW); PROBE_T1(4)
#endif
    XBAR();
#if (DUP_MASK >> 4) & 1
    phase4(L, lane, wave, G, bx, vcu, gw, NGW);
    XBAR();
#endif

#ifndef SKIP_P6
    PROBE_T0(6) phase6(L, lane, wave, G, bx, vcu, gw, NGW); PROBE_T1(6)
#endif
    XBAR();
#if (DUP_MASK >> 6) & 1
    phase6(L, lane, wave, G, bx, vcu, gw, NGW);
    XBAR();
#endif


#ifndef SKIP_P8
    PROBE_T0(8) phase8(L, lane, wave, G, bx, vcu, gw, NGW); PROBE_T1(8)
#endif
    XBAR();
#if (DUP_MASK >> 8) & 1
    phase8(L, lane, wave, G, bx, vcu, gw, NGW);
    XBAR();
#endif


#ifndef SKIP_P10
    PROBE_T0(10) phase10(L, lane, wave, G, bx, vcu, gw, NGW); PROBE_T1(10)
#endif
#if (DUP_MASK >> 10) & 1
    XBAR();
    phase10(L, lane, wave, G, bx, vcu, gw, NGW);
#endif
#ifdef PROBE_TOTAL
    if (bx == PROBE_BLK && tid == 0) __hip_atomic_fetch_add((unsigned*)(ctl + 8), (unsigned)(__builtin_amdgcn_s_memrealtime() - tt0_), __ATOMIC_RELAXED, __HIP_MEMORY_SCOPE_AGENT);
#endif
#if defined(PROBE_PHASE) || defined(PROBE_EPI) || defined(PROBE_BAR) || defined(PROBE_CLK) || defined(PROBE_ATT) || defined(PROBE_TOTAL)
    if (bx == PROBE_BLK && tid == 0) { const unsigned tk = __hip_atomic_load((unsigned*)(ctl + 8), __ATOMIC_RELAXED, __HIP_MEMORY_SCOPE_AGENT); const unsigned long long t0 = __builtin_amdgcn_s_memrealtime();
        while (__builtin_amdgcn_s_memrealtime() - t0 < (unsigned long long)tk * PROBE_AMP) __builtin_amdgcn_s_sleep(32); }
#endif
}

extern "C" void kernel_launch(void* const* d_in, const int* in_sizes, int n_in, void* d_out, int out_size, void* d_ws, size_t ws_size, hipStream_t stream) {
    static int grid = 0;
    if (grid == 0) {
        if (n_in != 20 || out_size != MROWS * DM || ws_size < WS_END) { fprintf(stderr, "kernel_launch: unexpected shapes (n_in %d, out %d, ws %zu); nothing launched\n", n_in, out_size, ws_size); grid = -1; return; }
        int dev = 0, cus = 0, per_cu = 0;
        if (hipGetDevice(&dev) != hipSuccess || hipDeviceGetAttribute(&cus, hipDeviceAttributeMultiprocessorCount, dev) != hipSuccess) { grid = -1; return; }
        if (hipFuncSetAttribute((const void*)hybrid_fwd, hipFuncAttributeMaxDynamicSharedMemorySize, LDS_BYTES) != hipSuccess) { fprintf(stderr, "kernel_launch: hipFuncSetAttribute failed\n"); grid = -1; return; }
        if (hipOccupancyMaxActiveBlocksPerMultiprocessor(&per_cu, (const void*)hybrid_fwd, NWAVES * 64, LDS_BYTES) != hipSuccess || per_cu < 1)
            fprintf(stderr, "kernel_launch: note: occupancy query reports %d workgroups per CU\n", per_cu);
        (void)hipGetLastError();
        grid = cus;
        if (grid != 256) fprintf(stderr, "kernel_launch: %d CUs (built for 256)\n", grid);
    }
    if (grid < 0) return;
    if (hipMemsetAsync((char*)d_ws + WS_CTL, 0, CTL_ZERO_BYTES, stream) != hipSuccess) { fprintf(stderr, "kernel_launch: hipMemsetAsync failed\n"); return; }
    Args a{};
    for (int i = 0; i < 20; ++i) a.in[i] = (const float*)d_in[i];
    a.out = (float*)d_out; a.ws = (unsigned char*)d_ws;
    hipLaunchKernelGGL(hybrid_fwd, dim3(grid), dim3(NWAVES * 64), LDS_BYTES, stream, a);
    const hipError_t le = hipPeekAtLastError();
    if (le != hipSuccess) fprintf(stderr, "kernel_launch: launch failed: %s\n", hipGetErrorName(le));
}
```

```cpp
#include <hip/hip_runtime.h>
#include <cstdio>
#include <cstdint>
namespace pg8 {
#define PG8_LAS __attribute__((address_space(3)))
typedef unsigned short bf16_t;
typedef short bf16x8 __attribute__((ext_vector_type(8)));
typedef float f32x4 __attribute__((ext_vector_type(4)));
typedef unsigned u32x4 __attribute__((ext_vector_type(4)));
constexpr int BM = 256, BK = 64, HALF = 128, HTB = HALF * BK * 2  , STAGE_BYTES = 8 * HTB, NXCD = 8;
#ifndef PG8_WGM
#define PG8_WGM 4
#endif
constexpr int WGM = PG8_WGM;

__host__ __device__ __forceinline__ int lds_byte(int r, int c) { const int st = (r >> 4) * 2 + (c >> 5), rr = r & 15, cc = c & 31, ob = rr * 64 + cc * 2; return st * 1024 + (ob ^ (((ob >> 9) & 1) << 5)); }
__host__ __device__ __forceinline__ void stage_rc(int b, int& R, int& C) { const int st = b / 1024, sb = b % 1024, swz = sb ^ (((sb >> 9) & 1) << 5); R = (st >> 1) * 16 + swz / 64; C = (st & 1) * 32 + (swz % 64) / 2; }
__host__ __device__ __forceinline__ int perm32(int rho) { const int n = rho >> 4, i = rho & 15; return 8 * (i >> 2) + 4 * n + (i & 3); }

struct Unit { int pm, pn; };
struct Gemm { const bf16_t* A; const bf16_t* Bt; int M, N, K; unsigned* tacc = nullptr; };

struct StaticOrder {
    int nM, nN, nwg, G, c, wgm;
    __host__ __device__ void init(int M, int N, int G_, int c_, int wgm_ = WGM) { nM = M / BM; nN = N / BM; nwg = nM * nN; G = G_; c = c_; wgm = wgm_; }
    __host__ __device__ bool next(int i, Unit& u) const {
        const long L = (long)i * G + c; if (L >= nwg) return false;
        int wgid = (int)L; { const int q = nwg / NXCD, r = nwg % NXCD, xcd = wgid % NXCD, off = wgid / NXCD; wgid = (xcd < r ? xcd * (q + 1) : r * (q + 1) + (xcd - r) * q) + off; }
        const int nig = wgm * nN, gid = wgid / nig, fm = gid * wgm, gsz = (nM - fm) < wgm ? (nM - fm) : wgm;
        u.pm = fm + ((wgid % nig) % gsz); u.pn = (wgid % nig) / gsz; return true;
    }
    __device__ __forceinline__ void a_ready(const Unit&) const {}
    __device__ __forceinline__ void done(const Unit&) const {}
};

#ifndef EPI_NT
#define EPI_NT 0
#endif
__device__ __forceinline__ unsigned cvt_pk_bf16(float lo, float hi) { unsigned r; asm volatile("v_cvt_pk_bf16_f32 %0, %1, %2" : "=v"(r) : "v"(lo), "v"(hi)); return r; }
__device__ __forceinline__ u32x4 pack8(const f32x4& v0, const f32x4& v1) { u32x4 w; w.x = cvt_pk_bf16(v0[0], v0[1]); w.y = cvt_pk_bf16(v0[2], v0[3]); w.z = cvt_pk_bf16(v1[0], v1[1]); w.w = cvt_pk_bf16(v1[2], v1[3]); return w; }
__device__ __forceinline__ float bf2f(unsigned short h) { return __builtin_bit_cast(float, (unsigned)h << 16); }

struct EpiBf16 {
    static constexpr bool PERM = true, AFTER_DRAIN = false;
    bf16_t* O; int ldc;
    __device__ __forceinline__ void operator()(const f32x4 (&acc)[2][2][4][2], const Unit& u, int wr, int wc, int fr, int fq) const {
        const int row0 = u.pm * BM + wr * 64 + fr, col0 = u.pn * BM + wc * 32 + 8 * fq;
#pragma unroll
        for (int ai = 0; ai < 2; ++ai)
#pragma unroll
            for (int m = 0; m < 4; ++m) { bf16_t* rowp = O + (size_t)(row0 + ai * HALF + m * 16) * ldc + col0;
#pragma unroll
                for (int bj = 0; bj < 2; ++bj) *(u32x4*)(rowp + bj * HALF) = pack8(acc[ai][bj][m][0], acc[ai][bj][m][1]); }
    }
};
__device__ __forceinline__ float rstd4(const f32x4 a, float eps) { return __builtin_amdgcn_rsqf(((a[0] + a[1]) + (a[2] + a[3])) * (1.0f / 1024.0f) + eps); }
struct EpiGU {
    static constexpr bool PERM = true, AFTER_DRAIN = false;
    bf16_t* G; bf16_t* U; int ldc; const float* SS; float eps;
    __device__ __forceinline__ void operator()(const f32x4 (&acc)[2][2][4][2], const Unit& u, int wr, int wc, int fr, int fq) const {
        const int row0 = u.pm * BM + wr * 64 + fr, col0 = u.pn * HALF + wc * 32 + 8 * fq;
        f32x4 sp[2][4];
#pragma unroll
        for (int ai = 0; ai < 2; ++ai)
#pragma unroll
            for (int m = 0; m < 4; ++m) sp[ai][m] = *(const f32x4*)(SS + (size_t)(row0 + ai * HALF + m * 16) * 4);
#pragma unroll
        for (int ai = 0; ai < 2; ++ai)
#pragma unroll
            for (int m = 0; m < 4; ++m) { const int row = row0 + ai * HALF + m * 16; const float rs = rstd4(sp[ai][m], eps); const size_t off = (size_t)row * ldc + col0;
                *(u32x4*)(G + off) = pack8(acc[ai][0][m][0] * rs, acc[ai][0][m][1] * rs);
                *(u32x4*)(U + off) = pack8(acc[ai][1][m][0] * rs, acc[ai][1][m][1] * rs); }
    }
};
__device__ __forceinline__ float dpp_ror1(float v) { return __builtin_bit_cast(float, __builtin_amdgcn_mov_dpp(__builtin_bit_cast(int, v), 0x121, 0xf, 0xf, false)); }
__device__ __forceinline__ float dpp_ror2(float v) { return __builtin_bit_cast(float, __builtin_amdgcn_mov_dpp(__builtin_bit_cast(int, v), 0x122, 0xf, 0xf, false)); }
struct EpiGUAct {
    static constexpr bool PERM = true, AFTER_DRAIN = false;
    bf16_t* ACT; int ldc; const float* SS; float eps; const float* cw; const float* cbias; float* TOPG; float* BOTG; float* TOPU; PG8_LAS float* xch;
    __device__ __forceinline__ void operator()(const f32x4 (&acc_)[2][2][4][2], const Unit& u, int wr, int wc, int fr, int fq) const {
        f32x4 (&acc)[2][2][4][2] = const_cast<f32x4 (&)[2][2][4][2]>(acc_);
        const int row0 = u.pm * BM + wr * 64 + fr, colh = wc * 32 + 8 * fq, col0 = u.pn * HALF + colh;
        {
            f32x4 sp[2][4];
#pragma unroll
            for (int ai = 0; ai < 2; ++ai)
#pragma unroll
                for (int m = 0; m < 4; ++m) sp[ai][m] = *(const f32x4*)(SS + (size_t)(row0 + ai * HALF + m * 16) * 4);
#pragma unroll
            for (int ai = 0; ai < 2; ++ai)
#pragma unroll
                for (int m = 0; m < 4; ++m) { const float rs = rstd4(sp[ai][m], eps);
#pragma unroll
                    for (int bj = 0; bj < 2; ++bj)
#pragma unroll
                        for (int n = 0; n < 2; ++n) acc[ai][bj][m][n] = acc[ai][bj][m][n] * rs; }
        }
        if (fr >= 14) {
#pragma unroll
            for (int ai = 0; ai < 2; ++ai)
#pragma unroll
                for (int n = 0; n < 2; ++n) *(PG8_LAS f32x4*)(xch + (((wr * 2 + ai) * 2 + (fr - 14)) * 128 + colh + 4 * n)) = acc[ai][0][3][n];
            if (wr == 1) {
#pragma unroll
                for (int n = 0; n < 2; ++n) *(f32x4*)(BOTG + (size_t)(u.pm * 2 + fr - 14) * ldc + col0 + 4 * n) = acc[1][0][3][n];
            }
        }
        if (wr == 0 && fr < 2) {
#pragma unroll
            for (int n = 0; n < 2; ++n) { *(f32x4*)(TOPG + (size_t)(u.pm * 2 + fr) * ldc + col0 + 4 * n) = acc[0][0][0][n]; *(f32x4*)(TOPU + (size_t)(u.pm * 2 + fr) * ldc + col0 + 4 * n) = acc[0][1][0][n]; }
        }
        asm volatile("s_waitcnt lgkmcnt(0)" ::: "memory"); __builtin_amdgcn_s_barrier(); asm volatile("" ::: "memory");
        typedef unsigned u32x2v __attribute__((ext_vector_type(2)));
#pragma unroll
        for (int n = 0; n < 2; ++n) {
            const f32x4 w0 = *(const f32x4*)(cw + col0 + 4 * n), w1 = *(const f32x4*)(cw + ldc + col0 + 4 * n), w2 = *(const f32x4*)(cw + 2 * ldc + col0 + 4 * n), bb = *(const f32x4*)(cbias + col0 + 4 * n);
#pragma unroll
            for (int ai = 0; ai < 2; ++ai) {
                f32x4 r1p, r2p;
                if (wr == 0 && ai == 0) { r1p = (f32x4){0.f, 0.f, 0.f, 0.f}; r2p = (f32x4){0.f, 0.f, 0.f, 0.f}; }
                else {
                    const int pw = wr ^ 1, pai = (wr == 1) ? ai : ai - 1;
                    const PG8_LAS float* xb = xch + ((pw * 2 + pai) * 2) * 128 + colh + 4 * n;
                    const f32x4 e2 = *(const PG8_LAS f32x4*)(xb), e1 = *(const PG8_LAS f32x4*)(xb + 128); r1p = e1; r2p = (fr == 0) ? e2 : e1;
                }
#pragma unroll
                for (int m = 0; m < 4; ++m) {
                    const f32x4 g = acc[ai][0][m][n], uu = acc[ai][1][m][n];
                    f32x4 r1, r2, a4;
#pragma unroll
                    for (int j = 0; j < 4; ++j) { r1[j] = dpp_ror1(g[j]); r2[j] = dpp_ror2(g[j]); }
#pragma unroll
                    for (int j = 0; j < 4; ++j) {
                        const float p1 = (fr == 0) ? r1p[j] : r1[j], p2 = (fr < 2) ? r2p[j] : r2[j];
                        const float pre = w0[j] * p2 + w1[j] * p1 + w2[j] * g[j] + bb[j];
                        a4[j] = pre * __builtin_amdgcn_rcpf(1.0f + __builtin_amdgcn_exp2f(-1.4426950408889634f * pre)) * uu[j];
                    }
                    r1p = r1; r2p = r2;
                    u32x2v w; w.x = cvt_pk_bf16(a4[0], a4[1]); w.y = cvt_pk_bf16(a4[2], a4[3]);
#if EPI_NT
                    __builtin_nontemporal_store(w, (u32x2v*)(ACT + (size_t)(row0 + ai * HALF + m * 16) * ldc + col0 + 4 * n));
#else
                    *(u32x2v*)(ACT + (size_t)(row0 + ai * HALF + m * 16) * ldc + col0 + 4 * n) = w;
#endif
                    asm volatile("" ::: "memory");
                }
            }
        }
    }
};
struct EpiInProj {
    static constexpr bool PERM = true, AFTER_DRAIN = false;
    bf16_t* ZC; bf16_t* Q; bf16_t* Kk; bf16_t* V; const float* gq; const float* gk; float qscale; float eps;
    __device__ __forceinline__ void operator()(const f32x4 (&acc)[2][2][4][2], const Unit& u, int wr, int wc, int fr, int fq) const {
        if (u.pn < 6) {
            const int row0 = u.pm * BM + wr * 64 + fr, col0 = u.pn * BM + wc * 32 + 8 * fq;
#pragma unroll
            for (int ai = 0; ai < 2; ++ai)
#pragma unroll
                for (int m = 0; m < 4; ++m) { bf16_t* rowp = ZC + (size_t)(row0 + ai * HALF + m * 16) * 1536 + col0;
#pragma unroll
                    for (int bj = 0; bj < 2; ++bj) *(u32x4*)(rowp + bj * HALF) = pack8(acc[ai][bj][m][0], acc[ai][bj][m][1]); }
        } else {
            const int sec = u.pn - 6, which = sec >> 1, head = 4 * (sec & 1) + wc;
            if (which < 2) {
                bf16_t* base = which == 0 ? Q : Kk;
                const float* g = which == 0 ? gq : gk;
                const float sc = which == 0 ? qscale : 1.f;
                const f32x4 g00 = *(const f32x4*)(g + 8 * fq), g01 = *(const f32x4*)(g + 8 * fq + 4), g10 = *(const f32x4*)(g + 32 + 8 * fq), g11 = *(const f32x4*)(g + 32 + 8 * fq + 4);
#pragma unroll
                for (int ai = 0; ai < 2; ++ai)
#pragma unroll
                    for (int m = 0; m < 4; ++m) {
                        const int row = u.pm * BM + ai * HALF + wr * 64 + m * 16 + fr, b = row >> 13, t = row & 8191;
                        float ss = 0.f;
#pragma unroll
                        for (int bj = 0; bj < 2; ++bj)
#pragma unroll
                            for (int n = 0; n < 2; ++n) { const f32x4 x = acc[ai][bj][m][n]; ss += (x[0] * x[0] + x[1] * x[1]) + (x[2] * x[2] + x[3] * x[3]); }
                        ss += __shfl_xor(ss, 16); ss += __shfl_xor(ss, 32);
                        const float rs = sc * __builtin_amdgcn_rsqf(ss * (1.0f / 64.0f) + eps);
                        bf16_t* dst = base + ((size_t)((b * 8 + head) * 8192 + t)) * 64 + 8 * fq;
                        *(u32x4*)(dst) = pack8(acc[ai][0][m][0] * rs * g00, acc[ai][0][m][1] * rs * g01);
                        *(u32x4*)(dst + 32) = pack8(acc[ai][1][m][0] * rs * g10, acc[ai][1][m][1] * rs * g11);
                    }
            } else {
#pragma unroll
                for (int ai = 0; ai < 2; ++ai)
#pragma unroll
                    for (int m = 0; m < 4; ++m) {
                        const int row = u.pm * BM + ai * HALF + wr * 64 + m * 16 + fr, b = row >> 13, t = row & 8191;
                        bf16_t* dst = V + ((size_t)((b * 8 + head) * 8192 + t)) * 64 + 8 * fq;
                        *(u32x4*)(dst) = pack8(acc[ai][0][m][0], acc[ai][0][m][1]);
                        *(u32x4*)(dst + 32) = pack8(acc[ai][1][m][0], acc[ai][1][m][1]);
                    }
            }
        }
    }
};
template <bool BASE_BF16> struct EpiResNorm {
    static constexpr bool PERM = true, AFTER_DRAIN = false;
    const void* base; bf16_t* XB; float* SS; int ldc; PG8_LAS float* red;
    __device__ __forceinline__ void operator()(const f32x4 (&acc)[2][2][4][2], const Unit& u, int wr, int wc, int fr, int fq) const {
        const int row0 = u.pm * BM + wr * 64 + fr, col0 = u.pn * BM + wc * 32 + 8 * fq;
        constexpr int NB = BASE_BF16 ? 1 : 2, GPB = 8 / NB;
#pragma unroll
        for (int bt = 0; bt < NB; ++bt) {
            u32x4 pb[GPB][2]; f32x4 pf[BASE_BF16 ? 1 : GPB][2][2];
#pragma unroll
            for (int gi = 0; gi < GPB; ++gi) { const int g8 = bt * GPB + gi, ai = g8 >> 2, m = g8 & 3; const size_t off = (size_t)(row0 + ai * HALF + m * 16) * ldc + col0;
#pragma unroll
                for (int bj = 0; bj < 2; ++bj) {
                    if constexpr (BASE_BF16) pb[gi][bj] = *(const u32x4*)((const bf16_t*)base + off + bj * HALF);
                    else { pf[gi][bj][0] = *(const f32x4*)((const float*)base + off + bj * HALF); pf[gi][bj][1] = *(const f32x4*)((const float*)base + off + bj * HALF + 4); } } }
#pragma unroll
            for (int gi = 0; gi < GPB; ++gi) { const int g8 = bt * GPB + gi, ai = g8 >> 2, m = g8 & 3; const int row = row0 + ai * HALF + m * 16; const size_t off = (size_t)row * ldc + col0; float ss = 0.f;
#pragma unroll
                for (int bj = 0; bj < 2; ++bj) {
                    f32x4 b0, b1;
                    if constexpr (BASE_BF16) { const u32x4 w = pb[gi][bj];
                        b0[0] = __builtin_bit_cast(float, w.x << 16); b0[1] = __builtin_bit_cast(float, w.x & 0xffff0000u); b0[2] = __builtin_bit_cast(float, w.y << 16); b0[3] = __builtin_bit_cast(float, w.y & 0xffff0000u);
                        b1[0] = __builtin_bit_cast(float, w.z << 16); b1[1] = __builtin_bit_cast(float, w.z & 0xffff0000u); b1[2] = __builtin_bit_cast(float, w.w << 16); b1[3] = __builtin_bit_cast(float, w.w & 0xffff0000u); }
                    else { b0 = pf[gi][bj][0]; b1 = pf[gi][bj][1]; }
                    const f32x4 x0 = b0 + acc[ai][bj][m][0], x1 = b1 + acc[ai][bj][m][1];
                    *(u32x4*)(XB + off + bj * HALF) = pack8(x0, x1);
                    ss += ((x0[0] * x0[0] + x0[1] * x0[1]) + (x0[2] * x0[2] + x0[3] * x0[3])) + ((x1[0] * x1[0] + x1[1] * x1[1]) + (x1[2] * x1[2] + x1[3] * x1[3]));
                }
                ss += __shfl_xor(ss, 16); ss += __shfl_xor(ss, 32);
                if (fq == 0) red[(ai * HALF + wr * 64 + m * 16 + fr) * 4 + wc] = ss; }
            asm volatile("" ::: "memory");
        }
        asm volatile("s_waitcnt lgkmcnt(0)" ::: "memory"); __builtin_amdgcn_s_barrier(); asm volatile("" ::: "memory");
        { const int t = threadIdx.x; if (t < 256) { const f32x4 v = *(const PG8_LAS f32x4*)(red + t * 4); SS[(size_t)(u.pm * BM + t) * 4 + u.pn] = (v[0] + v[1]) + (v[2] + v[3]); } }
        asm volatile("s_waitcnt lgkmcnt(0)" ::: "memory"); __builtin_amdgcn_s_barrier(); asm volatile("" ::: "memory");
    }
};
struct EpiPle {
    static constexpr bool PERM = true, AFTER_DRAIN = false;
    const bf16_t* xb; float* out; const bf16_t* pp; int ldc; const float* SS; float eps;
    __device__ __forceinline__ void operator()(const f32x4 (&acc)[2][2][4][2], const Unit& u, int wr, int wc, int fr, int fq) const {
        const int row0 = u.pm * BM + wr * 64 + fr, col0 = u.pn * BM + wc * 32 + 8 * fq;
        float rsv[8];
        {
            f32x4 sp[8];
#pragma unroll
            for (int g8 = 0; g8 < 8; ++g8) sp[g8] = *(const f32x4*)(SS + (size_t)(row0 + (g8 >> 2) * HALF + (g8 & 3) * 16) * 4);
#pragma unroll
            for (int g8 = 0; g8 < 8; ++g8) rsv[g8] = -1.4426950408889634f * rstd4(sp[g8], eps);
        }
        asm volatile("" ::: "memory");
#pragma unroll
        for (int bt = 0; bt < 4; ++bt) {
            u32x4 bw[2][2], pw[2][2];
#pragma unroll
            for (int gi = 0; gi < 2; ++gi) { const int g8 = bt * 2 + gi; const size_t off = (size_t)(row0 + (g8 >> 2) * HALF + (g8 & 3) * 16) * ldc + col0;
#pragma unroll
                for (int bj = 0; bj < 2; ++bj) { bw[gi][bj] = *(const u32x4*)(xb + off + bj * HALF); pw[gi][bj] = *(const u32x4*)(pp + off + bj * HALF); } }
#pragma unroll
            for (int gi = 0; gi < 2; ++gi) { const int g8 = bt * 2 + gi, ai = g8 >> 2, m = g8 & 3; const size_t off = (size_t)(row0 + ai * HALF + m * 16) * ldc + col0; const float rs = rsv[g8];
#pragma unroll
                for (int bj = 0; bj < 2; ++bj) { const size_t o2 = off + bj * HALF;
                    const unsigned bws[4] = {bw[gi][bj].x, bw[gi][bj].y, bw[gi][bj].z, bw[gi][bj].w}, pws[4] = {pw[gi][bj].x, pw[gi][bj].y, pw[gi][bj].z, pw[gi][bj].w};
                    f32x4 o[2];
#pragma unroll
                    for (int n = 0; n < 2; ++n)
#pragma unroll
                        for (int e = 0; e < 4; ++e) { const unsigned bb = bws[2 * n + (e >> 1)], pq = pws[2 * n + (e >> 1)];
                            const float bv = (e & 1) ? __builtin_bit_cast(float, bb & 0xffff0000u) : __builtin_bit_cast(float, bb << 16), pv = (e & 1) ? __builtin_bit_cast(float, pq & 0xffff0000u) : __builtin_bit_cast(float, pq << 16);
                            const float sg = __builtin_amdgcn_rcpf(1.0f + __builtin_amdgcn_exp2f(rs * acc[ai][bj][m][n][e])); o[n][e] = bv + sg * pv; }
                    *(f32x4*)(out + o2) = o[0]; *(f32x4*)(out + o2 + 4) = o[1]; } }
            asm volatile("" ::: "memory");
        }
    }
};

template <class Epi, class Sched, bool ALIGN_EPI = false, bool SP2 = false>
__device__ __forceinline__ void gemm_phase(PG8_LAS unsigned char* lds, const Gemm g, const Sched& S, const Epi& E) {
    int tid_ = threadIdx.x; asm volatile("" : "+v"(tid_));
    const int tid = tid_, wid = __builtin_amdgcn_readfirstlane(tid >> 6), lane = tid & 63, wr = wid >> 2, wc = wid & 3, fr = lane & 15, fq = lane >> 4;
    const int K = g.K, nt = K / BK;
    unsigned voffA[2], voffB[2];
#pragma unroll
    for (int i = 0; i < 2; ++i) { int R, C; stage_rc(tid * 16 + i * 8192, R, C); const int Rb = Epi::PERM ? ((R & ~31) + perm32(R & 31)) : R;
        voffA[i] = (unsigned)(R * K + C) * 2u; voffB[i] = (unsigned)(Rb * K + C) * 2u; }
    const size_t kstep = (size_t)(BK * 2);
    const size_t hstep = (size_t)HALF * K * 2;
    const size_t tstep = 2 * hstep;
    const unsigned ldsw = (unsigned)wid * 1024u;
    const int aoff = lds_byte(wr * 64 + fr, fq * 8), boff = lds_byte(wc * 32 + fr, fq * 8);
#define PG8_SA(b, h) (((b) * 2 + (h)) * HTB)
#define PG8_SB(b, h) ((4 + (b) * 2 + (h)) * HTB)
#define PG8_STAGE(bufoff, gbase, voff) do { _Pragma("unroll") for (int _i = 0; _i < 2; ++_i) \
        __builtin_amdgcn_global_load_lds((const unsigned*)((const char*)(gbase) + (voff)[_i]), (PG8_LAS unsigned*)(lds + (bufoff) + ldsw + _i * 8192), 16, 0, 0); } while (0)
#define PG8_LDA(dst, b, h) do { _Pragma("unroll") for (int m = 0; m < 4; ++m) _Pragma("unroll") for (int k = 0; k < 2; ++k) dst[m][k] = *(const PG8_LAS bf16x8*)(lds + PG8_SA(b, h) + aoff + m * 2048 + k * 1024); } while (0)
#define PG8_LDB(dst, b, h) do { _Pragma("unroll") for (int n = 0; n < 2; ++n) _Pragma("unroll") for (int k = 0; k < 2; ++k) dst[n][k] = *(const PG8_LAS bf16x8*)(lds + PG8_SB(b, h) + boff + n * 2048 + k * 1024); } while (0)
#ifndef PG8_KOUT
#define PG8_KOUT 0
#endif
#ifndef PG8_ORD
#define PG8_ORD 0
#endif
#ifndef PG8_BAL
#define PG8_BAL 1
#endif
#ifndef PG8_PRIO_LOAD
#define PG8_PRIO_LOAD 0
#endif
#ifndef PG8_PRIO
#define PG8_PRIO 1
#endif
#if PG8_KOUT
#define PG8_MMA(ai, bj, At, Bt) do { if (PG8_PRIO) __builtin_amdgcn_s_setprio(PG8_PRIO); _Pragma("unroll") for (int k = 0; k < 2; ++k) _Pragma("unroll") for (int m = 0; m < 4; ++m) _Pragma("unroll") for (int n = 0; n < 2; ++n) \
        acc[ai][bj][m][n] = __builtin_amdgcn_mfma_f32_16x16x32_bf16(Bt[n][k], At[m][k], acc[ai][bj][m][n], 0, 0, 0); if (PG8_PRIO) __builtin_amdgcn_s_setprio(PG8_PRIO_LOAD); } while (0)
#else
#define PG8_MMA(ai, bj, At, Bt) do { if (PG8_PRIO) __builtin_amdgcn_s_setprio(PG8_PRIO); _Pragma("unroll") for (int m = 0; m < 4; ++m) _Pragma("unroll") for (int n = 0; n < 2; ++n) _Pragma("unroll") for (int k = 0; k < 2; ++k) \
        acc[ai][bj][m][n] = __builtin_amdgcn_mfma_f32_16x16x32_bf16(Bt[n][k], At[m][k], acc[ai][bj][m][n], 0, 0, 0); if (PG8_PRIO) __builtin_amdgcn_s_setprio(PG8_PRIO_LOAD); } while (0)
#endif
#define PG8_WAIT_V(n) asm volatile("s_waitcnt vmcnt(" #n ")" ::: "memory")
#define PG8_WAIT_L(n) asm volatile("s_waitcnt lgkmcnt(" #n ")" ::: "memory")
#define PG8_BAR __builtin_amdgcn_s_barrier()
#define PG8_SCHED __builtin_amdgcn_sched_barrier(0)
    Unit cur, nxt; int ui = 0;
    if (!S.next(0, cur)) return;
    f32x4 acc[2][2][4][2];
#pragma unroll
    for (int a = 0; a < 2; ++a)
#pragma unroll
        for (int b = 0; b < 2; ++b)
#pragma unroll
            for (int m = 0; m < 4; ++m)
#pragma unroll
                for (int n = 0; n < 2; ++n) acc[a][b][m][n] = (f32x4){0.f, 0.f, 0.f, 0.f};
    bf16x8 At[4][2], B0[2][2], B1[2][2];
    const char* cA = (const char*)g.A + (size_t)cur.pm * tstep; const char* cB = (const char*)g.Bt + (size_t)cur.pn * tstep;
    S.a_ready(cur);
    if constexpr (SP2) {
        PG8_STAGE(PG8_SB(0, 0), cB, voffB); PG8_STAGE(PG8_SB(0, 1), cB + hstep, voffB); PG8_STAGE(PG8_SA(0, 0), cA, voffA); PG8_STAGE(PG8_SA(0, 1), cA + hstep, voffA);
        if (wr == 1) PG8_BAR;
        PG8_WAIT_V(2); PG8_BAR;
#if PG8_BAL
        PG8_STAGE(PG8_SB(1, 0), cB + kstep, voffB); PG8_STAGE(PG8_SB(1, 1), cB + hstep + kstep, voffB);
        PG8_WAIT_V(4); PG8_BAR;
#else
        PG8_STAGE(PG8_SB(1, 0), cB + kstep, voffB); PG8_STAGE(PG8_SA(1, 0), cA + kstep, voffA); PG8_STAGE(PG8_SB(1, 1), cB + hstep + kstep, voffB);
        PG8_WAIT_V(6); PG8_BAR;
#endif
    } else {
        PG8_STAGE(PG8_SB(0, 0), cB, voffB); PG8_STAGE(PG8_SA(0, 0), cA, voffA); PG8_STAGE(PG8_SB(0, 1), cB + hstep, voffB); PG8_STAGE(PG8_SA(0, 1), cA + hstep, voffA);
        if (wr == 1) PG8_BAR;
        PG8_WAIT_V(4); PG8_BAR;
        PG8_STAGE(PG8_SB(1, 0), cB + kstep, voffB); PG8_STAGE(PG8_SA(1, 0), cA + kstep, voffA); PG8_STAGE(PG8_SB(1, 1), cB + hstep + kstep, voffB);
        PG8_WAIT_V(6); PG8_BAR;
    }
    for (;;) {
        const bool has_next = S.next(ui + 1, nxt);
        const char* nA = has_next ? (const char*)g.A + (size_t)nxt.pm * tstep : cA; const char* nB = has_next ? (const char*)g.Bt + (size_t)nxt.pn * tstep : cB;
        for (int t = 0; t < nt; t += 2) {
            const bool last = (t == nt - 2);
            const char* a1 = cA + (size_t)(t + 1) * kstep;
            const char* a2 = last ? nA : cA + (size_t)(t + 2) * kstep; const char* b2 = last ? nB : cB + (size_t)(t + 2) * kstep;
            const char* a3 = a2 + kstep; const char* b3 = b2 + kstep;
            if (last && has_next) S.a_ready(nxt);
            if constexpr (SP2) {
#if PG8_BAL
#if PG8_ORD == 1
            PG8_STAGE(PG8_SA(1, 0), a1, voffA); PG8_STAGE(PG8_SA(1, 1), a1 + hstep, voffA); PG8_SCHED; PG8_LDB(B0, 0, 0); PG8_LDB(B1, 0, 1); PG8_SCHED; PG8_LDA(At, 0, 0);
            PG8_WAIT_V(8); PG8_WAIT_L(0); PG8_BAR; PG8_MMA(0, 0, At, B0); PG8_MMA(0, 1, At, B1); PG8_BAR; PG8_SCHED;
            PG8_STAGE(PG8_SB(0, 0), b2, voffB); PG8_STAGE(PG8_SB(0, 1), b2 + hstep, voffB); PG8_SCHED; PG8_LDA(At, 0, 1);
            PG8_WAIT_V(6); PG8_WAIT_L(0); PG8_BAR; PG8_MMA(1, 0, At, B0); PG8_MMA(1, 1, At, B1); PG8_BAR; PG8_SCHED;
            PG8_STAGE(PG8_SA(0, 0), a2, voffA); PG8_STAGE(PG8_SA(0, 1), a2 + hstep, voffA); PG8_SCHED; PG8_LDB(B0, 1, 0); PG8_LDB(B1, 1, 1); PG8_SCHED; PG8_LDA(At, 1, 0);
            PG8_WAIT_V(8); PG8_WAIT_L(0); PG8_BAR; PG8_MMA(0, 0, At, B0); PG8_MMA(0, 1, At, B1); PG8_BAR; PG8_SCHED;
            PG8_STAGE(PG8_SB(1, 0), b3, voffB); PG8_STAGE(PG8_SB(1, 1), b3 + hstep, voffB); PG8_SCHED; PG8_LDA(At, 1, 1);
            PG8_WAIT_V(6); PG8_WAIT_L(0); PG8_BAR; PG8_MMA(1, 0, At, B0); PG8_MMA(1, 1, At, B1); PG8_BAR; PG8_SCHED;
#elif PG8_ORD == 2
            PG8_LDB(B0, 0, 0); PG8_SCHED; PG8_STAGE(PG8_SA(1, 0), a1, voffA); PG8_SCHED; PG8_LDB(B1, 0, 1); PG8_SCHED; PG8_STAGE(PG8_SA(1, 1), a1 + hstep, voffA); PG8_SCHED; PG8_LDA(At, 0, 0);
            PG8_WAIT_V(8); PG8_WAIT_L(0); PG8_BAR; PG8_MMA(0, 0, At, B0); PG8_MMA(0, 1, At, B1); PG8_BAR; PG8_SCHED;
            PG8_STAGE(PG8_SB(0, 0), b2, voffB); PG8_SCHED; PG8_LDA(At, 0, 1); PG8_SCHED; PG8_STAGE(PG8_SB(0, 1), b2 + hstep, voffB);
            PG8_WAIT_V(6); PG8_WAIT_L(0); PG8_BAR; PG8_MMA(1, 0, At, B0); PG8_MMA(1, 1, At, B1); PG8_BAR; PG8_SCHED;
            PG8_LDB(B0, 1, 0); PG8_SCHED; PG8_STAGE(PG8_SA(0, 0), a2, voffA); PG8_SCHED; PG8_LDB(B1, 1, 1); PG8_SCHED; PG8_STAGE(PG8_SA(0, 1), a2 + hstep, voffA); PG8_SCHED; PG8_LDA(At, 1, 0);
            PG8_WAIT_V(8); PG8_WAIT_L(0); PG8_BAR; PG8_MMA(0, 0, At, B0); PG8_MMA(0, 1, At, B1); PG8_BAR; PG8_SCHED;
            PG8_STAGE(PG8_SB(1, 0), b3, voffB); PG8_SCHED; PG8_LDA(At, 1, 1); PG8_SCHED; PG8_STAGE(PG8_SB(1, 1), b3 + hstep, voffB);
            PG8_WAIT_V(6); PG8_WAIT_L(0); PG8_BAR; PG8_MMA(1, 0, At, B0); PG8_MMA(1, 1, At, B1); PG8_BAR; PG8_SCHED;
#else
            PG8_LDB(B0, 0, 0); PG8_LDB(B1, 0, 1); PG8_SCHED; PG8_LDA(At, 0, 0); PG8_STAGE(PG8_SA(1, 0), a1, voffA); PG8_STAGE(PG8_SA(1, 1), a1 + hstep, voffA);
            PG8_WAIT_V(8); PG8_WAIT_L(0); PG8_BAR; PG8_MMA(0, 0, At, B0); PG8_MMA(0, 1, At, B1); PG8_BAR; PG8_SCHED;
            PG8_LDA(At, 0, 1); PG8_STAGE(PG8_SB(0, 0), b2, voffB); PG8_STAGE(PG8_SB(0, 1), b2 + hstep, voffB);
            PG8_WAIT_V(6); PG8_WAIT_L(0); PG8_BAR; PG8_MMA(1, 0, At, B0); PG8_MMA(1, 1, At, B1); PG8_BAR; PG8_SCHED;
            PG8_LDB(B0, 1, 0); PG8_LDB(B1, 1, 1); PG8_SCHED; PG8_LDA(At, 1, 0); PG8_STAGE(PG8_SA(0, 0), a2, voffA); PG8_STAGE(PG8_SA(0, 1), a2 + hstep, voffA);
            PG8_WAIT_V(8); PG8_WAIT_L(0); PG8_BAR; PG8_MMA(0, 0, At, B0); PG8_MMA(0, 1, At, B1); PG8_BAR; PG8_SCHED;
            PG8_LDA(At, 1, 1); PG8_STAGE(PG8_SB(1, 0), b3, voffB); PG8_STAGE(PG8_SB(1, 1), b3 + hstep, voffB);
            PG8_WAIT_V(6); PG8_WAIT_L(0); PG8_BAR; PG8_MMA(1, 0, At, B0); PG8_MMA(1, 1, At, B1); PG8_BAR; PG8_SCHED;
#endif
            (void)a3;
#else
            PG8_LDB(B0, 0, 0); PG8_LDB(B1, 0, 1); PG8_SCHED; PG8_LDA(At, 0, 0); PG8_STAGE(PG8_SA(1, 1), a1 + hstep, voffA);
            PG8_WAIT_V(8); PG8_WAIT_L(0); PG8_BAR; PG8_MMA(0, 0, At, B0); PG8_MMA(0, 1, At, B1); PG8_BAR; PG8_SCHED;
            PG8_LDA(At, 0, 1); PG8_STAGE(PG8_SB(0, 0), b2, voffB); PG8_STAGE(PG8_SB(0, 1), b2 + hstep, voffB); PG8_STAGE(PG8_SA(0, 0), a2, voffA);
            PG8_WAIT_V(8); PG8_WAIT_L(0); PG8_BAR; PG8_MMA(1, 0, At, B0); PG8_MMA(1, 1, At, B1); PG8_BAR; PG8_SCHED;
            PG8_LDB(B0, 1, 0); PG8_LDB(B1, 1, 1); PG8_SCHED; PG8_LDA(At, 1, 0); PG8_STAGE(PG8_SA(0, 1), a2 + hstep, voffA);
            PG8_WAIT_V(8); PG8_WAIT_L(0); PG8_BAR; PG8_MMA(0, 0, At, B0); PG8_MMA(0, 1, At, B1); PG8_BAR; PG8_SCHED;
            PG8_LDA(At, 1, 1); PG8_STAGE(PG8_SB(1, 0), b3, voffB); PG8_STAGE(PG8_SB(1, 1), b3 + hstep, voffB); PG8_STAGE(PG8_SA(1, 0), a3, voffA);
            PG8_WAIT_V(8); PG8_WAIT_L(0); PG8_BAR; PG8_MMA(1, 0, At, B0); PG8_MMA(1, 1, At, B1); PG8_BAR; PG8_SCHED;
#endif
            } else {
            PG8_LDB(B0, 0, 0); PG8_SCHED; PG8_LDA(At, 0, 0); PG8_STAGE(PG8_SA(1, 1), a1 + hstep, voffA);
            PG8_WAIT_L(8); PG8_BAR; PG8_WAIT_L(0); PG8_MMA(0, 0, At, B0); PG8_BAR; PG8_SCHED;
            PG8_LDB(B1, 0, 1); PG8_STAGE(PG8_SB(0, 0), b2, voffB);
            PG8_BAR; PG8_WAIT_L(0); PG8_MMA(0, 1, At, B1); PG8_BAR;
            PG8_LDA(At, 0, 1); PG8_STAGE(PG8_SA(0, 0), a2, voffA);
            PG8_BAR; PG8_WAIT_L(0); PG8_MMA(1, 0, At, B0); PG8_BAR; PG8_SCHED;
            PG8_STAGE(PG8_SB(0, 1), b2 + hstep, voffB);
            PG8_WAIT_V(6); PG8_BAR; PG8_MMA(1, 1, At, B1); PG8_BAR;
            PG8_LDB(B0, 1, 0); PG8_SCHED; PG8_LDA(At, 1, 0); PG8_STAGE(PG8_SA(0, 1), a2 + hstep, voffA);
            PG8_WAIT_L(8); PG8_BAR; PG8_WAIT_L(0); PG8_MMA(0, 0, At, B0); PG8_BAR; PG8_SCHED;
            PG8_LDB(B1, 1, 1); PG8_STAGE(PG8_SB(1, 0), b3, voffB);
            PG8_BAR; PG8_WAIT_L(0); PG8_MMA(0, 1, At, B1); PG8_BAR;
            PG8_LDA(At, 1, 1); PG8_STAGE(PG8_SA(1, 0), a3, voffA);
            PG8_BAR; PG8_WAIT_L(0); PG8_MMA(1, 0, At, B0); PG8_BAR; PG8_SCHED;
            PG8_STAGE(PG8_SB(1, 1), b3 + hstep, voffB);
            PG8_WAIT_V(6); PG8_BAR; PG8_MMA(1, 1, At, B1); PG8_BAR;
            }
        }
        if constexpr (ALIGN_EPI) { if (wr == 0) PG8_BAR; }
#ifdef PROBE_EPI
        unsigned long long te0_ = 0; if (g.tacc) te0_ = __builtin_amdgcn_s_memrealtime();
#endif
        if constexpr (!Epi::AFTER_DRAIN) { E(acc, cur, wr, wc, fr, fq); S.done(cur); }
#ifdef PROBE_EPI
        if (g.tacc && blockIdx.x == 0 && tid == 0) { *g.tacc += (unsigned)(__builtin_amdgcn_s_memrealtime() - te0_); }
#endif
        if (!has_next) break;
#pragma unroll
        for (int a = 0; a < 2; ++a)
#pragma unroll
            for (int b = 0; b < 2; ++b)
#pragma unroll
                for (int m = 0; m < 4; ++m)
#pragma unroll
                    for (int n = 0; n < 2; ++n) acc[a][b][m][n] = (f32x4){0.f, 0.f, 0.f, 0.f};
        cur = nxt; cA = nA; cB = nB; ++ui;
        if constexpr (ALIGN_EPI) { if (wr == 1) PG8_BAR; }
    }
    PG8_WAIT_V(0);
    if constexpr (!ALIGN_EPI) { if (wr == 0) PG8_BAR; }
    PG8_BAR;
    if constexpr (Epi::AFTER_DRAIN) { E.fused(acc, cur, wr, wc, fr, fq, lds, wid, lane); S.done(cur); }
#undef PG8_SA
#undef PG8_SB
#undef PG8_STAGE
#undef PG8_LDA
#undef PG8_LDB
#undef PG8_MMA
#undef PG8_WAIT_V
#undef PG8_WAIT_L
#undef PG8_BAR
#undef PG8_SCHED
}
}
#define GAS __attribute__((address_space(1)))
#define LAS __attribute__((address_space(3)))
typedef unsigned short bf16;
typedef unsigned v4u __attribute__((ext_vector_type(4)));
typedef float f32x4 __attribute__((ext_vector_type(4)));
typedef short bf16x8 __attribute__((ext_vector_type(8)));
typedef GAS unsigned gu32;
typedef GAS unsigned long long gu64;
#define RLX_AGENT __ATOMIC_RELAXED, __HIP_MEMORY_SCOPE_AGENT
#define LDS_WAIT() asm volatile("s_waitcnt lgkmcnt(0)" ::: "memory")
#define VM_WAIT() asm volatile("s_waitcnt vmcnt(0)" ::: "memory")
__device__ __forceinline__ unsigned long long rt() { return __builtin_amdgcn_s_memrealtime(); }
__device__ __forceinline__ unsigned f2bf(float f) { unsigned u = __builtin_bit_cast(unsigned, f); return (u + 0x7fffu + ((u >> 16) & 1u)) >> 16; }
__device__ __forceinline__ unsigned pk2(float lo, float hi) { return f2bf(lo) | (f2bf(hi) << 16); }

#define XB_TMO      128
#define XB_XCNT(j)  (256  + 64 * (j))
#define XB_XSUB(j)  (1280 + 64 * (j))
#define XB_XGEN(j)  (2304 + 64 * (j))
#define XB_TOP      3328
#define XB_TOPGEN   3392
#define XCD_BAR_WORDS 3456
#define XB_SPIN_CAP (1u << 18)

__device__ __forceinline__ unsigned xb_ld(unsigned* p)              { return __hip_atomic_load(p, __ATOMIC_RELAXED, __HIP_MEMORY_SCOPE_AGENT); }
__device__ __forceinline__ unsigned xb_add(unsigned* p, unsigned v) { return __hip_atomic_fetch_add(p, v, __ATOMIC_RELAXED, __HIP_MEMORY_SCOPE_AGENT); }
__device__ __forceinline__ unsigned xb_xcc_id() { return (unsigned)__builtin_amdgcn_s_getreg((3 << 11) | 20) & 0xFu; }
#define XB_SPIN(cond, bar) do { unsigned _sp = 0; while (cond) { __builtin_amdgcn_s_sleep(1); \
    if ((++_sp & 255u) == 0u) { if (xb_ld(&(bar)[XB_TMO])) break; if (_sp > XB_SPIN_CAP) { atomicAdd(&(bar)[XB_TMO], 1u); break; } } } } while (0)

struct XcdBarrier {
    unsigned* bar; unsigned x;
    volatile LAS unsigned* st;
};

__device__ __forceinline__ XcdBarrier xcd_barrier_post(unsigned* bar, volatile LAS unsigned* st) {
    XcdBarrier b; b.bar = bar; b.x = xb_xcc_id(); b.st = st;
    if (threadIdx.x == 0) (void)xb_add(&bar[XB_XCNT(b.x)], 1u);
    return b;
}
__device__ __forceinline__ void xcd_barrier_complete(unsigned* bar, unsigned x, unsigned& nloc, unsigned& nx) {
    const unsigned G = gridDim.x * gridDim.y * gridDim.z;
    unsigned sum, cnt, mine, sp = 0u;
    for (;;) {
        sum = 0u; cnt = 0u; mine = 0u;
#pragma unroll
        for (unsigned j = 0; j < 16; ++j) { const unsigned c = xb_ld(&bar[XB_XCNT(j)]); sum += c; cnt += (c > 0u) ? 1u : 0u; mine = (j == x) ? c : mine; }
        if (sum == G) break;
        __builtin_amdgcn_s_sleep(1);
        if ((++sp & 255u) == 0u) { if (xb_ld(&bar[XB_TMO])) break; if (sp > XB_SPIN_CAP) { atomicAdd(&bar[XB_TMO], 1u); break; } }
    }
    nloc = mine > 0u ? mine : 1u; nx = cnt > 0u ? cnt : 1u;
}

__device__ __forceinline__ void xcd_barrier(const XcdBarrier& b) {
    asm volatile("s_waitcnt vmcnt(0)" ::: "memory");
    __syncthreads();
    if (threadIdx.x == 0) {
        unsigned* bar = b.bar;
        __builtin_amdgcn_s_waitcnt(0);
        unsigned nloc = b.st[0], nx = b.st[1];
        if (nloc == 0u) { xcd_barrier_complete(bar, b.x, nloc, nx); b.st[0] = nloc; b.st[1] = nx; }
        const unsigned old = xb_add(&bar[XB_XSUB(b.x)], 1u);
        const unsigned gen = old / nloc;
        if (old + 1u == (gen + 1u) * nloc) {
            __builtin_amdgcn_fence(__ATOMIC_RELEASE, "agent");
            asm volatile("s_waitcnt vmcnt(0)" ::: "memory");
            const unsigned og = xb_add(&bar[XB_TOP], 1u);
            const unsigned tg = og / nx;
            if (og + 1u == (tg + 1u) * nx) xb_add(&bar[XB_TOPGEN], 1u);
            else XB_SPIN(xb_ld(&bar[XB_TOPGEN]) == tg, bar);
            __builtin_amdgcn_fence(__ATOMIC_ACQUIRE, "agent");
            xb_add(&bar[XB_XGEN(b.x)], 1u);
            asm volatile("s_waitcnt vmcnt(0)" ::: "memory");
        } else {
            XB_SPIN(xb_ld(&bar[XB_XGEN(b.x)]) == gen, bar);
            __builtin_amdgcn_fence(__ATOMIC_ACQUIRE, "agent");
            asm volatile("s_waitcnt vmcnt(0)" ::: "memory");
        }
    }
    __syncthreads();
}

constexpr int NWAVES = 8;
constexpr int BATCH = 4, SEQ = 8192, DM = 1024, MROWS = BATCH * SEQ, CONVW = 512, NHEAD = 8, HD = 64, ATTW = 512, INCOLS = 3072, DFF = 2816, PLED = 256;
constexpr float EPS = 1e-6f;
constexpr float LOG2E = 1.4426950408889634f;
constexpr size_t MiB = 1u << 20;
constexpr size_t WS_CTL = 0, CTL_ZERO_BYTES = 32768;
constexpr size_t WS_WIN = 2 * MiB, WS_WOUT = 8 * MiB, WS_WGU = 10 * MiB, WS_WDN = 21 * MiB, WS_WPG = 27 * MiB, WS_WPP = 29 * MiB;
constexpr size_t WS_H = 32 * MiB;
constexpr size_t WS_PB = 96 * MiB;
constexpr size_t WS_ZC = 112 * MiB;
constexpr size_t WS_Q = 208 * MiB, WS_K = 240 * MiB, WS_V = 272 * MiB;
constexpr size_t WS_OP = 304 * MiB;
constexpr size_t WS_LP = 400 * MiB;
constexpr size_t WS_Y = 404 * MiB;
constexpr size_t WS_U = 112 * MiB;
constexpr size_t WS_TOPG = 288 * MiB, WS_BOTG = 291 * MiB, WS_TOPU = 294 * MiB;
constexpr size_t WS_PP = 300 * MiB;
constexpr size_t WS_SS = 30 * MiB;
constexpr size_t WS_X2 = 364 * MiB;
constexpr size_t WS_END = 468 * MiB;
constexpr int CW_BAR = 4096;
constexpr int CW_Q0 = 64;
constexpr int RING_BYTES = 131072, LDSCTL_OFF = RING_BYTES, MISC_OFF = LDSCTL_OFF + 320, XCH_OFF = RING_BYTES + 4096  , LDS_BYTES = 147456;

__device__ __forceinline__ float wave_sum(float v) {
#pragma unroll
    for (int o = 1; o < 64; o <<= 1) v += __shfl_xor(v, o);
    return v;
}
__device__ __forceinline__ float wave_max(float v) {
#pragma unroll
    for (int o = 1; o < 64; o <<= 1) v = fmaxf(v, __shfl_xor(v, o));
    return v;
}
__device__ __forceinline__ unsigned cvtpk(float lo, float hi) { unsigned r; asm volatile("v_cvt_pk_bf16_f32 %0, %1, %2" : "=v"(r) : "v"(lo), "v"(hi)); return r; }
__device__ __forceinline__ float bflo(unsigned w) { return __builtin_bit_cast(float, w << 16); }
__device__ __forceinline__ float bfhi(unsigned w) { return __builtin_bit_cast(float, w & 0xffff0000u); }
__device__ __forceinline__ void unpack8(const v4u w, float (&f)[8]) { f[0] = bflo(w.x); f[1] = bfhi(w.x); f[2] = bflo(w.y); f[3] = bfhi(w.y); f[4] = bflo(w.z); f[5] = bfhi(w.z); f[6] = bflo(w.w); f[7] = bfhi(w.w); }
__device__ __forceinline__ v4u pack8f(const float (&f)[8]) { v4u w; w.x = cvtpk(f[0], f[1]); w.y = cvtpk(f[2], f[3]); w.z = cvtpk(f[4], f[5]); w.w = cvtpk(f[6], f[7]); return w; }
__device__ __forceinline__ void load8f(const float* p, float (&f)[8]) { const f32x4 a = *(const f32x4*)p, b = *(const f32x4*)(p + 4); f[0] = a[0]; f[1] = a[1]; f[2] = a[2]; f[3] = a[3]; f[4] = b[0]; f[5] = b[1]; f[6] = b[2]; f[7] = b[3]; }

__device__ __forceinline__ void p0_transpose_item(const float* W, int K, int N, bf16* WT, int drow0, LAS float* scr, int k0, int n0, int lane, const float* gain = nullptr) {
    f32x4 w[8]; float gk[8];
#pragma unroll
    for (int i = 0; i < 8; ++i) { const int kk = 8 * i + (lane >> 3); w[i] = *(const GAS f32x4*)(W + (size_t)(k0 + kk) * N + n0 + 4 * (lane & 7)); gk[i] = gain ? gain[k0 + kk] : 1.0f; }
#pragma unroll
    for (int i = 0; i < 8; ++i) { const int kk = 8 * i + (lane >> 3); LAS float* d = scr + kk * 33 + 4 * (lane & 7); d[0] = w[i].x * gk[i]; d[1] = w[i].y * gk[i]; d[2] = w[i].z * gk[i]; d[3] = w[i].w * gk[i]; }
    LDS_WAIT(); asm volatile("" ::: "memory");
    const int c = lane & 7;
#pragma unroll
    for (int j = 0; j < 4; ++j) { const int n = (lane >> 3) + 8 * j; const LAS float* s = scr + (8 * c) * 33 + n;
        v4u o; o.x = cvtpk(s[0 * 33], s[1 * 33]); o.y = cvtpk(s[2 * 33], s[3 * 33]); o.z = cvtpk(s[4 * 33], s[5 * 33]); o.w = cvtpk(s[6 * 33], s[7 * 33]);
        *(GAS v4u*)(WT + (size_t)(drow0 + n) * K + k0 + 8 * c) = o; }
    LDS_WAIT(); asm volatile("" ::: "memory");
}
__device__ __forceinline__ int map_in_row(int n0) {
    if (n0 < 1536) return n0;
    const int w = n0 - 1536, sec = w >> 8, within = w & 255, hl = within >> 6, dim = within & 63;
    return 1536 + 256 * sec + 128 * (dim >> 5) + 32 * hl + (dim & 31);
}
__device__ __forceinline__ void rms_row(const float* srow, const float* g, bf16* drow, int lane) {
    const GAS f32x4* xr = (const GAS f32x4*)srow + lane;
    f32x4 v[4]; float s = 0.f;
#pragma unroll
    for (int j = 0; j < 4; ++j) { v[j] = xr[64 * j]; s += (v[j].x * v[j].x + v[j].y * v[j].y) + (v[j].z * v[j].z + v[j].w * v[j].w); }
    const float rstd = __builtin_amdgcn_rsqf(wave_sum(s) * (1.f / DM) + EPS);
    GAS unsigned long long* o8 = (GAS unsigned long long*)drow + lane;
#pragma unroll
    for (int j = 0; j < 4; ++j) { const f32x4 gg = ((const GAS f32x4*)g)[lane + 64 * j];
        o8[64 * j] = (unsigned long long)cvtpk(v[j].x * rstd * gg.x, v[j].y * rstd * gg.y) | ((unsigned long long)cvtpk(v[j].z * rstd * gg.z, v[j].w * rstd * gg.w) << 32); }
}
__device__ __forceinline__ int wave_pull(unsigned* ctr, int lane) {
    unsigned v = 0u;
    if (lane == 0) v = __hip_atomic_fetch_add(ctr, 1u, __ATOMIC_RELAXED, __HIP_MEMORY_SCOPE_AGENT);
    return (int)__builtin_amdgcn_readfirstlane((int)v);
}
#ifndef RMS_NR
#define RMS_NR 4
#endif
__device__ __forceinline__ void rms_rows(const float* src, const float* g, bf16* dst, int gw, int NGW, int lane, int mend = MROWS, unsigned* pool = nullptr) {
    f32x4 gg[4];
#pragma unroll
    for (int j = 0; j < 4; ++j) gg[j] = ((const GAS f32x4*)g)[lane + 64 * j];
    int m = gw * RMS_NR, pooled = 0;
    for (;;) {
        if (!pooled && m >= mend) { if (!pool) break; pooled = 1; }
        if (pooled) { const int k = wave_pull(pool, lane); m = mend + 16 * k; if (m >= MROWS) break; }
      for (int sub = 0; sub < (pooled ? 16 / RMS_NR : 1); ++sub, m += (pooled ? RMS_NR : 0)) {
        f32x4 v[RMS_NR][4]; float s[RMS_NR];
#pragma unroll
        for (int r = 0; r < RMS_NR; ++r)
#pragma unroll
            for (int j = 0; j < 4; ++j) v[r][j] = ((const GAS f32x4*)(src + (size_t)(m + r) * DM))[lane + 64 * j];
#pragma unroll
        for (int r = 0; r < RMS_NR; ++r) { s[r] = 0.f;
#pragma unroll
            for (int j = 0; j < 4; ++j) s[r] += (v[r][j].x * v[r][j].x + v[r][j].y * v[r][j].y) + (v[r][j].z * v[r][j].z + v[r][j].w * v[r][j].w); }
#pragma unroll
        for (int o = 1; o < 64; o <<= 1) {
#pragma unroll
            for (int r = 0; r < RMS_NR; ++r) s[r] += __shfl_xor(s[r], o); }
#pragma unroll
        for (int r = 0; r < RMS_NR; ++r) { const float rstd = __builtin_amdgcn_rsqf(s[r] * (1.f / DM) + EPS);
            GAS unsigned long long* o8 = (GAS unsigned long long*)(dst + (size_t)(m + r) * DM) + lane;
#pragma unroll
            for (int j = 0; j < 4; ++j) o8[64 * j] = (unsigned long long)cvtpk(v[r][j].x * rstd * gg[j].x, v[r][j].y * rstd * gg[j].y) | ((unsigned long long)cvtpk(v[r][j].z * rstd * gg[j].z, v[r][j].w * rstd * gg[j].w) << 32); }
      }
        if (!pooled) m += NGW * RMS_NR;
    }
}

namespace att {
typedef float f32x16 __attribute__((ext_vector_type(16)));
typedef short s16x4 __attribute__((ext_vector_type(4)));
typedef short v4i16_t __attribute__((ext_vector_type(4)));
__device__ __forceinline__ constexpr int cr(int r) { return (r & 3) + 8 * (r >> 2); }
__device__ __forceinline__ s16x4 vtr(LAS const unsigned char* p) { return __builtin_bit_cast(s16x4, __builtin_amdgcn_ds_read_tr16_b64_v4i16((LAS v4i16_t*)p)); }

constexpr int K_OFF = 0, V_OFF = 49152, O_OFF = 98304;
struct UnitP { int b, h, d, r, blk, branch; float cb; };
__device__ __forceinline__ UnitP unit_params(int u) {
    UnitP p; const int bh = u / 96, u96 = u % 96, within = u96 & 31; p.branch = u96 >> 5;
    p.d = 1 << (2 * p.branch); const int nblk = 32 >> (2 * p.branch); p.r = within / nblk; p.blk = within % nblk; p.b = bh >> 3; p.h = bh & 7;
    p.cb = __builtin_amdgcn_exp2f(-(float)(p.h + 1)) * (float)p.d * LOG2E; return p;
}
struct Stage { v4u k[6], v[6]; bf16x8 q[4]; };
__device__ __forceinline__ void stage_load(Stage& st, const bf16* Qg, const bf16* Kg, const bf16* Vg, const UnitP& p, int tid, int wave, int lane) {
    const size_t hb = (size_t)(p.b * NHEAD + p.h) * SEQ * HD; const bf16* Kh = Kg + hb; const bf16* Vh = Vg + hb; const bf16* Qh = Qg + hb;
    const int lbase = p.blk * 256 - 128;
#pragma unroll
    for (int it = 0; it < 6; ++it) { const int idx = tid + 512 * it, row = idx >> 3, c = idx & 7; int l = lbase + row; l = l < 0 ? 0 : l;
        const size_t off = (size_t)(p.r + p.d * l) * HD + 8 * c; st.k[it] = *(const GAS v4u*)(Kh + off); st.v[it] = *(const GAS v4u*)(Vh + off); }
    const int pq = p.r + p.d * (p.blk * 256 + 32 * wave + (lane & 31));
#pragma unroll
    for (int s = 0; s < 4; ++s) st.q[s] = *(const GAS bf16x8*)(Qh + (size_t)pq * HD + 16 * s + 8 * (lane >> 5));
}
__device__ __forceinline__ void stage_write(const Stage& st, LAS unsigned char* L, int tid) {
#pragma unroll
    for (int it = 0; it < 6; ++it) { const int idx = tid + 512 * it, row = idx >> 3, c = idx & 7;
        *(LAS v4u*)(L + K_OFF + row * 128 + ((c ^ (row & 7)) << 4)) = st.k[it];
        *(LAS v4u*)(L + V_OFF + ((row >> 4) * 2 + (c >> 2)) * 1024 + (row & 15) * 64 + (c & 3) * 16) = st.v[it]; }
}
__device__ __forceinline__ void compute_tile(LAS unsigned char* L, const bf16x8 (&qf)[4], const UnitP& p, bf16* OPb, float* LPb, float negM, int wave, int lane) {
    const int r32 = lane & 31, hi = lane >> 5;
    const int l0 = p.blk * 256 + 32 * wave, d = p.d, r = p.r; const float cb = p.cb;
    const int pq = r + d * (l0 + r32);
    const int kb0 = l0 >= 128 ? 0 : ((128 - l0) >> 5);
    f32x16 o0, o1;
#pragma unroll
    for (int i = 0; i < 16; ++i) { o0[i] = 0.f; o1[i] = 0.f; }
    float lsum = 0.f;
    const int i4 = r32 - 4 * hi;
    const int laneoff = ((lane >> 4) & 1) * 32 + (lane & 3) * 8 + (4 * hi + ((lane & 15) >> 2)) * 64;
    bf16x8 kf[4];
    LAS const unsigned char* kbase = L + K_OFF + (32 * wave + r32) * 128;
    const int ksw = r32 & 7;
#pragma unroll
    for (int kb = 0; kb < 5; ++kb) if (kb >= kb0) {
        if (kb == kb0) {
#pragma unroll
            for (int s = 0; s < 4; ++s) kf[s] = *(LAS const bf16x8*)(kbase + kb * 4096 + (((2 * s + hi) ^ ksw) << 4));
        }
        const float lt = negM - cb * (float)(128 + r32 - 32 * kb - 4 * hi);
        f32x16 sacc;
#pragma unroll
        for (int i = 0; i < 16; ++i) sacc[i] = __builtin_fmaf(cb, (float)cr(i), lt);
#if ATT_PRIO == 2
        __builtin_amdgcn_s_setprio(1);
#endif
#pragma unroll
        for (int s = 0; s < 4; ++s) sacc = __builtin_amdgcn_mfma_f32_32x32x16_bf16(kf[s], qf[s], sacc, 0, 0, 0);
#if ATT_PRIO == 2
        __builtin_amdgcn_s_setprio(0);
#endif
        if (kb < 4) {
#pragma unroll
            for (int s = 0; s < 4; ++s) kf[s] = *(LAS const bf16x8*)(kbase + (kb + 1) * 4096 + (((2 * s + hi) ^ ksw) << 4));
        }
        float pe[16];
#pragma unroll
        for (int i = 0; i < 16; ++i) pe[i] = __builtin_amdgcn_exp2f(sacc[i]);
        if (kb == 0) {
#pragma unroll
            for (int i = 0; i < 16; ++i) pe[i] = (cr(i) >= i4) ? pe[i] : 0.f;
        }
        if (kb == 4) {
#pragma unroll
            for (int i = 0; i < 16; ++i) pe[i] = (cr(i) <= i4) ? pe[i] : 0.f;
        }
        float ps = 0.f;
#pragma unroll
        for (int i = 0; i < 16; ++i) ps += pe[i];
        lsum += ps;
        v4u pw0, pw1;
        pw0.x = cvtpk(pe[0], pe[1]); pw0.y = cvtpk(pe[2], pe[3]); pw0.z = cvtpk(pe[4], pe[5]); pw0.w = cvtpk(pe[6], pe[7]);
        pw1.x = cvtpk(pe[8], pe[9]); pw1.y = cvtpk(pe[10], pe[11]); pw1.z = cvtpk(pe[12], pe[13]); pw1.w = cvtpk(pe[14], pe[15]);
        const bf16x8 pa0 = __builtin_bit_cast(bf16x8, pw0), pa1 = __builtin_bit_cast(bf16x8, pw1);
        LAS const unsigned char* vb = L + V_OFF + (wave + kb) * 4096 + laneoff;
#pragma unroll
        for (int d0 = 0; d0 < 2; ++d0) {
            const s16x4 a_lo = vtr(vb + d0 * 1024), a_hi = vtr(vb + d0 * 1024 + 512), b_lo = vtr(vb + 2048 + d0 * 1024), b_hi = vtr(vb + 2048 + d0 * 1024 + 512);
            const bf16x8 v0 = (bf16x8){a_lo[0], a_lo[1], a_lo[2], a_lo[3], a_hi[0], a_hi[1], a_hi[2], a_hi[3]};
            const bf16x8 v1 = (bf16x8){b_lo[0], b_lo[1], b_lo[2], b_lo[3], b_hi[0], b_hi[1], b_hi[2], b_hi[3]};
            if (d0 == 0) { o0 = __builtin_amdgcn_mfma_f32_32x32x16_bf16(pa0, v0, o0, 0, 0, 0); o0 = __builtin_amdgcn_mfma_f32_32x32x16_bf16(pa1, v1, o0, 0, 0, 0); }
            else         { o1 = __builtin_amdgcn_mfma_f32_32x32x16_bf16(pa0, v0, o1, 0, 0, 0); o1 = __builtin_amdgcn_mfma_f32_32x32x16_bf16(pa1, v1, o1, 0, 0, 0); }
        }
    }
    lsum += __shfl_xor(lsum, 32);
    if (hi == 0) LPb[(size_t)(p.b * SEQ + pq) * NHEAD + p.h] = lsum;
    LAS unsigned short* stg = (LAS unsigned short*)(L + O_OFF + wave * 4096);
#pragma unroll
    for (int i = 0; i < 16; ++i) { const int q = cr(i) + 4 * hi;
        stg[q * 64 + r32] = (unsigned short)(cvtpk(o0[i], o0[i]) & 0xffffu); stg[q * 64 + 32 + r32] = (unsigned short)(cvtpk(o1[i], o1[i]) & 0xffffu); }
    LDS_WAIT(); asm volatile("" ::: "memory");
#pragma unroll
    for (int it = 0; it < 4; ++it) { const int row = it * 8 + (lane >> 3), ch = lane & 7;
        const v4u v = *(LAS const v4u*)(stg + row * 64 + ch * 8);
        *(GAS v4u*)(OPb + (size_t)(p.b * SEQ + r + d * (l0 + row)) * ATTW + p.h * HD + ch * 8) = v; }
    LDS_WAIT(); asm volatile("" ::: "memory");
}
}

#ifndef DUP_MASK
#define DUP_MASK 0
#endif
#ifndef MIX_EARLY
#define MIX_EARLY 1
#endif
#ifndef PP_IN_P8
#define PP_IN_P8 1
#endif
#ifndef P0_STATIC_ROWS
#define P0_STATIC_ROWS MROWS
#endif
#ifndef ATT_PRIO
#define ATT_PRIO 1
#endif
#ifndef WGM_P1
#define WGM_P1 4
#endif
#ifndef WGM_P4
#define WGM_P4 4
#endif
#ifndef WGM_P6
#define WGM_P6 4
#endif
#ifndef WGM_P8
#define WGM_P8 4
#endif
#ifndef WGM_P10
#define WGM_P10 4
#endif
#ifndef PROBE_AMP
#define PROBE_AMP 4
#endif
#ifndef PROBE_BLK
#define PROBE_BLK 0
#endif
#ifdef PROBE_EPI
#define PROBE_EPI_SET(n) if ((n) == PROBE_EPI) g.tacc = (unsigned*)(ws_ + WS_CTL) + 8;
#else
#define PROBE_EPI_SET(n)
#endif
#ifndef PG8_SP2
#define PG8_SP2 true
#endif
struct Args { const float* in[20]; float* out; unsigned char* ws; };
enum { I_X = 0, I_P, I_GMIX, I_WIN, I_CONVW, I_CONVB, I_QG, I_KG, I_GOC, I_GOA, I_WOUT, I_GFFN, I_WGATE, I_WUP, I_FCW, I_FCB, I_WDOWN, I_GPLE, I_WPG, I_WPP };

#define PHASE_PTRS KARG_DECL unsigned char* const ws_ = ARG_WS(); float* const out = ARG_OUT(); (void)out; \
    bf16* const WIN = (bf16*)(ws_ + WS_WIN); bf16* const WOUT = (bf16*)(ws_ + WS_WOUT); bf16* const WGU = (bf16*)(ws_ + WS_WGU); bf16* const WDN = (bf16*)(ws_ + WS_WDN); bf16* const WPG = (bf16*)(ws_ + WS_WPG); bf16* const WPP = (bf16*)(ws_ + WS_WPP); \
    bf16* const HB = (bf16*)(ws_ + WS_H); bf16* const PB = (bf16*)(ws_ + WS_PB); bf16* const ZC = (bf16*)(ws_ + WS_ZC); bf16* const QB = (bf16*)(ws_ + WS_Q); bf16* const KB = (bf16*)(ws_ + WS_K); bf16* const VB = (bf16*)(ws_ + WS_V); \
    bf16* const OP = (bf16*)(ws_ + WS_OP); float* const LP = (float*)(ws_ + WS_LP); bf16* const YB = (bf16*)(ws_ + WS_Y); bf16* const UB = (bf16*)(ws_ + WS_U); float* const TOPG = (float*)(ws_ + WS_TOPG); float* const BOTG = (float*)(ws_ + WS_BOTG); float* const TOPU = (float*)(ws_ + WS_TOPU); (void)TOPG; (void)BOTG; (void)TOPU; bf16* const PP = (bf16*)(ws_ + WS_PP); float* const SSB = (float*)(ws_ + WS_SS); (void)SSB; bf16* const X2B = (bf16*)(ws_ + WS_X2); (void)X2B; \
    (void)WIN; (void)WOUT; (void)WGU; (void)WDN; (void)WPG; (void)WPP; (void)HB; (void)PB; (void)ZC; (void)QB; (void)KB; (void)VB; (void)OP; (void)LP; (void)YB; (void)UB; (void)PP;
#define CAS __attribute__((address_space(4)))
#define ARG_IN(i) (*(const float* const CAS*)(ka_ + 8 * (i)))
#define ARG_OUT() (*(float* const CAS*)(ka_ + 8 * 20))
#define ARG_WS() (*(unsigned char* const CAS*)(ka_ + 8 * 21))
#define KARG_DECL const CAS unsigned char* ka_ = (const CAS unsigned char*)__builtin_amdgcn_kernarg_segment_ptr(); asm volatile("" : "+s"(ka_));
__device__ __forceinline__ void phase_stagger(int g, int ng, unsigned ticks) {
    if (g > 0) { const unsigned long long t0 = __builtin_amdgcn_s_memrealtime(); const unsigned long long wait = (unsigned long long)ticks * (unsigned)g / (unsigned)ng;
        while (__builtin_amdgcn_s_memrealtime() - t0 < wait) __builtin_amdgcn_s_sleep(16); }
}
#ifndef STAG6
#define STAG6 1000
#endif
#ifndef STAG6_NG
#define STAG6_NG 2
#endif
__device__ __forceinline__ void phase0(LAS unsigned char* L, const int lane, const int wave, const int G, const int bx, const int vcu, const int gw, const int NGW) {
    { PHASE_PTRS
    {
        LAS float* scr = (LAS float*)(L + wave * 16384);
        constexpr int I_IN = 16 * 96, I_OUT = 16 * 32, I_GT = 16 * 88, I_DN = 44 * 32, I_PG = 16 * 32, I_PPJ = 4 * 32;
        constexpr int NITEMS = I_IN + I_OUT + 2 * I_GT + I_DN + I_PG + I_PPJ;
        for (int it = gw; it < NITEMS; it += NGW) {
            int r = it;
            if (r < I_IN) { const int kb = r / 96, n0 = 32 * (r % 96); p0_transpose_item(ARG_IN(I_WIN), DM, INCOLS, WIN, map_in_row(n0), scr, 64 * kb, n0, lane); continue; } r -= I_IN;
            if (r < I_OUT) { const int kb = r / 32, n0 = 32 * (r % 32); p0_transpose_item(ARG_IN(I_WOUT), DM, DM, WOUT, n0, scr, 64 * kb, n0, lane); continue; } r -= I_OUT;
            if (r < I_GT) { const int kb = r / 88, n0 = 32 * (r % 88); p0_transpose_item(ARG_IN(I_WGATE), DM, DFF, WGU, 256 * (n0 >> 7) + (n0 & 127), scr, 64 * kb, n0, lane, ARG_IN(I_GFFN)); continue; } r -= I_GT;
            if (r < I_GT) { const int kb = r / 88, n0 = 32 * (r % 88); p0_transpose_item(ARG_IN(I_WUP), DM, DFF, WGU, 256 * (n0 >> 7) + 128 + (n0 & 127), scr, 64 * kb, n0, lane, ARG_IN(I_GFFN)); continue; } r -= I_GT;
            if (r < I_DN) { const int kb = r / 32, n0 = 32 * (r % 32); p0_transpose_item(ARG_IN(I_WDOWN), DFF, DM, WDN, n0, scr, 64 * kb, n0, lane); continue; } r -= I_DN;
            if (r < I_PG) { const int kb = r / 32, n0 = 32 * (r % 32); p0_transpose_item(ARG_IN(I_WPG), DM, DM, WPG, n0, scr, 64 * kb, n0, lane, ARG_IN(I_GPLE)); continue; } r -= I_PG;
            { const int kb = r / 32, n0 = 32 * (r % 32); p0_transpose_item(ARG_IN(I_WPP), PLED, DM, WPP, n0, scr, 64 * kb, n0, lane); }
        }
        rms_rows(ARG_IN(I_X), ARG_IN(I_GMIX), HB, gw, NGW, lane, P0_STATIC_ROWS, (P0_STATIC_ROWS < MROWS) ? (unsigned*)(ws_ + WS_CTL) + CW_Q0 : nullptr);
        for (int m = gw * 8; m < MROWS; m += NGW * 8) {
            f32x4 v[8];
#pragma unroll
            for (int r = 0; r < 8; ++r) v[r] = ((const GAS f32x4*)(ARG_IN(I_P) + (size_t)(m + r) * PLED))[lane];
#pragma unroll
            for (int r = 0; r < 8; ++r) ((GAS unsigned long long*)(PB + (size_t)(m + r) * PLED))[lane] = (unsigned long long)cvtpk(v[r].x, v[r].y) | ((unsigned long long)cvtpk(v[r].z, v[r].w) << 32);
        }
    }
    }
}
__device__ __forceinline__ void phase1(LAS unsigned char* L, const int lane, const int wave, const int G, const int bx, const int vcu, const int gw, const int NGW) {
    { PHASE_PTRS
    {
        int kdim_ = DM; asm volatile("" : "+s"(kdim_)); pg8::Gemm g{HB, WIN, MROWS, INCOLS, kdim_}; PROBE_EPI_SET(1) pg8::StaticOrder S; S.init(MROWS, INCOLS, G, bx, WGM_P1);
        pg8::EpiInProj E{ZC, QB, KB, VB, ARG_IN(I_QG), ARG_IN(I_KG), 0.125f * LOG2E, EPS};
        pg8::gemm_phase<pg8::EpiInProj, pg8::StaticOrder, true, PG8_SP2>(L, g, S, E);
    }
    }
}
__device__ __forceinline__ void mixer_conv_part(const int lane, const int gw, const int NGW) {
    PHASE_PTRS
    const int c = 8 * lane;
    float cw0[8], cw1[8], cw2[8], cbv[8], gc[8];
    load8f(ARG_IN(I_CONVW) + c, cw0); load8f(ARG_IN(I_CONVW) + CONVW + c, cw1); load8f(ARG_IN(I_CONVW) + 2 * CONVW + c, cw2);
    load8f(ARG_IN(I_CONVB) + c, cbv); load8f(ARG_IN(I_GOC) + c, gc);
    for (int ch = gw; ch < MROWS / 16; ch += NGW) {
        const int m0 = ch * 16;
        float u1[8], u2[8];
        if ((m0 & (SEQ - 1)) == 0) {
#pragma unroll
            for (int j = 0; j < 8; ++j) { u1[j] = 0.f; u2[j] = 0.f; }
        } else {
            float a[8], bb[8];
            unpack8(*(const GAS v4u*)(ZC + (size_t)(m0 - 1) * 1536 + 512 + c), a); unpack8(*(const GAS v4u*)(ZC + (size_t)(m0 - 1) * 1536 + 1024 + c), bb);
#pragma unroll
            for (int j = 0; j < 8; ++j) u1[j] = a[j] * bb[j];
            unpack8(*(const GAS v4u*)(ZC + (size_t)(m0 - 2) * 1536 + 512 + c), a); unpack8(*(const GAS v4u*)(ZC + (size_t)(m0 - 2) * 1536 + 1024 + c), bb);
#pragma unroll
            for (int j = 0; j < 8; ++j) u2[j] = a[j] * bb[j];
        }
        for (int tt = 0; tt < 16; ++tt) {
            const size_t m = (size_t)(m0 + tt);
            float zb[8], zc[8], zx[8], y[8];
            unpack8(*(const GAS v4u*)(ZC + m * 1536 + c), zb); unpack8(*(const GAS v4u*)(ZC + m * 1536 + 512 + c), zc); unpack8(*(const GAS v4u*)(ZC + m * 1536 + 1024 + c), zx);
            float ss = 0.f;
#pragma unroll
            for (int j = 0; j < 8; ++j) { const float u0 = zc[j] * zx[j]; y[j] = zb[j] * (cw0[j] * u2[j] + cw1[j] * u1[j] + cw2[j] * u0 + cbv[j]); ss += y[j] * y[j]; u2[j] = u1[j]; u1[j] = u0; }
            const float rc = __builtin_amdgcn_rsqf(wave_sum(ss) * (1.f / CONVW) + EPS);
#pragma unroll
            for (int j = 0; j < 8; ++j) y[j] = y[j] * rc * gc[j];
            *(GAS v4u*)(YB + m * DM + c) = pack8f(y);
        }
    }
}
__device__ __forceinline__ void mixer_merge_part(const int lane, const int gw, const int NGW) {
    PHASE_PTRS
    const int c = 8 * lane;
    float ga[8];
    load8f(ARG_IN(I_GOA) + c, ga);
    for (int ch = gw; ch < MROWS / 16; ch += NGW) {
        const int m0 = ch * 16;
#pragma unroll 2
        for (int tt = 0; tt < 16; ++tt) {
            const size_t m = (size_t)(m0 + tt);
            float o1[8], o2[8], o3[8], y[8];
            unpack8(*(const GAS v4u*)(OP + m * ATTW + c), o1); unpack8(*(const GAS v4u*)(OP + ((size_t)MROWS + m) * ATTW + c), o2); unpack8(*(const GAS v4u*)(OP + ((size_t)2 * MROWS + m) * ATTW + c), o3);
            const float lt = LP[m * NHEAD + (lane >> 3)] + LP[((size_t)MROWS + m) * NHEAD + (lane >> 3)] + LP[((size_t)2 * MROWS + m) * NHEAD + (lane >> 3)];
            const float rl = 1.0f / lt; float sa = 0.f;
#pragma unroll
            for (int j = 0; j < 8; ++j) { y[j] = (o1[j] + o2[j] + o3[j]) * rl; sa += y[j] * y[j]; }
            const float ra = __builtin_amdgcn_rsqf(wave_sum(sa) * (1.f / ATTW) + EPS);
#pragma unroll
            for (int j = 0; j < 8; ++j) y[j] = y[j] * ra * ga[j];
            *(GAS v4u*)(YB + m * DM + CONVW + c) = pack8f(y);
        }
    }
}
__device__ __forceinline__ void phase2(LAS unsigned char* L, const int lane, const int wave, const int G, const int bx, const int vcu, const int gw, const int NGW) {
    { PHASE_PTRS
    {
#if MIX_EARLY
        mixer_conv_part(lane, gw, NGW);
#endif
        const float mq = wave_max(fabsf(ARG_IN(I_QG)[lane])), mk = wave_max(fabsf(ARG_IN(I_KG)[lane]));
        const float negM = -8.0f * mq * mk * LOG2E;
        const int nper = 3072 / G, tid = threadIdx.x;
#define ATT_UNIT(i) ((G == 256) ? ((4 * (vcu >> 5) + (i) / 3) * 96 + ((i) % 3) * 32 + (vcu & 31)) : (vcu * nper + (i)))
#if ATT_PRIO == 1
        if (wave >= 4) __builtin_amdgcn_s_setprio(1);
#endif
        att::Stage st; att::UnitP p = att::unit_params(ATT_UNIT(0));
        att::stage_load(st, QB, KB, VB, p, tid, wave, lane);
        for (int i = 0; i < nper; ++i) {
#if defined(PROBE_ATT) && PROBE_ATT == 2
            const unsigned long long tw0_ = __builtin_amdgcn_s_memrealtime();
#endif
            att::stage_write(st, L, tid);
            bf16x8 qf[4];
#pragma unroll
            for (int s = 0; s < 4; ++s) qf[s] = st.q[s];
            asm volatile("s_waitcnt lgkmcnt(0)" ::: "memory"); __builtin_amdgcn_s_barrier(); asm volatile("" ::: "memory");
#if defined(PROBE_ATT) && PROBE_ATT == 2
            if (bx == PROBE_BLK && tid == 0) __hip_atomic_fetch_add((unsigned*)(ws_ + WS_CTL) + 8, (unsigned)(__builtin_amdgcn_s_memrealtime() - tw0_), __ATOMIC_RELAXED, __HIP_MEMORY_SCOPE_AGENT);
#endif
            att::UnitP pn = p;
            if (i + 1 < nper) { pn = att::unit_params(ATT_UNIT(i + 1)); att::stage_load(st, QB, KB, VB, pn, tid, wave, lane); }
#if defined(PROBE_ATT) && PROBE_ATT == 1
            const unsigned long long ta0_ = __builtin_amdgcn_s_memrealtime();
#endif
            att::compute_tile(L, qf, p, OP + (size_t)p.branch * MROWS * ATTW, LP + (size_t)p.branch * MROWS * NHEAD, negM, wave, lane);
#if defined(PROBE_ATT) && PROBE_ATT == 1
            if (bx == PROBE_BLK && tid == 0) __hip_atomic_fetch_add((unsigned*)(ws_ + WS_CTL) + 8, (unsigned)(__builtin_amdgcn_s_memrealtime() - ta0_), __ATOMIC_RELAXED, __HIP_MEMORY_SCOPE_AGENT);
#endif
            asm volatile("s_waitcnt lgkmcnt(0)" ::: "memory"); __builtin_amdgcn_s_barrier(); asm volatile("" ::: "memory");
            p = pn;
        }
#if ATT_PRIO == 1
        __builtin_amdgcn_s_setprio(0);
#endif
    }
    }
}
__device__ __forceinline__ void phase3(LAS unsigned char* L, const int lane, const int wave, const int G, const int bx, const int vcu, const int gw, const int NGW) {
#if !MIX_EARLY
    mixer_conv_part(lane, gw, NGW);
#endif
    mixer_merge_part(lane, gw, NGW);
}
__device__ __forceinline__ void phase4(LAS unsigned char* L, const int lane, const int wave, const int G, const int bx, const int vcu, const int gw, const int NGW) {
    for (int s_ = 0; s_ < (PP_IN_P8 ? 1 : 2); ++s_) {
        if (s_ == 0) { PHASE_PTRS
            int kdim_ = DM; asm volatile("" : "+s"(kdim_)); pg8::Gemm g{YB, WOUT, MROWS, DM, kdim_}; PROBE_EPI_SET(4) pg8::StaticOrder S; S.init(MROWS, DM, G, bx, WGM_P4);
            pg8::EpiResNorm<false> E{ARG_IN(I_X), HB, SSB, DM, (LAS float*)(L + XCH_OFF)};
            pg8::gemm_phase<pg8::EpiResNorm<false>, pg8::StaticOrder, true, PG8_SP2>(L, g, S, E);
        } else { PHASE_PTRS
            int kdim_ = PLED; asm volatile("" : "+s"(kdim_)); pg8::Gemm g{PB, WPP, MROWS, DM, kdim_}; PROBE_EPI_SET(4) pg8::StaticOrder S; S.init(MROWS, DM, G, bx, WGM_P4);
            pg8::EpiBf16 E{PP, DM};
            pg8::gemm_phase<pg8::EpiBf16, pg8::StaticOrder, true, PG8_SP2>(L, g, S, E);
        }
    }
}
__device__ __forceinline__ void phase6(LAS unsigned char* L, const int lane, const int wave, const int G, const int bx, const int vcu, const int gw, const int NGW) {
    { PHASE_PTRS
    {
        int kdim_ = DM; asm volatile("" : "+s"(kdim_)); pg8::Gemm g{HB, WGU, MROWS, 2 * DFF, kdim_}; PROBE_EPI_SET(6) pg8::StaticOrder S; S.init(MROWS, 2 * DFF, G, bx, WGM_P6);
        pg8::EpiGUAct E{UB, DFF, SSB, EPS, ARG_IN(I_FCW), ARG_IN(I_FCB), TOPG, BOTG, TOPU, (LAS float*)(L + XCH_OFF)};
        pg8::gemm_phase<pg8::EpiGUAct, pg8::StaticOrder, true, PG8_SP2>(L, g, S, E);
    }
    }
}
__device__ __forceinline__ void ffn_fix_rows(const float* fcw, const float* fcb, const float* TOPG, const float* BOTG, const float* TOPU, bf16* UB, int pm, int c) {
    float w0[8], w1[8], w2[8], bv[8], g0[8], g1[8], gm1[8], gm2[8], u0[8], u1[8], a0[8], a1[8];
    load8f(fcw + c, w0); load8f(fcw + DFF + c, w1); load8f(fcw + 2 * DFF + c, w2); load8f(fcb + c, bv);
    load8f(TOPG + (size_t)(pm * 2) * DFF + c, g0); load8f(TOPG + (size_t)(pm * 2 + 1) * DFF + c, g1);
    load8f(BOTG + (size_t)(pm * 2 - 2) * DFF + c, gm2); load8f(BOTG + (size_t)(pm * 2 - 1) * DFF + c, gm1);
    load8f(TOPU + (size_t)(pm * 2) * DFF + c, u0); load8f(TOPU + (size_t)(pm * 2 + 1) * DFF + c, u1);
#pragma unroll
    for (int j = 0; j < 8; ++j) {
        const float p0 = w0[j] * gm2[j] + w1[j] * gm1[j] + w2[j] * g0[j] + bv[j], p1 = w0[j] * gm1[j] + w1[j] * g0[j] + w2[j] * g1[j] + bv[j];
        a0[j] = p0 * __builtin_amdgcn_rcpf(1.0f + __builtin_amdgcn_exp2f(-LOG2E * p0)) * u0[j];
        a1[j] = p1 * __builtin_amdgcn_rcpf(1.0f + __builtin_amdgcn_exp2f(-LOG2E * p1)) * u1[j];
    }
    *(GAS v4u*)(UB + (size_t)(pm * 256) * DFF + c) = pack8f(a0);
    *(GAS v4u*)(UB + (size_t)(pm * 256 + 1) * DFF + c) = pack8f(a1);
}
__device__ __forceinline__ void phase8(LAS unsigned char* L, const int lane, const int wave, const int G, const int bx, const int vcu, const int gw, const int NGW) {
    { PHASE_PTRS
    {
        int kdim_ = DFF; asm volatile("" : "+s"(kdim_)); pg8::Gemm g{UB, WDN, MROWS, DM, kdim_}; PROBE_EPI_SET(8) pg8::StaticOrder S; S.init(MROWS, DM, G, bx, WGM_P8);
        { const int tid = threadIdx.x; pg8::Unit fu; int prev = -1;
          for (int i = 0; S.next(i, fu); ++i) { if (fu.pm != prev && (fu.pm & 31) != 0 && 8 * tid < DFF) ffn_fix_rows(ARG_IN(I_FCW), ARG_IN(I_FCB), TOPG, BOTG, TOPU, UB, fu.pm, 8 * tid); prev = fu.pm; }
          asm volatile("s_waitcnt vmcnt(0)" ::: "memory"); __syncthreads(); }
        pg8::EpiResNorm<true> E{HB, X2B, SSB, DM, (LAS float*)(L + XCH_OFF)};
        pg8::gemm_phase<pg8::EpiResNorm<true>, pg8::StaticOrder, true, PG8_SP2>(L, g, S, E);
    }
    }
#if PP_IN_P8
    { PHASE_PTRS
        int kdim_ = PLED; asm volatile("" : "+s"(kdim_)); pg8::Gemm g{PB, WPP, MROWS, DM, kdim_}; pg8::StaticOrder S; S.init(MROWS, DM, G, bx, WGM_P8);
        pg8::EpiBf16 E{PP, DM};
        pg8::gemm_phase<pg8::EpiBf16, pg8::StaticOrder, true, PG8_SP2>(L, g, S, E);
    }
#endif
}
__device__ __forceinline__ void phase10(LAS unsigned char* L, const int lane, const int wave, const int G, const int bx, const int vcu, const int gw, const int NGW) {
    { PHASE_PTRS
    {
        int kdim_ = DM; asm volatile("" : "+s"(kdim_)); pg8::Gemm g{X2B, WPG, MROWS, DM, kdim_}; PROBE_EPI_SET(10) pg8::StaticOrder S; S.init(MROWS, DM, G, bx, WGM_P10);
        pg8::EpiPle E{X2B, out, PP, DM, SSB, EPS};
        pg8::gemm_phase<pg8::EpiPle, pg8::StaticOrder, true, PG8_SP2>(L, g, S, E);
    }
    }
}

#if defined(PROBE_CLK)
#define PROBE_T0(n) unsigned long long tp0_##n = 0; if ((n) == PROBE_CLK) tp0_##n = __builtin_amdgcn_s_memtime();
#define PROBE_T1(n) if ((n) == PROBE_CLK && bx == PROBE_BLK && tid == 0) { __hip_atomic_fetch_add((unsigned*)(ctl + 8), (unsigned)((__builtin_amdgcn_s_memtime() - tp0_##n) / 25), __ATOMIC_RELAXED, __HIP_MEMORY_SCOPE_AGENT); }
#elif defined(PROBE_PHASE)
#define PROBE_T0(n) unsigned long long tp0_##n = 0; if ((n) == PROBE_PHASE) tp0_##n = __builtin_amdgcn_s_memrealtime();
#define PROBE_T1(n) if ((n) == PROBE_PHASE && bx == PROBE_BLK && tid == 0) { __hip_atomic_fetch_add((unsigned*)(ctl + 8), (unsigned)(__builtin_amdgcn_s_memrealtime() - tp0_##n), __ATOMIC_RELAXED, __HIP_MEMORY_SCOPE_AGENT); }
#else
#define PROBE_T0(n)
#define PROBE_T1(n)
#endif
#ifdef PROBE_BAR
#define XBAR() do { const unsigned long long tb0_ = __builtin_amdgcn_s_memrealtime(); xcd_barrier(bar); ++nbar_; if ((PROBE_BAR == 99 || nbar_ == PROBE_BAR) && bx == PROBE_BLK && tid == 0) __hip_atomic_fetch_add((unsigned*)(ctl + 8), (unsigned)(__builtin_amdgcn_s_memrealtime() - tb0_), __ATOMIC_RELAXED, __HIP_MEMORY_SCOPE_AGENT); } while (0)
#else
#define XBAR() xcd_barrier(bar)
#endif
__global__ void __launch_bounds__(NWAVES * 64, 2) hybrid_fwd(Args args) {
    extern __shared__ __attribute__((aligned(16))) unsigned char lds[];
    LAS unsigned char* L = (LAS unsigned char*)lds;
    volatile LAS unsigned* MISC = (volatile LAS unsigned*)(L + MISC_OFF);
    const int tid = threadIdx.x, lane = tid & 63, wave = __builtin_amdgcn_readfirstlane(tid >> 6);
    const int G = gridDim.x; const int bx = blockIdx.x;
    const int vcu = (G % 8 == 0) ? (bx % 8) * (G / 8) + bx / 8 : bx;
    const int gw = vcu * NWAVES + wave, NGW = G * NWAVES;
    gu32* ctl; { KARG_DECL ctl = (gu32*)(ARG_WS() + WS_CTL); }
    for (int u = tid; u < (LDS_BYTES - LDSCTL_OFF) / 4; u += NWAVES * 64) ((LAS unsigned*)(L + LDSCTL_OFF))[u] = 0u;
    __syncthreads();
    XcdBarrier bar = xcd_barrier_post((unsigned*)(ctl + CW_BAR), MISC + 8);
#ifdef PROBE_TOTAL
    const unsigned long long tt0_ = __builtin_amdgcn_s_memrealtime();
#endif
#ifdef PROBE_BAR
    int nbar_ = 0;
#endif

#ifndef SKIP_P0
    PROBE_T0(0) phase0(L, lane, wave, G, bx, vcu, gw, NGW); PROBE_T1(0)
#endif
    XBAR();
#if (DUP_MASK >> 0) & 1
    phase0(L, lane, wave, G, bx, vcu, gw, NGW);
    XBAR();
#endif
#ifdef EXTRA_BARRIERS
    { int nb_ = EXTRA_BARRIERS; asm volatile("" : "+s"(nb_)); for (int eb_ = 0; eb_ < nb_; ++eb_) xcd_barrier(bar); }
#endif

#ifndef SKIP_P1
    PROBE_T0(1) phase1(L, lane, wave, G, bx, vcu, gw, NGW); PROBE_T1(1)
#endif
    XBAR();
#if (DUP_MASK >> 1) & 1
    phase1(L, lane, wave, G, bx, vcu, gw, NGW);
    XBAR();
#endif

#ifndef SKIP_P2
    PROBE_T0(2) phase2(L, lane, wave, G, bx, vcu, gw, NGW); PROBE_T1(2)
#endif
    XBAR();
#if (DUP_MASK >> 2) & 1
    phase2(L, lane, wave, G, bx, vcu, gw, NGW);
    XBAR();
#endif

#ifndef SKIP_P3
    PROBE_T0(3) phase3(L, lane, wave, G, bx, vcu, gw, NGW); PROBE_T1(3)
#endif
    XBAR();
#if (DUP_MASK >> 3) & 1
    phase3(L, lane, wave, G, bx, vcu, gw, NGW);
    XBAR();
#endif

#ifndef SKIP_P4
    PROBE_T0(4) phase4(L, lane, wave, G, bx, vcu, gw, NGW); PROBE_T1(4)
#endif
    XBAR();
#if (DUP_MASK >> 4) & 1
    phase4(L, lane, wave, G, bx, vcu, gw, NGW);
    XBAR();
#endif

#ifndef SKIP_P6
    PROBE_T0(6) phase6(L, lane, wave, G, bx, vcu, gw, NGW); PROBE_T1(6)
#endif
    XBAR();
#if (DUP_MASK >> 6) & 1
    phase6(L, lane, wave, G, bx, vcu, gw, NGW);
    XBAR();
#endif


#ifndef SKIP_P8
    PROBE_T0(8) phase8(L, lane, wave, G, bx, vcu, gw, NGW); PROBE_T1(8)
#endif
    XBAR();
#if (DUP_MASK >> 8) & 1
    phase8(L, lane, wave, G, bx, vcu, gw, NGW);
    XBAR();
#endif


#ifndef SKIP_P10
    PROBE_T0(10) phase10(L, lane, wave, G, bx, vcu, gw, NGW); PROBE_T1(10)
#endif
#if (DUP_MASK >> 10) & 1
    XBAR();
    phase10(L, lane, wave, G, bx, vcu, gw, NGW);
#endif
#ifdef PROBE_TOTAL
    if (bx == PROBE_BLK && tid == 0) __hip_atomic_fetch_add((unsigned*)(ctl + 8), (unsigned)(__builtin_amdgcn_s_memrealtime() - tt0_), __ATOMIC_RELAXED, __HIP_MEMORY_SCOPE_AGENT);
#endif
#if defined(PROBE_PHASE) || defined(PROBE_EPI) || defined(PROBE_BAR) || defined(PROBE_CLK) || defined(PROBE_ATT) || defined(PROBE_TOTAL)
    if (bx == PROBE_BLK && tid == 0) { const unsigned tk = __hip_atomic_load((unsigned*)(ctl + 8), __ATOMIC_RELAXED, __HIP_MEMORY_SCOPE_AGENT); const unsigned long long t0 = __builtin_amdgcn_s_memrealtime();
        while (__builtin_amdgcn_s_memrealtime() - t0 < (unsigned long long)tk * PROBE_AMP) __builtin_amdgcn_s_sleep(32); }
#endif
}

extern "C" void kernel_launch(void* const* d_in, const int* in_sizes, int n_in, void* d_out, int out_size, void* d_ws, size_t ws_size, hipStream_t stream) {
    static int grid = 0;
    if (grid == 0) {
        if (n_in != 20 || out_size != MROWS * DM || ws_size < WS_END) { fprintf(stderr, "kernel_launch: unexpected shapes (n_in %d, out %d, ws %zu); nothing launched\n", n_in, out_size, ws_size); grid = -1; return; }
        int dev = 0, cus = 0, per_cu = 0;
        if (hipGetDevice(&dev) != hipSuccess || hipDeviceGetAttribute(&cus, hipDeviceAttributeMultiprocessorCount, dev) != hipSuccess) { grid = -1; return; }
        if (hipFuncSetAttribute((const void*)hybrid_fwd, hipFuncAttributeMaxDynamicSharedMemorySize, LDS_BYTES) != hipSuccess) { fprintf(stderr, "kernel_launch: hipFuncSetAttribute failed\n"); grid = -1; return; }
        if (hipOccupancyMaxActiveBlocksPerMultiprocessor(&per_cu, (const void*)hybrid_fwd, NWAVES * 64, LDS_BYTES) != hipSuccess || per_cu < 1)
            fprintf(stderr, "kernel_launch: note: occupancy query reports %d workgroups per CU\n", per_cu);
        (void)hipGetLastError();
        grid = cus;
        if (grid != 256) fprintf(stderr, "kernel_launch: %d CUs (built for 256)\n", grid);
    }
    if (grid < 0) return;
    if (hipMemsetAsync((char*)d_ws + WS_CTL, 0, CTL_ZERO_BYTES, stream) != hipSuccess) { fprintf(stderr, "kernel_launch: hipMemsetAsync failed\n"); return; }
    Args a{};
    for (int i = 0; i < 20; ++i) a.in[i] = (const float*)d_in[i];
    a.out = (float*)d_out; a.ws = (unsigned char*)d_ws;
    hipLaunchKernelGGL(hybrid_fwd, dim3(grid), dim3(NWAVES * 64), LDS_BYTES, stream, a);
    const hipError_t le = hipPeekAtLastError();
    if (le != hipSuccess) fprintf(stderr, "kernel_launch: launch failed: %s\n", hipGetErrorName(le));
}
```

```cpp
#include <hip/hip_runtime.h>
#include <cstdio>
#include <cstdint>
__device__ __forceinline__ int hw_lane() { int l; asm volatile("v_mbcnt_lo_u32_b32 %0, -1, 0\n\tv_mbcnt_hi_u32_b32 %0, -1, %0" : "=v"(l)); return l; }
#ifndef REG_DIET
#define REG_DIET 1
#endif
template <int O> __device__ __forceinline__ float lane_xor(float v) {
    if constexpr (!REG_DIET) return __shfl_xor(v, O);
    else if constexpr (O < 32) return __builtin_bit_cast(float, __builtin_amdgcn_ds_swizzle(__builtin_bit_cast(int, v), (O << 10) | 0x1F));
    else { int l = hw_lane(); asm volatile("" : "+v"(l)); return __builtin_bit_cast(float, __builtin_amdgcn_ds_bpermute((l ^ 32) << 2, __builtin_bit_cast(int, v))); }
}
namespace pg8 {
#define PG8_LAS __attribute__((address_space(3)))
typedef unsigned short bf16_t;
typedef short bf16x8 __attribute__((ext_vector_type(8)));
typedef float f32x4 __attribute__((ext_vector_type(4)));
typedef unsigned u32x4 __attribute__((ext_vector_type(4)));
typedef int i32x4 __attribute__((ext_vector_type(4)));
typedef int i32x8 __attribute__((ext_vector_type(8)));
constexpr int BM = 256, BK = 64, HALF = 128, HTB = HALF * BK * 2  , STAGE_BYTES = 8 * HTB, NXCD = 8;
#ifndef PG8_WGM
#define PG8_WGM 4
#endif
constexpr int WGM = PG8_WGM;

__host__ __device__ __forceinline__ int lds_byte(int r, int c) { const int st = (r >> 4) * 2 + (c >> 5), rr = r & 15, cc = c & 31, ob = rr * 64 + cc * 2; return st * 1024 + (ob ^ (((ob >> 9) & 1) << 5)); }
__host__ __device__ __forceinline__ void stage_rc(int b, int& R, int& C) { const int st = b / 1024, sb = b % 1024, swz = sb ^ (((sb >> 9) & 1) << 5); R = (st >> 1) * 16 + swz / 64; C = (st & 1) * 32 + (swz % 64) / 2; }
__host__ __device__ __forceinline__ int perm32(int rho) { const int n = rho >> 4, i = rho & 15; return 8 * (i >> 2) + 4 * n + (i & 3); }

struct Unit { int pm, pn; };
struct Gemm { const bf16_t* A; const bf16_t* Bt; int M, N, K; unsigned* tacc = nullptr; };

struct StaticOrder {
    int nM, nN, nwg, G, c, wgm;
    __host__ __device__ void init(int M, int N, int G_, int c_, int wgm_ = WGM) { nM = M / BM; nN = N / BM; nwg = nM * nN; G = G_; c = c_; wgm = wgm_; }
    __host__ __device__ bool next(int i, Unit& u) const {
        const long L = (long)i * G + c; if (L >= nwg) return false;
        int wgid = (int)L; { const int q = nwg / NXCD, r = nwg % NXCD, xcd = wgid % NXCD, off = wgid / NXCD; wgid = (xcd < r ? xcd * (q + 1) : r * (q + 1) + (xcd - r) * q) + off; }
        const int nig = wgm * nN, gid = wgid / nig, fm = gid * wgm, gsz = (nM - fm) < wgm ? (nM - fm) : wgm;
        u.pm = fm + ((wgid % nig) % gsz); u.pn = (wgid % nig) / gsz; return true;
    }
    __device__ __forceinline__ void a_ready(const Unit&) const {}
    __device__ __forceinline__ void done(const Unit&) const {}
};
struct PanelOrder : StaticOrder {
    const unsigned* ready; unsigned need;
    __device__ __forceinline__ void a_ready(const Unit& u) const {
        if (threadIdx.x < 64) {
            const unsigned long long t0 = __builtin_amdgcn_s_memrealtime();
            while ((unsigned)__builtin_amdgcn_readfirstlane(__hip_atomic_load(ready + 16 * u.pm, __ATOMIC_RELAXED, __HIP_MEMORY_SCOPE_AGENT)) < need) {
                if (__builtin_amdgcn_s_memrealtime() - t0 > 2000000ull) break;
                __builtin_amdgcn_s_sleep(2); }
            __builtin_amdgcn_fence(__ATOMIC_ACQUIRE, "agent");
            asm volatile("s_waitcnt vmcnt(0)" ::: "memory");
        }
        asm volatile("" ::: "memory"); __builtin_amdgcn_s_barrier(); asm volatile("" ::: "memory");
    }
};


#ifndef EPI_GU_ST16
#define EPI_GU_ST16 1
#endif
#ifndef EPI_XB_NT
#define EPI_XB_NT 0
#endif
#ifndef EPI_X_NT
#define EPI_X_NT 1
#endif
#ifndef EPI_OUT_NT
#define EPI_OUT_NT 0
#endif
#ifndef EPI_PP_NT
#define EPI_PP_NT 0
#endif
typedef float cvb_f32x2 __attribute__((ext_vector_type(2)));
typedef __bf16 cvb_bf16x2 __attribute__((ext_vector_type(2)));
__device__ __forceinline__ unsigned cvt_pk_bf16(float lo, float hi) { const cvb_f32x2 v = {lo, hi}; return __builtin_bit_cast(unsigned, __builtin_convertvector(v, cvb_bf16x2)); }
__device__ __forceinline__ u32x4 pack8(const f32x4& v0, const f32x4& v1) { u32x4 w; w.x = cvt_pk_bf16(v0[0], v0[1]); w.y = cvt_pk_bf16(v0[2], v0[3]); w.z = cvt_pk_bf16(v1[0], v1[1]); w.w = cvt_pk_bf16(v1[2], v1[3]); return w; }
__device__ __forceinline__ float clamp_f8(float x) { return __builtin_amdgcn_fmed3f(x, -448.0f, 448.0f); }
__device__ __forceinline__ unsigned pack4_f8(float a, float b2, float c, float d) { int w = 0; w = __builtin_amdgcn_cvt_pk_fp8_f32(clamp_f8(a), clamp_f8(b2), w, false); w = __builtin_amdgcn_cvt_pk_fp8_f32(clamp_f8(c), clamp_f8(d), w, true); return (unsigned)w; }
__device__ __forceinline__ unsigned long long pack8_f8(const f32x4& v0, const f32x4& v1) { return (unsigned long long)pack4_f8(v0[0], v0[1], v0[2], v0[3]) | ((unsigned long long)pack4_f8(v1[0], v1[1], v1[2], v1[3]) << 32); }
__device__ __forceinline__ float bf2f(unsigned short h) { return __builtin_bit_cast(float, (unsigned)h << 16); }

#ifndef EPI_SC1
#define EPI_SC1 0
#endif
__device__ __forceinline__ void st16(void* p, const u32x4& v) {
#if EPI_SC1
    asm volatile("global_store_dwordx4 %0, %1, off sc1\n\ts_nop 1" :: "v"(p), "v"(v) : "memory");
#else
    *(u32x4*)p = v;
#endif
}
struct EpiNull {
    static constexpr bool PERM = true, AFTER_DRAIN = false;
    __device__ __forceinline__ void operator()(const f32x4 (&acc)[2][2][4][2], const Unit&, int, int, int, int) const {
#pragma unroll
        for (int a = 0; a < 2; ++a)
#pragma unroll
            for (int b = 0; b < 2; ++b)
#pragma unroll
                for (int m = 0; m < 4; ++m)
#pragma unroll
                    for (int n = 0; n < 2; ++n) asm volatile("" :: "v"(acc[a][b][m][n]));
    }
};
struct SameUnitOrder : StaticOrder {
    __device__ bool next(int i, Unit& u) const { Unit t; const bool ok = StaticOrder::next(i, t); u.pm = 0; u.pn = 0; return ok; }
};
struct EpiBf16 {
    static constexpr bool PERM = true, AFTER_DRAIN = false;
    bf16_t* O; int ldc;
    __device__ __forceinline__ void operator()(const f32x4 (&acc)[2][2][4][2], const Unit& u, int wr, int wc, int fr, int fq) const {
        const int row0 = u.pm * BM + wr * 64 + fr, col0 = u.pn * BM + wc * 32 + 8 * fq;
#pragma unroll
        for (int ai = 0; ai < 2; ++ai)
#pragma unroll
            for (int m = 0; m < 4; ++m) { bf16_t* rowp = O + (size_t)(row0 + ai * HALF + m * 16) * ldc + col0;
#pragma unroll
                for (int bj = 0; bj < 2; ++bj) *(u32x4*)(rowp + bj * HALF) = pack8(acc[ai][bj][m][0], acc[ai][bj][m][1]); }
    }
};
__device__ __forceinline__ float rstd4(const f32x4 a, float eps) { return __builtin_amdgcn_rsqf(((a[0] + a[1]) + (a[2] + a[3])) * (1.0f / 1024.0f) + eps); }
struct EpiGU {
    static constexpr bool PERM = true, AFTER_DRAIN = false;
    bf16_t* G; bf16_t* U; int ldc; const float* SS; float eps;
    __device__ __forceinline__ void operator()(const f32x4 (&acc)[2][2][4][2], const Unit& u, int wr, int wc, int fr, int fq) const {
        const int row0 = u.pm * BM + wr * 64 + fr, col0 = u.pn * HALF + wc * 32 + 8 * fq;
        f32x4 sp[2][4];
#pragma unroll
        for (int ai = 0; ai < 2; ++ai)
#pragma unroll
            for (int m = 0; m < 4; ++m) sp[ai][m] = *(const f32x4*)(SS + (size_t)(row0 + ai * HALF + m * 16) * 4);
#pragma unroll
        for (int ai = 0; ai < 2; ++ai)
#pragma unroll
            for (int m = 0; m < 4; ++m) { const int row = row0 + ai * HALF + m * 16; const float rs = rstd4(sp[ai][m], eps); const size_t off = (size_t)row * ldc + col0;
                *(u32x4*)(G + off) = pack8(acc[ai][0][m][0] * rs, acc[ai][0][m][1] * rs);
                *(u32x4*)(U + off) = pack8(acc[ai][1][m][0] * rs, acc[ai][1][m][1] * rs); }
    }
};
__device__ __forceinline__ float dpp_ror1(float v) { return __builtin_bit_cast(float, __builtin_amdgcn_mov_dpp(__builtin_bit_cast(int, v), 0x121, 0xf, 0xf, false)); }
__device__ __forceinline__ float dpp_ror2(float v) { return __builtin_bit_cast(float, __builtin_amdgcn_mov_dpp(__builtin_bit_cast(int, v), 0x122, 0xf, 0xf, false)); }
struct EpiGUAct {
    static constexpr bool PERM = true, AFTER_DRAIN = false;
    bf16_t* ACT; int ldc; const float* SS; float eps; const float* cw; const float* cbias; float* TOPG; float* BOTG; float* TOPU; PG8_LAS float* xch;
#ifdef PROBE_SS
    unsigned* tacc = nullptr;
#endif
    __device__ __forceinline__ void operator()(const f32x4 (&acc_)[2][2][4][2], const Unit& u, int wr, int wc, int fr, int fq) const {
        f32x4 (&acc)[2][2][4][2] = const_cast<f32x4 (&)[2][2][4][2]>(acc_);
        const int row0 = u.pm * BM + wr * 64 + fr, colh = wc * 32 + 8 * fq, col0 = u.pn * HALF + colh;
        {
            f32x4 sp[2][4];
#ifdef PROBE_SS
            const unsigned long long tq0_ = __builtin_amdgcn_s_memrealtime();
#endif
#pragma unroll
            for (int ai = 0; ai < 2; ++ai)
#pragma unroll
                for (int m = 0; m < 4; ++m) sp[ai][m] = *(const f32x4*)(SS + (size_t)(row0 + ai * HALF + m * 16) * 4);
#ifdef PROBE_SS
            asm volatile("s_waitcnt vmcnt(0)" ::: "memory");
            if (tacc && blockIdx.x == 0 && wr == 0 && wc == 0 && fr == 0 && fq == 0) *tacc += (unsigned)(__builtin_amdgcn_s_memrealtime() - tq0_);
#endif
#pragma unroll
            for (int ai = 0; ai < 2; ++ai)
#pragma unroll
                for (int m = 0; m < 4; ++m) { const float rs = rstd4(sp[ai][m], eps);
#pragma unroll
                    for (int bj = 0; bj < 2; ++bj)
#pragma unroll
                        for (int n = 0; n < 2; ++n) acc[ai][bj][m][n] = acc[ai][bj][m][n] * (bj ? rs * -0.6931471805599453f : rs); }
        }
        if (fr >= 14) {
#pragma unroll
            for (int ai = 0; ai < 2; ++ai)
#pragma unroll
                for (int n = 0; n < 2; ++n) *(PG8_LAS f32x4*)(xch + (((wr * 2 + ai) * 2 + (fr - 14)) * 128 + colh + 4 * n)) = acc[ai][0][3][n];
            if (wr == 1) {
#pragma unroll
                for (int n = 0; n < 2; ++n) *(f32x4*)(BOTG + (size_t)(u.pm * 2 + fr - 14) * ldc + col0 + 4 * n) = acc[1][0][3][n];
            }
        }
        if (wr == 0 && fr < 2) {
#pragma unroll
            for (int n = 0; n < 2; ++n) { *(f32x4*)(TOPG + (size_t)(u.pm * 2 + fr) * ldc + col0 + 4 * n) = acc[0][0][0][n]; *(f32x4*)(TOPU + (size_t)(u.pm * 2 + fr) * ldc + col0 + 4 * n) = acc[0][1][0][n]; }
        }
        asm volatile("s_waitcnt lgkmcnt(0)" ::: "memory"); __builtin_amdgcn_s_barrier(); asm volatile("" ::: "memory");
        typedef unsigned u32x2v __attribute__((ext_vector_type(2)));
        typedef float f32x2v __attribute__((ext_vector_type(2)));
#if EPI_GU_ST16
        {
            constexpr float NL2E = -1.4426950408889634f;
            f32x4 w0[2], w1[2], w2[2], bb[2];
#pragma unroll
            for (int n = 0; n < 2; ++n) { w0[n] = *(const f32x4*)(cw + col0 + 4 * n) * NL2E; w1[n] = *(const f32x4*)(cw + ldc + col0 + 4 * n) * NL2E; w2[n] = *(const f32x4*)(cw + 2 * ldc + col0 + 4 * n) * NL2E; bb[n] = *(const f32x4*)(cbias + col0 + 4 * n) * NL2E; }
#pragma unroll
            for (int ai = 0; ai < 2; ++ai) {
                f32x4 gp[2], t1p[2];
#pragma unroll
                for (int n = 0; n < 2; ++n) {
                    if (wr == 0 && ai == 0) { gp[n] = (f32x4){0.f, 0.f, 0.f, 0.f}; t1p[n] = (f32x4){0.f, 0.f, 0.f, 0.f}; }
                    else {
                        const int pw = wr ^ 1, pai = (wr == 1) ? ai : ai - 1;
                        const PG8_LAS float* xb = xch + ((pw * 2 + pai) * 2) * 128 + colh + 4 * n;
                        const f32x4 e2 = *(const PG8_LAS f32x4*)(xb), e1 = *(const PG8_LAS f32x4*)(xb + 128); gp[n] = e1; t1p[n] = w1[n] * e1 + w0[n] * e2;
                    } }
#pragma unroll
                for (int m = 0; m < 4; ++m) {
                    u32x4 wq;
#pragma unroll
                    for (int n = 0; n < 2; ++n) {
                        const f32x4 g = acc[ai][0][m][n], uu = acc[ai][1][m][n];
                        f32x4 t1, pre;
#pragma unroll
                        for (int j = 0; j < 4; ++j) { float t_;
                            asm volatile("v_mul_f32 %0, %3, %1\n\tv_fmac_f32_dpp %0, %1, %4 row_shr:1 row_mask:0xf bank_mask:0xf\n\tv_fmac_f32_dpp %0, %2, %4 row_shl:15 row_mask:0xf bank_mask:0xf"
                                         : "=&v"(t_) : "v"(g[j]), "v"(gp[n][j]), "v"(w1[n][j]), "v"(w0[n][j])); t1[j] = t_; }
#pragma unroll
                        for (int j = 0; j < 4; ++j) { float p_;
                            asm volatile("v_fma_f32 %0, %4, %1, %5\n\tv_add_f32_dpp %0, %2, %0 row_shr:1 row_mask:0xf bank_mask:0xf\n\tv_add_f32_dpp %0, %3, %0 row_shl:15 row_mask:0xf bank_mask:0xf"
                                         : "=&v"(p_) : "v"(g[j]), "v"(t1[j]), "v"(t1p[n][j]), "v"(w2[n][j]), "v"(bb[n][j])); pre[j] = p_; }
                        gp[n] = g; t1p[n] = t1;
#pragma unroll
                        for (int h = 0; h < 2; ++h) {
                            const f32x2v p = {pre[2 * h], pre[2 * h + 1]}, u2 = {uu[2 * h], uu[2 * h + 1]};
                            const f32x2v ex = {__builtin_amdgcn_exp2f(p.x), __builtin_amdgcn_exp2f(p.y)};
                            const f32x2v d = ex + 1.0f;
                            const f32x2v r = {__builtin_amdgcn_rcpf(d.x), __builtin_amdgcn_rcpf(d.y)};
                            const f32x2v a = (p * u2) * r;
                            const unsigned pk = cvt_pk_bf16(a.x, a.y);
                            if (n == 0) { if (h == 0) wq.x = pk; else wq.y = pk; } else { if (h == 0) wq.z = pk; else wq.w = pk; }
                        }
                    }
                    *(u32x4*)(ACT + (size_t)(row0 + ai * HALF + m * 16) * ldc + col0) = wq;
                    asm volatile("" ::: "memory");
                }
            }
        }
#else
#pragma unroll
        for (int n = 0; n < 2; ++n) {
            constexpr float NL2E = -1.4426950408889634f;
            const f32x4 w0 = *(const f32x4*)(cw + col0 + 4 * n) * NL2E, w1 = *(const f32x4*)(cw + ldc + col0 + 4 * n) * NL2E, w2 = *(const f32x4*)(cw + 2 * ldc + col0 + 4 * n) * NL2E, bb = *(const f32x4*)(cbias + col0 + 4 * n) * NL2E;
#pragma unroll
            for (int ai = 0; ai < 2; ++ai) {
                f32x4 gp, t1p;
                if (wr == 0 && ai == 0) { gp = (f32x4){0.f, 0.f, 0.f, 0.f}; t1p = (f32x4){0.f, 0.f, 0.f, 0.f}; }
                else {
                    const int pw = wr ^ 1, pai = (wr == 1) ? ai : ai - 1;
                    const PG8_LAS float* xb = xch + ((pw * 2 + pai) * 2) * 128 + colh + 4 * n;
                    const f32x4 e2 = *(const PG8_LAS f32x4*)(xb), e1 = *(const PG8_LAS f32x4*)(xb + 128); gp = e1; t1p = w1 * e1 + w0 * e2;
                }
#pragma unroll
                for (int m = 0; m < 4; ++m) {
                    const f32x4 g = acc[ai][0][m][n], uu = acc[ai][1][m][n];
                    f32x4 t1, pre;
#pragma unroll
                    for (int j = 0; j < 4; ++j) { float t_;
                        asm volatile("v_mul_f32 %0, %3, %1\n\tv_fmac_f32_dpp %0, %1, %4 row_shr:1 row_mask:0xf bank_mask:0xf\n\tv_fmac_f32_dpp %0, %2, %4 row_shl:15 row_mask:0xf bank_mask:0xf"
                                     : "=&v"(t_) : "v"(g[j]), "v"(gp[j]), "v"(w1[j]), "v"(w0[j])); t1[j] = t_; }
#pragma unroll
                    for (int j = 0; j < 4; ++j) { float p_;
                        asm volatile("v_fma_f32 %0, %4, %1, %5\n\tv_add_f32_dpp %0, %2, %0 row_shr:1 row_mask:0xf bank_mask:0xf\n\tv_add_f32_dpp %0, %3, %0 row_shl:15 row_mask:0xf bank_mask:0xf"
                                     : "=&v"(p_) : "v"(g[j]), "v"(t1[j]), "v"(t1p[j]), "v"(w2[j]), "v"(bb[j])); pre[j] = p_; }
                    gp = g; t1p = t1;
                    u32x2v w;
#pragma unroll
                    for (int h = 0; h < 2; ++h) {
                        const f32x2v p = {pre[2 * h], pre[2 * h + 1]}, u2 = {uu[2 * h], uu[2 * h + 1]};
                        const f32x2v ex = {__builtin_amdgcn_exp2f(p.x), __builtin_amdgcn_exp2f(p.y)};
                        const f32x2v d = ex + 1.0f;
                        const f32x2v r = {__builtin_amdgcn_rcpf(d.x), __builtin_amdgcn_rcpf(d.y)};
                        const f32x2v a = (p * u2) * r;
                        if (h == 0) w.x = cvt_pk_bf16(a.x, a.y); else w.y = cvt_pk_bf16(a.x, a.y);
                    }
                    *(u32x2v*)(ACT + (size_t)(row0 + ai * HALF + m * 16) * ldc + col0 + 4 * n) = w;
                    asm volatile("" ::: "memory");
                }
            }
        }
#endif
    }
};
template <int MODE> struct EpiInProj {
    static constexpr bool PERM = true, AFTER_DRAIN = false;
    bf16_t* ZC; bf16_t* Q; bf16_t* Kk; bf16_t* V; const float* gq; const float* gk; float qscale; float eps; float wsc;
    __device__ __forceinline__ void operator()(const f32x4 (&acc)[2][2][4][2], const Unit& u, int wr, int wc, int fr, int fq) const {
        if (MODE == 1 || (MODE == 0 && u.pn < 6)) {
            const int row0 = u.pm * BM + wr * 64 + fr, col0 = u.pn * BM + wc * 32 + 8 * fq;
#pragma unroll
            for (int ai = 0; ai < 2; ++ai)
#pragma unroll
                for (int m = 0; m < 4; ++m) { bf16_t* rowp = ZC + (size_t)(row0 + ai * HALF + m * 16) * 1536 + col0;
#pragma unroll
                    for (int bj = 0; bj < 2; ++bj) st16(rowp + bj * HALF, pack8(acc[ai][bj][m][0], acc[ai][bj][m][1])); }
        } else {
            const int sec = MODE == 2 ? u.pn : u.pn - 6, which = sec >> 1, head = 4 * (sec & 1) + wc; const float iw = 1.0f / wsc, eps2 = eps * wsc * wsc;
            if (which < 2) {
                bf16_t* base = which == 0 ? Q : Kk;
                const float* g = which == 0 ? gq : gk;
                const float sc = which == 0 ? qscale : 1.f;
                const f32x4 g00 = *(const f32x4*)(g + 8 * fq), g01 = *(const f32x4*)(g + 8 * fq + 4), g10 = *(const f32x4*)(g + 32 + 8 * fq), g11 = *(const f32x4*)(g + 32 + 8 * fq + 4);
#pragma unroll
                for (int ai = 0; ai < 2; ++ai)
#pragma unroll
                    for (int m = 0; m < 4; ++m) {
                        const int row = u.pm * BM + ai * HALF + wr * 64 + m * 16 + fr, b = row >> 13, t = row & 8191;
                        float ss = 0.f;
#pragma unroll
                        for (int bj = 0; bj < 2; ++bj)
#pragma unroll
                            for (int n = 0; n < 2; ++n) { const f32x4 x = acc[ai][bj][m][n]; ss += (x[0] * x[0] + x[1] * x[1]) + (x[2] * x[2] + x[3] * x[3]); }
                        ss += lane_xor<16>(ss); ss += lane_xor<32>(ss);
                        const float rs = sc * __builtin_amdgcn_rsqf(ss * (1.0f / 64.0f) + eps2);
                        bf16_t* dst = base + ((size_t)((b * 8 + head) * 8192 + t)) * 64 + 8 * fq;
                        *(u32x4*)(dst) = pack8(acc[ai][0][m][0] * rs * g00, acc[ai][0][m][1] * rs * g01);
                        *(u32x4*)(dst + 32) = pack8(acc[ai][1][m][0] * rs * g10, acc[ai][1][m][1] * rs * g11);
                    }
            } else {
#pragma unroll
                for (int ai = 0; ai < 2; ++ai)
#pragma unroll
                    for (int m = 0; m < 4; ++m) {
                        const int row = u.pm * BM + ai * HALF + wr * 64 + m * 16 + fr, b = row >> 13, t = row & 8191;
                        bf16_t* dst = V + ((size_t)((b * 8 + head) * 8192 + t)) * 64 + 8 * fq;
                        *(u32x4*)(dst) = pack8(acc[ai][0][m][0] * iw, acc[ai][0][m][1] * iw);
                        *(u32x4*)(dst + 32) = pack8(acc[ai][1][m][0] * iw, acc[ai][1][m][1] * iw);
                    }
            }
        }
    }
};
template <bool BASE_BF16, bool F8OUT = false> struct EpiResNorm {
    static constexpr bool PERM = true, AFTER_DRAIN = false;
    const void* base; bf16_t* XB; float* SS; int ldc; PG8_LAS float* red;
    unsigned char* X8 = nullptr;
    __device__ __forceinline__ void operator()(const f32x4 (&acc)[2][2][4][2], const Unit& u, int wr, int wc, int fr, int fq) const {
        const int row0 = u.pm * BM + wr * 64 + fr, col0 = u.pn * BM + wc * 32 + 8 * fq;
        constexpr int NB = BASE_BF16 ? 1 : 2, GPB = 8 / NB;
#pragma unroll
        for (int bt = 0; bt < NB; ++bt) {
            u32x4 pb[GPB][2]; f32x4 pf[BASE_BF16 ? 1 : GPB][2][2];
#pragma unroll
            for (int gi = 0; gi < GPB; ++gi) { const int g8 = bt * GPB + gi, ai = g8 >> 2, m = g8 & 3; const size_t off = (size_t)(row0 + ai * HALF + m * 16) * ldc + col0;
#pragma unroll
                for (int bj = 0; bj < 2; ++bj) {
                    if constexpr (BASE_BF16) {
#if EPI_XB_NT
                        pb[gi][bj] = __builtin_nontemporal_load((const u32x4*)((const bf16_t*)base + off + bj * HALF));
#else
                        pb[gi][bj] = *(const u32x4*)((const bf16_t*)base + off + bj * HALF);
#endif
                    }
                    else {
#if EPI_X_NT
                        pf[gi][bj][0] = __builtin_nontemporal_load((const f32x4*)((const float*)base + off + bj * HALF)); pf[gi][bj][1] = __builtin_nontemporal_load((const f32x4*)((const float*)base + off + bj * HALF + 4));
#else
                        pf[gi][bj][0] = *(const f32x4*)((const float*)base + off + bj * HALF); pf[gi][bj][1] = *(const f32x4*)((const float*)base + off + bj * HALF + 4);
#endif
                    } } }
#pragma unroll
            for (int gi = 0; gi < GPB; ++gi) { const int g8 = bt * GPB + gi, ai = g8 >> 2, m = g8 & 3; const int row = row0 + ai * HALF + m * 16; const size_t off = (size_t)row * ldc + col0; float ss = 0.f;
#pragma unroll
                for (int bj = 0; bj < 2; ++bj) {
                    f32x4 b0, b1;
                    if constexpr (BASE_BF16) { const u32x4 w = pb[gi][bj];
                        b0[0] = __builtin_bit_cast(float, w.x << 16); b0[1] = __builtin_bit_cast(float, w.x & 0xffff0000u); b0[2] = __builtin_bit_cast(float, w.y << 16); b0[3] = __builtin_bit_cast(float, w.y & 0xffff0000u);
                        b1[0] = __builtin_bit_cast(float, w.z << 16); b1[1] = __builtin_bit_cast(float, w.z & 0xffff0000u); b1[2] = __builtin_bit_cast(float, w.w << 16); b1[3] = __builtin_bit_cast(float, w.w & 0xffff0000u); }
                    else { b0 = pf[gi][bj][0]; b1 = pf[gi][bj][1]; }
                    const f32x4 x0 = b0 + acc[ai][bj][m][0], x1 = b1 + acc[ai][bj][m][1];
                    *(u32x4*)(XB + off + bj * HALF) = pack8(x0, x1);
                    if constexpr (F8OUT) *(unsigned long long*)(X8 + off + bj * HALF) = pack8_f8(x0, x1);
                    ss += ((x0[0] * x0[0] + x0[1] * x0[1]) + (x0[2] * x0[2] + x0[3] * x0[3])) + ((x1[0] * x1[0] + x1[1] * x1[1]) + (x1[2] * x1[2] + x1[3] * x1[3]));
                }
                ss += lane_xor<16>(ss); ss += lane_xor<32>(ss);
                if (fq == 0) red[(ai * HALF + wr * 64 + m * 16 + fr) * 4 + wc] = ss; }
            asm volatile("" ::: "memory");
        }
        asm volatile("s_waitcnt lgkmcnt(0)" ::: "memory"); __builtin_amdgcn_s_barrier(); asm volatile("" ::: "memory");
        { const int t = REG_DIET ? (wr * 4 + wc) * 64 + fq * 16 + fr : (int)threadIdx.x; if (t < 256) { const f32x4 v = *(const PG8_LAS f32x4*)(red + t * 4); SS[(size_t)(u.pm * BM + t) * 4 + u.pn] = (v[0] + v[1]) + (v[2] + v[3]); } }
        asm volatile("s_waitcnt lgkmcnt(0)" ::: "memory"); __builtin_amdgcn_s_barrier(); asm volatile("" ::: "memory");
    }
};
struct EpiPle {
    static constexpr bool PERM = true, AFTER_DRAIN = false;
    const bf16_t* xb; float* out; const bf16_t* pp; int ldc; const float* SS; float eps; float asc;
    __device__ __forceinline__ void operator()(const f32x4 (&acc)[2][2][4][2], const Unit& u, int wr, int wc, int fr, int fq) const {
        const int row0 = u.pm * BM + wr * 64 + fr, col0 = u.pn * BM + wc * 32 + 8 * fq;
        float rsv[8];
        {
            f32x4 sp[8];
#pragma unroll
            for (int g8 = 0; g8 < 8; ++g8) sp[g8] = *(const f32x4*)(SS + (size_t)(row0 + (g8 >> 2) * HALF + (g8 & 3) * 16) * 4);
#pragma unroll
            for (int g8 = 0; g8 < 8; ++g8) rsv[g8] = -1.4426950408889634f * asc * rstd4(sp[g8], eps);
        }
        asm volatile("" ::: "memory");
#pragma unroll
        for (int bt = 0; bt < 4; ++bt) {
            u32x4 bw[2][2], pw[2][2];
#pragma unroll
            for (int gi = 0; gi < 2; ++gi) { const int g8 = bt * 2 + gi; const size_t off = (size_t)(row0 + (g8 >> 2) * HALF + (g8 & 3) * 16) * ldc + col0;
#pragma unroll
                for (int bj = 0; bj < 2; ++bj) { bw[gi][bj] = *(const u32x4*)(xb + off + bj * HALF);
#if EPI_PP_NT
                    pw[gi][bj] = __builtin_nontemporal_load((const u32x4*)(pp + off + bj * HALF));
#else
                    pw[gi][bj] = *(const u32x4*)(pp + off + bj * HALF);
#endif
                } }
#pragma unroll
            for (int gi = 0; gi < 2; ++gi) { const int g8 = bt * 2 + gi, ai = g8 >> 2, m = g8 & 3; const size_t off = (size_t)(row0 + ai * HALF + m * 16) * ldc + col0; const float rs = rsv[g8];
#pragma unroll
                for (int bj = 0; bj < 2; ++bj) { const size_t o2 = off + bj * HALF;
                    const unsigned bws[4] = {bw[gi][bj].x, bw[gi][bj].y, bw[gi][bj].z, bw[gi][bj].w}, pws[4] = {pw[gi][bj].x, pw[gi][bj].y, pw[gi][bj].z, pw[gi][bj].w};
                    f32x4 o[2];
#pragma unroll
                    for (int n = 0; n < 2; ++n)
#pragma unroll
                        for (int e = 0; e < 4; ++e) { const unsigned bb = bws[2 * n + (e >> 1)], pq = pws[2 * n + (e >> 1)];
                            const float bv = (e & 1) ? __builtin_bit_cast(float, bb & 0xffff0000u) : __builtin_bit_cast(float, bb << 16), pv = (e & 1) ? __builtin_bit_cast(float, pq & 0xffff0000u) : __builtin_bit_cast(float, pq << 16);
                            const float sg = __builtin_amdgcn_rcpf(1.0f + __builtin_amdgcn_exp2f(rs * acc[ai][bj][m][n][e])); o[n][e] = bv + sg * pv; }
#if EPI_OUT_NT
                    __builtin_nontemporal_store(o[0], (f32x4*)(out + o2)); __builtin_nontemporal_store(o[1], (f32x4*)(out + o2 + 4)); } }
#else
                    *(f32x4*)(out + o2) = o[0]; *(f32x4*)(out + o2 + 4) = o[1]; } }
#endif
            asm volatile("" ::: "memory");
        }
    }
};

#ifndef PG8_SADDR
#define PG8_SADDR 1
#endif
#ifndef PG8_ZACC
#define PG8_ZACC 1
#endif
struct ZTrue { static constexpr bool value = true; }; struct ZFalse { static constexpr bool value = false; };
template <class Epi, class Sched, bool ALIGN_EPI = false, bool SP2 = false, int AUXA = 0, int AUXB = 0, int ABL = 0, bool F8 = false>
__device__ __forceinline__ void gemm_phase(PG8_LAS unsigned char* lds, const Gemm g, const Sched& S, const Epi& E, const int wave  ) {
    int tid_ = REG_DIET ? 64 * wave + hw_lane() : (int)threadIdx.x; asm volatile("" : "+v"(tid_));
    const int tid = tid_, wid = __builtin_amdgcn_readfirstlane(tid >> 6), lane = tid & 63, wr = wid >> 2, wc = wid & 3, fr = lane & 15, fq = lane >> 4;
    const int K = g.K, nt = K / BK;
    unsigned voffA[2], voffB[2];
#pragma unroll
    for (int i = 0; i < 2; ++i) { int R, C; stage_rc(tid * 16 + i * 8192, R, C); const int Rb = Epi::PERM ? ((R & ~31) + perm32(R & 31)) : R;
        voffA[i] = (unsigned)(R * K + C) * 2u; voffB[i] = (unsigned)(Rb * K + C) * 2u; }
    const size_t kstep = (size_t)(BK * 2);
    const size_t hstep = (size_t)HALF * K * 2;
    const size_t tstep = 2 * hstep;
    const unsigned ldsw = (unsigned)wid * 1024u;
    const int aoff = lds_byte(wr * 64 + fr, fq * 8), boff = lds_byte(wc * 32 + fr, fq * 8);
    PG8_LAS unsigned char* ldsA = lds + aoff; asm volatile("" : "+v"(ldsA)); PG8_LAS unsigned char* ldsB = lds + 4 * HTB + boff; asm volatile("" : "+v"(ldsB));
#define PG8_SA(b, h) (((b) * 2 + (h)) * HTB)
#define PG8_SB(b, h) ((4 + (b) * 2 + (h)) * HTB)
#if PG8_SADDR
#define PG8_STAGE_X(bufoff, gbase, voff, AUX) do { const char* _gp = (const char*)(gbase); asm volatile("" : "+s"(_gp));   \
        _Pragma("unroll") for (int _i = 0; _i < 2; ++_i) \
        __builtin_amdgcn_global_load_lds((const unsigned*)(_gp + (voff)[_i]), (PG8_LAS unsigned*)(lds + (bufoff) + ldsw + _i * 8192), 16, 0, AUX); } while (0)
#else
#define PG8_STAGE_X(bufoff, gbase, voff, AUX) do { _Pragma("unroll") for (int _i = 0; _i < 2; ++_i) \
        __builtin_amdgcn_global_load_lds((const unsigned*)((const char*)(gbase) + (voff)[_i]), (PG8_LAS unsigned*)(lds + (bufoff) + ldsw + _i * 8192), 16, 0, AUX); } while (0)
#endif
#define PG8_STAGE(bufoff, gbase, voff) do { if constexpr (!(ABL & 1)) { if (&(voff) == &voffA) PG8_STAGE_X(bufoff, gbase, voff, AUXA); else PG8_STAGE_X(bufoff, gbase, voff, AUXB); } } while (0)
#define PG8_LDA(dst, b, h) do { if constexpr (!(ABL & 2)) _Pragma("unroll") for (int m = 0; m < 4; ++m) _Pragma("unroll") for (int k = 0; k < 2; ++k) dst[m][k] = *(const PG8_LAS bf16x8*)(ldsA + PG8_SA(b, h) + m * 2048 + k * 1024); } while (0)
#define PG8_LDB(dst, b, h) do { if constexpr (!(ABL & 2)) _Pragma("unroll") for (int n = 0; n < 2; ++n) _Pragma("unroll") for (int k = 0; k < 2; ++k) dst[n][k] = *(const PG8_LAS bf16x8*)(ldsB + (PG8_SB(b, h) - 4 * HTB) + n * 2048 + k * 1024); } while (0)
#ifndef PG8_KOUT
#define PG8_KOUT 0
#endif
#ifndef PG8_ORD
#define PG8_ORD 0
#endif
#ifndef PG8_BAL
#define PG8_BAL 1
#endif
#ifndef PG8_PRIO_LOAD
#define PG8_PRIO_LOAD 0
#endif
#ifndef PG8_PRIO
#define PG8_PRIO 1
#endif
#if PG8_KOUT
#define PG8_MMA(ai, bj, At, Bt, Z) do { if constexpr (!(ABL & 4)) { if (PG8_PRIO) __builtin_amdgcn_s_setprio(PG8_PRIO); _Pragma("unroll") for (int k = 0; k < 2; ++k) _Pragma("unroll") for (int m = 0; m < 4; ++m) _Pragma("unroll") for (int n = 0; n < 2; ++n) \
        acc[ai][bj][m][n] = __builtin_amdgcn_mfma_f32_16x16x32_bf16(Bt[n][k], At[m][k], acc[ai][bj][m][n], 0, 0, 0); if (PG8_PRIO) __builtin_amdgcn_s_setprio(PG8_PRIO_LOAD); } } while (0)
#else
#define PG8_CAT8(x0, x1) __builtin_shufflevector(__builtin_bit_cast(i32x4, x0), __builtin_bit_cast(i32x4, x1), 0, 1, 2, 3, 4, 5, 6, 7)
#define PG8_MMA(ai, bj, At, Bt, Z) do { if constexpr (!(ABL & 4)) { if (PG8_PRIO) __builtin_amdgcn_s_setprio(PG8_PRIO); \
        if constexpr (F8) { _Pragma("unroll") for (int m = 0; m < 4; ++m) _Pragma("unroll") for (int n = 0; n < 2; ++n) \
            acc[ai][bj][m][n] = __builtin_amdgcn_mfma_scale_f32_16x16x128_f8f6f4(PG8_CAT8(Bt[n][0], Bt[n][1]), PG8_CAT8(At[m][0], At[m][1]), (Z) ? (f32x4){0.f, 0.f, 0.f, 0.f} : acc[ai][bj][m][n], 0, 0, 0, 0, 0, 0); } \
        else { _Pragma("unroll") for (int m = 0; m < 4; ++m) _Pragma("unroll") for (int n = 0; n < 2; ++n) _Pragma("unroll") for (int k = 0; k < 2; ++k) \
            acc[ai][bj][m][n] = __builtin_amdgcn_mfma_f32_16x16x32_bf16(Bt[n][k], At[m][k], ((Z) && k == 0) ? (f32x4){0.f, 0.f, 0.f, 0.f} : acc[ai][bj][m][n], 0, 0, 0); } \
        if (PG8_PRIO) __builtin_amdgcn_s_setprio(PG8_PRIO_LOAD); } } while (0)
#endif
#define PG8_WAIT_V(n) asm volatile("s_waitcnt vmcnt(" #n ")" ::: "memory")
#define PG8_WAIT_L(n) asm volatile("s_waitcnt lgkmcnt(" #n ")" ::: "memory")
#define PG8_BAR __builtin_amdgcn_s_barrier()
#define PG8_BARL do { if constexpr (!(ABL & 8)) __builtin_amdgcn_s_barrier(); } while (0)
#define PG8_SCHED __builtin_amdgcn_sched_barrier(0)
    Unit cur, nxt; int ui = 0;
    if (!S.next(0, cur)) return;
    f32x4 acc[2][2][4][2];
#if !PG8_ZACC
#pragma unroll
    for (int a = 0; a < 2; ++a)
#pragma unroll
        for (int b = 0; b < 2; ++b)
#pragma unroll
            for (int m = 0; m < 4; ++m)
#pragma unroll
                for (int n = 0; n < 2; ++n) acc[a][b][m][n] = (f32x4){0.f, 0.f, 0.f, 0.f};
#endif
    bf16x8 At[4][2], B0[2][2], B1[2][2];
    if constexpr ((ABL & 2) != 0) { _Pragma("unroll") for (int m = 0; m < 4; ++m) _Pragma("unroll") for (int k = 0; k < 2; ++k) At[m][k] = (bf16x8){1, 2, 3, 4, 5, 6, 7, 8}; _Pragma("unroll") for (int n = 0; n < 2; ++n) _Pragma("unroll") for (int k = 0; k < 2; ++k) { B0[n][k] = (bf16x8){1, 2, 3, 4, 5, 6, 7, 8}; B1[n][k] = (bf16x8){8, 7, 6, 5, 4, 3, 2, 1}; } }
    const char* cA = (const char*)g.A + (size_t)cur.pm * tstep; const char* cB = (const char*)g.Bt + (size_t)cur.pn * tstep;
    S.a_ready(cur);
    if constexpr (SP2) {
        PG8_STAGE(PG8_SB(0, 0), cB, voffB); PG8_STAGE(PG8_SB(0, 1), cB + hstep, voffB); PG8_STAGE(PG8_SA(0, 0), cA, voffA); PG8_STAGE(PG8_SA(0, 1), cA + hstep, voffA);
        if (wr == 1) PG8_BAR;
        PG8_WAIT_V(2); PG8_BAR;
#if PG8_BAL
        PG8_STAGE(PG8_SB(1, 0), cB + kstep, voffB); PG8_STAGE(PG8_SB(1, 1), cB + hstep + kstep, voffB);
        PG8_WAIT_V(4); PG8_BAR;
#else
        PG8_STAGE(PG8_SB(1, 0), cB + kstep, voffB); PG8_STAGE(PG8_SA(1, 0), cA + kstep, voffA); PG8_STAGE(PG8_SB(1, 1), cB + hstep + kstep, voffB);
        PG8_WAIT_V(6); PG8_BAR;
#endif
    } else {
        PG8_STAGE(PG8_SB(0, 0), cB, voffB); PG8_STAGE(PG8_SA(0, 0), cA, voffA); PG8_STAGE(PG8_SB(0, 1), cB + hstep, voffB); PG8_STAGE(PG8_SA(0, 1), cA + hstep, voffA);
        if (wr == 1) PG8_BAR;
        PG8_WAIT_V(4); PG8_BAR;
        PG8_STAGE(PG8_SB(1, 0), cB + kstep, voffB); PG8_STAGE(PG8_SA(1, 0), cA + kstep, voffA); PG8_STAGE(PG8_SB(1, 1), cB + hstep + kstep, voffB);
        PG8_WAIT_V(6); PG8_BAR;
    }
    for (;;) {
        const bool has_next = S.next(ui + 1, nxt);
        const char* nA = has_next ? (const char*)g.A + (size_t)nxt.pm * tstep : cA; const char* nB = has_next ? (const char*)g.Bt + (size_t)nxt.pn * tstep : cB;
        auto kbody = [&](auto zt_, const int t) __attribute__((always_inline)) {
            constexpr bool Z0 = decltype(zt_)::value; (void)Z0;
            const bool last = (t == nt - 2);
            const char* a1 = cA + (size_t)(t + 1) * kstep;
            const char* a2 = last ? nA : cA + (size_t)(t + 2) * kstep; const char* b2 = last ? nB : cB + (size_t)(t + 2) * kstep;
            const char* a3 = a2 + kstep; const char* b3 = b2 + kstep;
            if (last && has_next) S.a_ready(nxt);
            if constexpr (SP2) {
#if PG8_BAL
#if PG8_ORD == 1
            PG8_STAGE(PG8_SA(1, 0), a1, voffA); PG8_STAGE(PG8_SA(1, 1), a1 + hstep, voffA); PG8_SCHED; PG8_LDB(B0, 0, 0); PG8_LDB(B1, 0, 1); PG8_SCHED; PG8_LDA(At, 0, 0);
            PG8_WAIT_V(8); PG8_WAIT_L(0); PG8_BARL; PG8_MMA(0, 0, At, B0, Z0); PG8_MMA(0, 1, At, B1, Z0); PG8_BARL; PG8_SCHED;
            PG8_STAGE(PG8_SB(0, 0), b2, voffB); PG8_STAGE(PG8_SB(0, 1), b2 + hstep, voffB); PG8_SCHED; PG8_LDA(At, 0, 1);
            PG8_WAIT_V(6); PG8_WAIT_L(0); PG8_BARL; PG8_MMA(1, 0, At, B0, Z0); PG8_MMA(1, 1, At, B1, Z0); PG8_BARL; PG8_SCHED;
            PG8_STAGE(PG8_SA(0, 0), a2, voffA); PG8_STAGE(PG8_SA(0, 1), a2 + hstep, voffA); PG8_SCHED; PG8_LDB(B0, 1, 0); PG8_LDB(B1, 1, 1); PG8_SCHED; PG8_LDA(At, 1, 0);
            PG8_WAIT_V(8); PG8_WAIT_L(0); PG8_BARL; PG8_MMA(0, 0, At, B0, false); PG8_MMA(0, 1, At, B1, false); PG8_BARL; PG8_SCHED;
            PG8_STAGE(PG8_SB(1, 0), b3, voffB); PG8_STAGE(PG8_SB(1, 1), b3 + hstep, voffB); PG8_SCHED; PG8_LDA(At, 1, 1);
            PG8_WAIT_V(6); PG8_WAIT_L(0); PG8_BARL; PG8_MMA(1, 0, At, B0, false); PG8_MMA(1, 1, At, B1, false); PG8_BARL; PG8_SCHED;
#elif PG8_ORD == 2
            PG8_LDB(B0, 0, 0); PG8_SCHED; PG8_STAGE(PG8_SA(1, 0), a1, voffA); PG8_SCHED; PG8_LDB(B1, 0, 1); PG8_SCHED; PG8_STAGE(PG8_SA(1, 1), a1 + hstep, voffA); PG8_SCHED; PG8_LDA(At, 0, 0);
            PG8_WAIT_V(8); PG8_WAIT_L(0); PG8_BARL; PG8_MMA(0, 0, At, B0, Z0); PG8_MMA(0, 1, At, B1, Z0); PG8_BARL; PG8_SCHED;
            PG8_STAGE(PG8_SB(0, 0), b2, voffB); PG8_SCHED; PG8_LDA(At, 0, 1); PG8_SCHED; PG8_STAGE(PG8_SB(0, 1), b2 + hstep, voffB);
            PG8_WAIT_V(6); PG8_WAIT_L(0); PG8_BARL; PG8_MMA(1, 0, At, B0, Z0); PG8_MMA(1, 1, At, B1, Z0); PG8_BARL; PG8_SCHED;
            PG8_LDB(B0, 1, 0); PG8_SCHED; PG8_STAGE(PG8_SA(0, 0), a2, voffA); PG8_SCHED; PG8_LDB(B1, 1, 1); PG8_SCHED; PG8_STAGE(PG8_SA(0, 1), a2 + hstep, voffA); PG8_SCHED; PG8_LDA(At, 1, 0);
            PG8_WAIT_V(8); PG8_WAIT_L(0); PG8_BARL; PG8_MMA(0, 0, At, B0, false); PG8_MMA(0, 1, At, B1, false); PG8_BARL; PG8_SCHED;
            PG8_STAGE(PG8_SB(1, 0), b3, voffB); PG8_SCHED; PG8_LDA(At, 1, 1); PG8_SCHED; PG8_STAGE(PG8_SB(1, 1), b3 + hstep, voffB);
            PG8_WAIT_V(6); PG8_WAIT_L(0); PG8_BARL; PG8_MMA(1, 0, At, B0, false); PG8_MMA(1, 1, At, B1, false); PG8_BARL; PG8_SCHED;
#else
            PG8_LDB(B0, 0, 0); PG8_LDB(B1, 0, 1); PG8_SCHED; PG8_LDA(At, 0, 0); PG8_STAGE(PG8_SA(1, 0), a1, voffA); PG8_STAGE(PG8_SA(1, 1), a1 + hstep, voffA);
            PG8_WAIT_V(8); PG8_WAIT_L(0); PG8_BARL; PG8_MMA(0, 0, At, B0, Z0); PG8_MMA(0, 1, At, B1, Z0); PG8_BARL; PG8_SCHED;
            PG8_LDA(At, 0, 1); PG8_STAGE(PG8_SB(0, 0), b2, voffB); PG8_STAGE(PG8_SB(0, 1), b2 + hstep, voffB);
            PG8_WAIT_V(6); PG8_WAIT_L(0); PG8_BARL; PG8_MMA(1, 0, At, B0, Z0); PG8_MMA(1, 1, At, B1, Z0); PG8_BARL; PG8_SCHED;
            PG8_LDB(B0, 1, 0); PG8_LDB(B1, 1, 1); PG8_SCHED; PG8_LDA(At, 1, 0); PG8_STAGE(PG8_SA(0, 0), a2, voffA); PG8_STAGE(PG8_SA(0, 1), a2 + hstep, voffA);
            PG8_WAIT_V(8); PG8_WAIT_L(0); PG8_BARL; PG8_MMA(0, 0, At, B0, false); PG8_MMA(0, 1, At, B1, false); PG8_BARL; PG8_SCHED;
            PG8_LDA(At, 1, 1); PG8_STAGE(PG8_SB(1, 0), b3, voffB); PG8_STAGE(PG8_SB(1, 1), b3 + hstep, voffB);
            PG8_WAIT_V(6); PG8_WAIT_L(0); PG8_BARL; PG8_MMA(1, 0, At, B0, false); PG8_MMA(1, 1, At, B1, false); PG8_BARL; PG8_SCHED;
#endif
            (void)a3;
#else
            PG8_LDB(B0, 0, 0); PG8_LDB(B1, 0, 1); PG8_SCHED; PG8_LDA(At, 0, 0); PG8_STAGE(PG8_SA(1, 1), a1 + hstep, voffA);
            PG8_WAIT_V(8); PG8_WAIT_L(0); PG8_BARL; PG8_MMA(0, 0, At, B0, Z0); PG8_MMA(0, 1, At, B1, Z0); PG8_BARL; PG8_SCHED;
            PG8_LDA(At, 0, 1); PG8_STAGE(PG8_SB(0, 0), b2, voffB); PG8_STAGE(PG8_SB(0, 1), b2 + hstep, voffB); PG8_STAGE(PG8_SA(0, 0), a2, voffA);
            PG8_WAIT_V(8); PG8_WAIT_L(0); PG8_BARL; PG8_MMA(1, 0, At, B0, Z0); PG8_MMA(1, 1, At, B1, Z0); PG8_BARL; PG8_SCHED;
            PG8_LDB(B0, 1, 0); PG8_LDB(B1, 1, 1); PG8_SCHED; PG8_LDA(At, 1, 0); PG8_STAGE(PG8_SA(0, 1), a2 + hstep, voffA);
            PG8_WAIT_V(8); PG8_WAIT_L(0); PG8_BARL; PG8_MMA(0, 0, At, B0, false); PG8_MMA(0, 1, At, B1, false); PG8_BARL; PG8_SCHED;
            PG8_LDA(At, 1, 1); PG8_STAGE(PG8_SB(1, 0), b3, voffB); PG8_STAGE(PG8_SB(1, 1), b3 + hstep, voffB); PG8_STAGE(PG8_SA(1, 0), a3, voffA);
            PG8_WAIT_V(8); PG8_WAIT_L(0); PG8_BARL; PG8_MMA(1, 0, At, B0, false); PG8_MMA(1, 1, At, B1, false); PG8_BARL; PG8_SCHED;
#endif
            } else {
            PG8_LDB(B0, 0, 0); PG8_SCHED; PG8_LDA(At, 0, 0); PG8_STAGE(PG8_SA(1, 1), a1 + hstep, voffA);
            PG8_WAIT_L(8); PG8_BAR; PG8_WAIT_L(0); PG8_MMA(0, 0, At, B0, Z0); PG8_BAR; PG8_SCHED;
            PG8_LDB(B1, 0, 1); PG8_STAGE(PG8_SB(0, 0), b2, voffB);
            PG8_BAR; PG8_WAIT_L(0); PG8_MMA(0, 1, At, B1, Z0); PG8_BAR;
            PG8_LDA(At, 0, 1); PG8_STAGE(PG8_SA(0, 0), a2, voffA);
            PG8_BAR; PG8_WAIT_L(0); PG8_MMA(1, 0, At, B0, Z0); PG8_BAR; PG8_SCHED;
            PG8_STAGE(PG8_SB(0, 1), b2 + hstep, voffB);
            PG8_WAIT_V(6); PG8_BARL; PG8_MMA(1, 1, At, B1, Z0); PG8_BARL;
            PG8_LDB(B0, 1, 0); PG8_SCHED; PG8_LDA(At, 1, 0); PG8_STAGE(PG8_SA(0, 1), a2 + hstep, voffA);
            PG8_WAIT_L(8); PG8_BAR; PG8_WAIT_L(0); PG8_MMA(0, 0, At, B0, false); PG8_BAR; PG8_SCHED;
            PG8_LDB(B1, 1, 1); PG8_STAGE(PG8_SB(1, 0), b3, voffB);
            PG8_BAR; PG8_WAIT_L(0); PG8_MMA(0, 1, At, B1, false); PG8_BAR;
            PG8_LDA(At, 1, 1); PG8_STAGE(PG8_SA(1, 0), a3, voffA);
            PG8_BAR; PG8_WAIT_L(0); PG8_MMA(1, 0, At, B0, false); PG8_BAR; PG8_SCHED;
            PG8_STAGE(PG8_SB(1, 1), b3 + hstep, voffB);
            PG8_WAIT_V(6); PG8_BARL; PG8_MMA(1, 1, At, B1, false); PG8_BARL;
            }
        };
#if PG8_ZACC
        kbody(ZTrue{}, 0);
        for (int t = 2; t < nt; t += 2) kbody(ZFalse{}, t);
#else
        for (int t = 0; t < nt; t += 2) kbody(ZFalse{}, t);
#endif
        if constexpr (ALIGN_EPI) { if (wr == 0) PG8_BAR; }
#ifdef PROBE_EPI
        unsigned long long te0_ = 0; if (g.tacc) te0_ = __builtin_amdgcn_s_memrealtime();
#endif
        if constexpr (!Epi::AFTER_DRAIN) { int l2_ = lane; asm volatile("" : "+v"(l2_));
            if constexpr (REG_DIET) E(acc, cur, wr, wc, l2_ & 15, l2_ >> 4); else E(acc, cur, wr, wc, fr, fq); S.done(cur); }
#ifdef PROBE_EPI
        if (g.tacc && blockIdx.x == 0 && tid == 0) { *g.tacc += (unsigned)(__builtin_amdgcn_s_memrealtime() - te0_); }
#endif
        if (!has_next) break;
#if !PG8_ZACC
#pragma unroll
        for (int a = 0; a < 2; ++a)
#pragma unroll
            for (int b = 0; b < 2; ++b)
#pragma unroll
                for (int m = 0; m < 4; ++m)
#pragma unroll
                    for (int n = 0; n < 2; ++n) acc[a][b][m][n] = (f32x4){0.f, 0.f, 0.f, 0.f};
#endif
        cur = nxt; cA = nA; cB = nB; ++ui;
        if constexpr (ALIGN_EPI) { if (wr == 1) PG8_BAR; }
    }
    PG8_WAIT_V(0);
    if constexpr (!ALIGN_EPI) { if (wr == 0) PG8_BAR; }
    PG8_BAR;
    if constexpr (Epi::AFTER_DRAIN) { E.fused(acc, cur, wr, wc, fr, fq, lds, wid, lane); S.done(cur); }
#undef PG8_SA
#undef PG8_SB
#undef PG8_STAGE
#undef PG8_STAGE_X
#undef PG8_LDA
#undef PG8_LDB
#undef PG8_MMA
#undef PG8_CAT8
#undef PG8_WAIT_V
#undef PG8_WAIT_L
#undef PG8_BAR
#undef PG8_BARL
#undef PG8_SCHED
}
}
#define GAS __attribute__((address_space(1)))
#define LAS __attribute__((address_space(3)))
typedef unsigned short bf16;
typedef unsigned v4u __attribute__((ext_vector_type(4)));
typedef float f32x4 __attribute__((ext_vector_type(4)));
typedef short bf16x8 __attribute__((ext_vector_type(8)));
typedef GAS unsigned gu32;
typedef GAS unsigned long long gu64;
#define RLX_AGENT __ATOMIC_RELAXED, __HIP_MEMORY_SCOPE_AGENT
#define LDS_WAIT() asm volatile("s_waitcnt lgkmcnt(0)" ::: "memory")
#define VM_WAIT() asm volatile("s_waitcnt vmcnt(0)" ::: "memory")
__device__ __forceinline__ unsigned long long rt() { return __builtin_amdgcn_s_memrealtime(); }
__device__ __forceinline__ unsigned f2bf(float f) { unsigned u = __builtin_bit_cast(unsigned, f); return (u + 0x7fffu + ((u >> 16) & 1u)) >> 16; }
__device__ __forceinline__ unsigned pk2(float lo, float hi) { return f2bf(lo) | (f2bf(hi) << 16); }

#define XB_TMO      128
#define XB_XCNT(j)  (256  + 64 * (j))
#define XB_XSUB(j)  (1280 + 64 * (j))
#define XB_XGEN(j)  (2304 + 64 * (j))
#define XB_TOP      3328
#define XB_TOPGEN   3392
#define XCD_BAR_WORDS 3456
#define XB_SPIN_CAP (1u << 18)

__device__ __forceinline__ unsigned xb_ld(unsigned* p)              { return __hip_atomic_load(p, __ATOMIC_RELAXED, __HIP_MEMORY_SCOPE_AGENT); }
__device__ __forceinline__ unsigned xb_add(unsigned* p, unsigned v) { return __hip_atomic_fetch_add(p, v, __ATOMIC_RELAXED, __HIP_MEMORY_SCOPE_AGENT); }
__device__ __forceinline__ unsigned xb_xcc_id() { return (unsigned)__builtin_amdgcn_s_getreg((3 << 11) | 20) & 0xFu; }
#define XB_SPIN(cond, bar) do { unsigned _sp = 0; while (cond) { __builtin_amdgcn_s_sleep(1); \
    if ((++_sp & 255u) == 0u) { if (xb_ld(&(bar)[XB_TMO])) break; if (_sp > XB_SPIN_CAP) { atomicAdd(&(bar)[XB_TMO], 1u); break; } } } } while (0)

struct XcdBarrier {
    unsigned* bar; unsigned x;
    unsigned w;
    volatile LAS unsigned* st;
};

__device__ __forceinline__ XcdBarrier xcd_barrier_post(unsigned* bar, volatile LAS unsigned* st) {
    XcdBarrier b; b.bar = bar; b.x = xb_xcc_id(); b.st = st;
    if (threadIdx.x == 0) (void)xb_add(&bar[XB_XCNT(b.x)], 1u);
    return b;
}
__device__ __forceinline__ void xcd_barrier_complete(unsigned* bar, unsigned x, unsigned& nloc, unsigned& nx) {
    const unsigned G = gridDim.x * gridDim.y * gridDim.z;
    unsigned sum, cnt, mine, sp = 0u;
    for (;;) {
        sum = 0u; cnt = 0u; mine = 0u;
#pragma unroll
        for (unsigned j = 0; j < 16; ++j) { const unsigned c = xb_ld(&bar[XB_XCNT(j)]); sum += c; cnt += (c > 0u) ? 1u : 0u; mine = (j == x) ? c : mine; }
        if (sum == G) break;
        __builtin_amdgcn_s_sleep(1);
        if ((++sp & 255u) == 0u) { if (xb_ld(&bar[XB_TMO])) break; if (sp > XB_SPIN_CAP) { atomicAdd(&bar[XB_TMO], 1u); break; } }
    }
    nloc = mine > 0u ? mine : 1u; nx = cnt > 0u ? cnt : 1u;
}

__device__ __forceinline__ void xcd_barrier(const XcdBarrier& b) {
    asm volatile("s_waitcnt vmcnt(0)" ::: "memory");
    __syncthreads();
    if (REG_DIET ? (b.w == 0u && hw_lane() == 0) : (threadIdx.x == 0)) {
        unsigned* bar = b.bar;
        __builtin_amdgcn_s_waitcnt(0);
        unsigned nloc = b.st[0], nx = b.st[1];
        if (nloc == 0u) { xcd_barrier_complete(bar, b.x, nloc, nx); b.st[0] = nloc; b.st[1] = nx; }
        const unsigned old = xb_add(&bar[XB_XSUB(b.x)], 1u);
        const unsigned gen = old / nloc;
        if (old + 1u == (gen + 1u) * nloc) {
            __builtin_amdgcn_fence(__ATOMIC_RELEASE, "agent");
            asm volatile("s_waitcnt vmcnt(0)" ::: "memory");
            const unsigned og = xb_add(&bar[XB_TOP], 1u);
            const unsigned tg = og / nx;
            if (og + 1u == (tg + 1u) * nx) xb_add(&bar[XB_TOPGEN], 1u);
            else XB_SPIN(xb_ld(&bar[XB_TOPGEN]) == tg, bar);
            __builtin_amdgcn_fence(__ATOMIC_ACQUIRE, "agent");
            xb_add(&bar[XB_XGEN(b.x)], 1u);
            asm volatile("s_waitcnt vmcnt(0)" ::: "memory");
        } else {
            XB_SPIN(xb_ld(&bar[XB_XGEN(b.x)]) == gen, bar);
            __builtin_amdgcn_fence(__ATOMIC_ACQUIRE, "agent");
            asm volatile("s_waitcnt vmcnt(0)" ::: "memory");
        }
    }
    __syncthreads();
}

#ifndef ATT_VEARLY
#define ATT_VEARLY 1
#endif
constexpr int NWAVES = 8;
constexpr int BATCH = 4, SEQ = 8192, DM = 1024, MROWS = BATCH * SEQ, CONVW = 512, NHEAD = 8, HD = 64, ATTW = 512, INCOLS = 3072, DFF = 2816, PLED = 256;
constexpr float EPS = 1e-6f;
constexpr float LOG2E = 1.4426950408889634f;
constexpr size_t MiB = 1u << 20;
constexpr size_t WS_CTL = 0, CTL_ZERO_BYTES = 40960;
constexpr size_t WS_WIN = 2 * MiB, WS_WOUT = 8 * MiB, WS_WGU = 10 * MiB, WS_WDN = 21 * MiB, WS_WPG = 27 * MiB, WS_WPP = 29 * MiB;
constexpr size_t WS_H = 32 * MiB;
constexpr size_t WS_PB = 96 * MiB;
constexpr size_t WS_ZC = 112 * MiB;
constexpr size_t WS_Q = 208 * MiB, WS_K = 240 * MiB, WS_V = 272 * MiB;
constexpr size_t WS_OP = 304 * MiB;
constexpr size_t WS_LP = 400 * MiB;
constexpr size_t WS_Y = 404 * MiB;
constexpr size_t WS_U = 112 * MiB;
constexpr size_t WS_TOPG = 288 * MiB, WS_BOTG = 291 * MiB, WS_TOPU = 294 * MiB;
constexpr size_t WS_PP = 300 * MiB;
constexpr size_t WS_SS = 30 * MiB;
constexpr size_t WS_X2 = 364 * MiB;
#ifndef P10_F8
#define P10_F8 0
#endif
#ifndef P1_F8
#define P1_F8 0
#endif
constexpr size_t WS_H8 = 432 * MiB;
constexpr size_t WS_W8IN = 5 * MiB;
constexpr size_t WS_X2F8 = 432 * MiB;
constexpr size_t WS_END = 468 * MiB;
constexpr float W8_SCALE = 128.0f;
constexpr int CW_BAR = 4096;
constexpr int CW_PAN = 7680;
constexpr int CW_Q0 = 64;
constexpr int RING_BYTES = 131072, LDSCTL_OFF = RING_BYTES, MISC_OFF = LDSCTL_OFF + 320, XCH_OFF = RING_BYTES + 4096  , LDS_BYTES = 151552  ;

#ifndef MERGE_TB
#define MERGE_TB 8
#endif
#ifndef MIX_NT
#define MIX_NT 1
#endif
#if MIX_NT
#define MIX_LD(p) __builtin_nontemporal_load(p)
#else
#define MIX_LD(p) (*(p))
#endif
#ifndef P0_NT
#define P0_NT 1
#endif
#if P0_NT
#define P0_LD(p) __builtin_nontemporal_load(p)
#else
#define P0_LD(p) (*(p))
#endif
__device__ __forceinline__ float wave_sum(float v) {
    v += lane_xor<1>(v); v += lane_xor<2>(v); v += lane_xor<4>(v); v += lane_xor<8>(v); v += lane_xor<16>(v); v += lane_xor<32>(v);
    return v;
}
__device__ __forceinline__ float wave_max(float v) {
    v = fmaxf(v, lane_xor<1>(v)); v = fmaxf(v, lane_xor<2>(v)); v = fmaxf(v, lane_xor<4>(v)); v = fmaxf(v, lane_xor<8>(v)); v = fmaxf(v, lane_xor<16>(v)); v = fmaxf(v, lane_xor<32>(v));
    return v;
}
typedef float cv_f32x2 __attribute__((ext_vector_type(2)));
typedef __bf16 cv_bf16x2 __attribute__((ext_vector_type(2)));
__device__ __forceinline__ unsigned cvtpk(float lo, float hi) { const cv_f32x2 v = {lo, hi}; return __builtin_bit_cast(unsigned, __builtin_convertvector(v, cv_bf16x2)); }
__device__ __forceinline__ float bflo(unsigned w) { return __builtin_bit_cast(float, w << 16); }
__device__ __forceinline__ float bfhi(unsigned w) { return __builtin_bit_cast(float, w & 0xffff0000u); }
__device__ __forceinline__ void unpack8(const v4u w, float (&f)[8]) { f[0] = bflo(w.x); f[1] = bfhi(w.x); f[2] = bflo(w.y); f[3] = bfhi(w.y); f[4] = bflo(w.z); f[5] = bfhi(w.z); f[6] = bflo(w.w); f[7] = bfhi(w.w); }
__device__ __forceinline__ v4u pack8f(const float (&f)[8]) { v4u w; w.x = cvtpk(f[0], f[1]); w.y = cvtpk(f[2], f[3]); w.z = cvtpk(f[4], f[5]); w.w = cvtpk(f[6], f[7]); return w; }
__device__ __forceinline__ void load8f(const float* p, float (&f)[8]) { const f32x4 a = *(const f32x4*)p, b = *(const f32x4*)(p + 4); f[0] = a[0]; f[1] = a[1]; f[2] = a[2]; f[3] = a[3]; f[4] = b[0]; f[5] = b[1]; f[6] = b[2]; f[7] = b[3]; }

__device__ __forceinline__ void p0_transpose_item(const float* W, int K, int N, bf16* WT, int drow0, LAS float* scr, int k0, int n0, int lane, const float* gain = nullptr) {
    f32x4 w[8]; float gk[8];
#pragma unroll
    for (int i = 0; i < 8; ++i) { const int kk = 8 * i + (lane >> 3); w[i] = P0_LD((const GAS f32x4*)(W + (size_t)(k0 + kk) * N + n0 + 4 * (lane & 7))); gk[i] = gain ? gain[k0 + kk] : 1.0f; }
#pragma unroll
    for (int i = 0; i < 8; ++i) { const int kk = 8 * i + (lane >> 3); LAS float* d = scr + kk * 33 + 4 * (lane & 7); d[0] = w[i].x * gk[i]; d[1] = w[i].y * gk[i]; d[2] = w[i].z * gk[i]; d[3] = w[i].w * gk[i]; }
    LDS_WAIT(); asm volatile("" ::: "memory");
    const int c = lane & 7;
#pragma unroll
    for (int j = 0; j < 4; ++j) { const int n = (lane >> 3) + 8 * j; const LAS float* s = scr + (8 * c) * 33 + n;
        v4u o; o.x = cvtpk(s[0 * 33], s[1 * 33]); o.y = cvtpk(s[2 * 33], s[3 * 33]); o.z = cvtpk(s[4 * 33], s[5 * 33]); o.w = cvtpk(s[6 * 33], s[7 * 33]);
        *(GAS v4u*)(WT + (size_t)(drow0 + n) * K + k0 + 8 * c) = o; }
    LDS_WAIT(); asm volatile("" ::: "memory");
}
__device__ __forceinline__ void p0_transpose_item_f8(const float* W, int K, int N, unsigned char* W8, int drow0, LAS float* scr, int k0, int n0, int lane, const float* gain, float scale) {
    f32x4 w[8]; float gk[8];
#pragma unroll
    for (int i = 0; i < 8; ++i) { const int kk = 8 * i + (lane >> 3); w[i] = P0_LD((const GAS f32x4*)(W + (size_t)(k0 + kk) * N + n0 + 4 * (lane & 7))); gk[i] = (gain ? gain[k0 + kk] : 1.0f) * scale; }
#pragma unroll
    for (int i = 0; i < 8; ++i) { const int kk = 8 * i + (lane >> 3); LAS float* d = scr + kk * 33 + 4 * (lane & 7); d[0] = w[i].x * gk[i]; d[1] = w[i].y * gk[i]; d[2] = w[i].z * gk[i]; d[3] = w[i].w * gk[i]; }
    LDS_WAIT(); asm volatile("" ::: "memory");
    const int c = lane & 7;
#pragma unroll
    for (int j = 0; j < 4; ++j) { const int n = (lane >> 3) + 8 * j; const LAS float* s = scr + (8 * c) * 33 + n;
        const unsigned lo = pg8::pack4_f8(s[0 * 33], s[1 * 33], s[2 * 33], s[3 * 33]), hi = pg8::pack4_f8(s[4 * 33], s[5 * 33], s[6 * 33], s[7 * 33]);
        *(GAS unsigned long long*)(W8 + (size_t)(drow0 + n) * K + k0 + 8 * c) = (unsigned long long)lo | ((unsigned long long)hi << 32); }
    LDS_WAIT(); asm volatile("" ::: "memory");
}
__device__ __forceinline__ int map_in_row(int n0) {
    if (n0 < 1536) return n0;
    const int w = n0 - 1536, sec = w >> 8, within = w & 255, hl = within >> 6, dim = within & 63;
    return 1536 + 256 * sec + 128 * (dim >> 5) + 32 * hl + (dim & 31);
}
__device__ __forceinline__ void rms_row(const float* srow, const float* g, bf16* drow, int lane) {
    const GAS f32x4* xr = (const GAS f32x4*)srow + lane;
    f32x4 v[4]; float s = 0.f;
#pragma unroll
    for (int j = 0; j < 4; ++j) { v[j] = xr[64 * j]; s += (v[j].x * v[j].x + v[j].y * v[j].y) + (v[j].z * v[j].z + v[j].w * v[j].w); }
    const float rstd = __builtin_amdgcn_rsqf(wave_sum(s) * (1.f / DM) + EPS);
    GAS unsigned long long* o8 = (GAS unsigned long long*)drow + lane;
#pragma unroll
    for (int j = 0; j < 4; ++j) { const f32x4 gg = ((const GAS f32x4*)g)[lane + 64 * j];
        o8[64 * j] = (unsigned long long)cvtpk(v[j].x * rstd * gg.x, v[j].y * rstd * gg.y) | ((unsigned long long)cvtpk(v[j].z * rstd * gg.z, v[j].w * rstd * gg.w) << 32); }
}
__device__ __forceinline__ int wave_pull(unsigned* ctr, int lane) {
    unsigned v = 0u;
    if (lane == 0) v = __hip_atomic_fetch_add(ctr, 1u, __ATOMIC_RELAXED, __HIP_MEMORY_SCOPE_AGENT);
    return (int)__builtin_amdgcn_readfirstlane((int)v);
}
__device__ __forceinline__ void rms_rows4(const float* src, const f32x4 (&gg)[4], bf16* dst, unsigned char* dst8, int m, int lane) {
    f32x4 v[4][4]; float s[4];
#pragma unroll
    for (int r = 0; r < 4; ++r)
#pragma unroll
        for (int j = 0; j < 4; ++j) v[r][j] = P0_LD((const GAS f32x4*)(src + (size_t)(m + r) * DM) + lane + 64 * j);
#pragma unroll
    for (int r = 0; r < 4; ++r) { s[r] = 0.f;
#pragma unroll
        for (int j = 0; j < 4; ++j) s[r] += (v[r][j].x * v[r][j].x + v[r][j].y * v[r][j].y) + (v[r][j].z * v[r][j].z + v[r][j].w * v[r][j].w); }
#define RMS4_STEP(O) _Pragma("unroll") for (int r = 0; r < 4; ++r) s[r] += lane_xor<O>(s[r]);
    RMS4_STEP(1) RMS4_STEP(2) RMS4_STEP(4) RMS4_STEP(8) RMS4_STEP(16) RMS4_STEP(32)
#undef RMS4_STEP
#pragma unroll
    for (int r = 0; r < 4; ++r) { const float rstd = __builtin_amdgcn_rsqf(s[r] * (1.f / DM) + EPS);
        GAS unsigned long long* o8 = (GAS unsigned long long*)(dst + (size_t)(m + r) * DM) + lane;
#pragma unroll
        for (int j = 0; j < 4; ++j) { const float h0 = v[r][j].x * rstd * gg[j].x, h1 = v[r][j].y * rstd * gg[j].y, h2 = v[r][j].z * rstd * gg[j].z, h3 = v[r][j].w * rstd * gg[j].w;
            o8[64 * j] = (unsigned long long)cvtpk(h0, h1) | ((unsigned long long)cvtpk(h2, h3) << 32);
            if (dst8) ((GAS unsigned*)(dst8 + (size_t)(m + r) * DM))[lane + 64 * j] = pg8::pack4_f8(h0, h1, h2, h3); } }
}
__device__ __forceinline__ void rms_rows(const float* src, const float* g, bf16* dst, unsigned char* dst8, int gw, int NGW, int lane, int mend, unsigned* pool) {
    f32x4 gg[4];
#pragma unroll
    for (int j = 0; j < 4; ++j) gg[j] = ((const GAS f32x4*)g)[lane + 64 * j];
    for (int m = gw * 4; m < mend; m += NGW * 4) rms_rows4(src, gg, dst, dst8, m, lane);
    if (pool) {
        for (;;) { const int m = mend + 16 * wave_pull(pool, lane); if (m >= MROWS) break;
            for (int sub = 0; sub < 4; ++sub) rms_rows4(src, gg, dst, dst8, m + 4 * sub, lane); }
    }
}

namespace att {
typedef float f32x16 __attribute__((ext_vector_type(16)));
typedef short s16x4 __attribute__((ext_vector_type(4)));
typedef short v4i16_t __attribute__((ext_vector_type(4)));
__device__ __forceinline__ constexpr int cr(int r) { return (r & 3) + 8 * (r >> 2); }
__device__ __forceinline__ s16x4 vtr(LAS const unsigned char* p) { return __builtin_bit_cast(s16x4, __builtin_amdgcn_ds_read_tr16_b64_v4i16((LAS v4i16_t*)p)); }

__device__ __forceinline__ void bias_init(f32x16& s, float lt, float cb) {
    const float c8 = 8.0f * cb;
#pragma unroll
    for (int g = 0; g < 4; ++g) { const float b0 = (g == 0) ? lt : s[4 * (g - 1)] + c8; s[4 * g] = b0; s[4 * g + 1] = b0 + cb; s[4 * g + 2] = s[4 * g + 1] + cb; s[4 * g + 3] = s[4 * g + 2] + cb; }
}
constexpr int K_OFF = 0, V_OFF = 49152, O_OFF = 98304;
struct UnitP { int b, h, d, r, blk, branch; float cb; int lq0; };
__device__ __forceinline__ UnitP unit_params(int u) {
    UnitP p; const int bh = u / 96, u96 = u % 96, within = u96 & 31; p.branch = u96 >> 5;
    p.d = 1 << (2 * p.branch); const int nblk = 32 >> (2 * p.branch); p.r = within / nblk; p.blk = within % nblk; p.b = bh >> 3; p.h = bh & 7;
    p.cb = __builtin_amdgcn_exp2f(-(float)(p.h + 1)) * (float)p.d * LOG2E; p.lq0 = p.blk * 256; return p;
}
template <int NIT> struct StageT { v4u k[NIT], v[NIT]; };
typedef StageT<6> Stage;
template <int NIT, int NTH> __device__ __forceinline__ void stage_load(StageT<NIT>& st, const bf16* Qg, const bf16* Kg, const bf16* Vg, const UnitP& p, int tid, int wave, int lane) {
    const size_t hb = (size_t)(p.b * NHEAD + p.h) * SEQ * HD; const bf16* Kh = Kg + hb; const bf16* Vh = Vg + hb; (void)Qg; (void)wave;
    const int lbase = p.lq0 - 128;
#pragma unroll
    for (int it = 0; it < NIT; ++it) { const int idx = tid + NTH * it, row = idx >> 3, c = idx & 7; int l = lbase + row; l = l < 0 ? 0 : l;
        const size_t off = (size_t)(p.r + p.d * l) * HD + 8 * c; st.k[it] = *(const GAS v4u*)(Kh + off); st.v[it] = *(const GAS v4u*)(Vh + off); }
}
__device__ __forceinline__ const bf16* q_frag_ptr(const bf16* Qg, const UnitP& p, int wave, int lane) {
    const size_t hb = (size_t)(p.b * NHEAD + p.h) * SEQ * HD; const int pq = p.r + p.d * (p.lq0 + 32 * wave + (lane & 31));
    return Qg + hb + (size_t)pq * HD + 8 * (lane >> 5);
}
template <int NIT, int NTH, int VOFF> __device__ __forceinline__ void stage_write(const StageT<NIT>& st, LAS unsigned char* L, int tid) {
#pragma unroll
    for (int it = 0; it < NIT; ++it) { const int idx = tid + NTH * it, row = idx >> 3, c = idx & 7;
        *(LAS v4u*)(L + K_OFF + row * 128 + ((c ^ (row & 7)) << 4)) = st.k[it];
        *(LAS v4u*)(L + VOFF + ((row >> 4) * 2 + (c >> 2)) * 1024 + (row & 15) * 64 + (c & 3) * 16) = st.v[it]; }
}
template <int VOFF, int NPW = 8> __device__ __forceinline__ void stage_dma(LAS unsigned char* IMG, const bf16* Kg, const bf16* Vg, const UnitP& p, int w4, int lane) {
    const size_t hb = (size_t)(p.b * NHEAD + p.h) * SEQ * HD; const bf16* Kh = Kg + hb; const bf16* Vh = Vg + hb;
    const int lbase = p.lq0 - 128;
    const int kc = (lane & 7) ^ (lane >> 3);
#pragma unroll
    for (int i = 0; i < NPW; ++i) { const int piece = w4 * NPW + i, row = 8 * piece + (lane >> 3); int l = lbase + row; l = l < 0 ? 0 : l;
        __builtin_amdgcn_global_load_lds((const unsigned*)(Kh + (size_t)(p.r + p.d * l) * HD + 8 * kc), (LAS unsigned*)(IMG + K_OFF + piece * 1024), 16, 0, 0); }
#pragma unroll
    for (int i = 0; i < NPW; ++i) { const int piece = w4 * NPW + i, row = 16 * (piece >> 1) + (lane >> 2), c = 4 * (piece & 1) + (lane & 3); int l = lbase + row; l = l < 0 ? 0 : l;
        __builtin_amdgcn_global_load_lds((const unsigned*)(Vh + (size_t)(p.r + p.d * l) * HD + 8 * c), (LAS unsigned*)(IMG + VOFF + piece * 1024), 16, 0, 0); }
}
template <int VOFF, bool O2K> __device__ __forceinline__ void compute_tile(LAS unsigned char* L, LAS unsigned char* ostage, bf16x8 (&qf)[4], const bf16* qnext, const UnitP& p, bf16* OPb, float* LPb, float negM, int wave, int lane) {
    const int r32 = lane & 31, hi = lane >> 5;
    const int l0 = p.lq0 + 32 * wave, d = p.d, r = p.r; const float cb = p.cb;
    const int pq = r + d * (l0 + r32);
    const int kb0 = l0 >= 128 ? 0 : ((128 - l0) >> 5);
    f32x16 o0, o1;
#pragma unroll
    for (int i = 0; i < 16; ++i) { o0[i] = 0.f; o1[i] = 0.f; }
    float lsum = 0.f;
    const int i4 = r32 - 4 * hi;
    const int laneoff = ((lane >> 4) & 1) * 32 + (lane & 3) * 8 + (4 * hi + ((lane & 15) >> 2)) * 64;
    bf16x8 kf[4];
    LAS const unsigned char* kbase = L + K_OFF + (32 * wave + r32) * 128;
    const int ksw = r32 & 7;
#if ATT_PIPE
    {
#pragma unroll
        for (int s = 0; s < 4; ++s) kf[s] = *(LAS const bf16x8*)(kbase + (((2 * s + hi) ^ ksw) << 4));
        f32x16 sacc;
        { const float lt = (kb0 == 0) ? negM - cb * (float)(128 + r32 - 4 * hi) : -INFINITY;
#if ATT_BIAS_ADD
          bias_init(sacc, lt, cb);
#else
#pragma unroll
          for (int i = 0; i < 16; ++i) sacc[i] = __builtin_fmaf(cb, (float)cr(i), lt);
#endif
#pragma unroll
          for (int s = 0; s < 4; ++s) sacc = __builtin_amdgcn_mfma_f32_32x32x16_bf16(kf[s], qf[s], sacc, 0, 0, 0); }
#pragma unroll
        for (int kb = 0; kb < 5; ++kb) {
            f32x16 snext;
            if (kb < 4) {
#pragma unroll
                for (int s = 0; s < 4; ++s) kf[s] = *(LAS const bf16x8*)(kbase + (kb + 1) * 4096 + (((2 * s + hi) ^ ksw) << 4));
                const float lt = (kb + 1 >= kb0) ? negM - cb * (float)(128 + r32 - 32 * (kb + 1) - 4 * hi) : -INFINITY;
#if ATT_BIAS_ADD
                bias_init(snext, lt, cb);
#else
#pragma unroll
                for (int i = 0; i < 16; ++i) snext[i] = __builtin_fmaf(cb, (float)cr(i), lt);
#endif
#pragma unroll
                for (int s = 0; s < 4; ++s) snext = __builtin_amdgcn_mfma_f32_32x32x16_bf16(kf[s], qf[s], snext, 0, 0, 0);
                if (kb == 3 && qnext) {
#pragma unroll
                    for (int s = 0; s < 4; ++s) qf[s] = *(const GAS bf16x8*)(qnext + 16 * s);
                }
            }
            __builtin_amdgcn_sched_barrier(0);
            float pe[16];
#pragma unroll
            for (int i = 0; i < 16; ++i) pe[i] = __builtin_amdgcn_exp2f(sacc[i]);
            if (kb == 0) {
#pragma unroll
                for (int i = 0; i < 16; ++i) pe[i] = (cr(i) >= i4) ? pe[i] : 0.f;
            }
            if (kb == 4) {
#pragma unroll
                for (int i = 0; i < 16; ++i) pe[i] = (cr(i) <= i4) ? pe[i] : 0.f;
            }
            float ps = 0.f;
#pragma unroll
            for (int i = 0; i < 16; ++i) ps += pe[i];
            lsum += ps;
            v4u pw0, pw1;
            pw0.x = cvtpk(pe[0], pe[1]); pw0.y = cvtpk(pe[2], pe[3]); pw0.z = cvtpk(pe[4], pe[5]); pw0.w = cvtpk(pe[6], pe[7]);
            pw1.x = cvtpk(pe[8], pe[9]); pw1.y = cvtpk(pe[10], pe[11]); pw1.z = cvtpk(pe[12], pe[13]); pw1.w = cvtpk(pe[14], pe[15]);
            const bf16x8 pa0 = __builtin_bit_cast(bf16x8, pw0), pa1 = __builtin_bit_cast(bf16x8, pw1);
            LAS const unsigned char* vb = L + VOFF + (wave + kb) * 4096 + laneoff;
#pragma unroll
            for (int d0 = 0; d0 < 2; ++d0) {
                const s16x4 a_lo = vtr(vb + d0 * 1024), a_hi = vtr(vb + d0 * 1024 + 512), b_lo = vtr(vb + 2048 + d0 * 1024), b_hi = vtr(vb + 2048 + d0 * 1024 + 512);
                const bf16x8 v0 = (bf16x8){a_lo[0], a_lo[1], a_lo[2], a_lo[3], a_hi[0], a_hi[1], a_hi[2], a_hi[3]};
                const bf16x8 v1 = (bf16x8){b_lo[0], b_lo[1], b_lo[2], b_lo[3], b_hi[0], b_hi[1], b_hi[2], b_hi[3]};
                if (d0 == 0) { o0 = __builtin_amdgcn_mfma_f32_32x32x16_bf16(pa0, v0, o0, 0, 0, 0); o0 = __builtin_amdgcn_mfma_f32_32x32x16_bf16(pa1, v1, o0, 0, 0, 0); }
                else         { o1 = __builtin_amdgcn_mfma_f32_32x32x16_bf16(pa0, v0, o1, 0, 0, 0); o1 = __builtin_amdgcn_mfma_f32_32x32x16_bf16(pa1, v1, o1, 0, 0, 0); }
            }
            if (kb < 4) sacc = snext;
        }
    }
#else
    {
#pragma unroll
    for (int kb = 0; kb < 5; ++kb) if (kb >= kb0) {
        if (kb == kb0) {
#pragma unroll
            for (int s = 0; s < 4; ++s) kf[s] = *(LAS const bf16x8*)(kbase + kb * 4096 + (((2 * s + hi) ^ ksw) << 4));
        }
        const float lt = negM - cb * (float)(128 + r32 - 32 * kb - 4 * hi);
        f32x16 sacc;
#if ATT_BIAS_ADD
        bias_init(sacc, lt, cb);
#else
#pragma unroll
        for (int i = 0; i < 16; ++i) sacc[i] = __builtin_fmaf(cb, (float)cr(i), lt);
#endif
#if ATT_PRIO == 2
        __builtin_amdgcn_s_setprio(1);
#endif
#pragma unroll
        for (int s = 0; s < 4; ++s) sacc = __builtin_amdgcn_mfma_f32_32x32x16_bf16(kf[s], qf[s], sacc, 0, 0, 0);
#if ATT_PRIO == 2
        __builtin_amdgcn_s_setprio(0);
#endif
        if (kb < 4) {
#pragma unroll
            for (int s = 0; s < 4; ++s) kf[s] = *(LAS const bf16x8*)(kbase + (kb + 1) * 4096 + (((2 * s + hi) ^ ksw) << 4));
        } else if (qnext) {
#pragma unroll
            for (int s = 0; s < 4; ++s) qf[s] = *(const GAS bf16x8*)(qnext + 16 * s);
        }
#if ATT_VEARLY
        s16x4 vq_[2][4];
        { LAS const unsigned char* vb_ = L + VOFF + (wave + kb) * 4096 + laneoff;
#pragma unroll
          for (int d0 = 0; d0 < 2; ++d0) { vq_[d0][0] = vtr(vb_ + d0 * 1024); vq_[d0][1] = vtr(vb_ + d0 * 1024 + 512); vq_[d0][2] = vtr(vb_ + 2048 + d0 * 1024); vq_[d0][3] = vtr(vb_ + 2048 + d0 * 1024 + 512); }
          __builtin_amdgcn_sched_barrier(0); }
#endif
        float pe[16];
#pragma unroll
        for (int i = 0; i < 16; ++i) pe[i] = __builtin_amdgcn_exp2f(sacc[i]);
        if (kb == 0) {
#pragma unroll
            for (int i = 0; i < 16; ++i) pe[i] = (cr(i) >= i4) ? pe[i] : 0.f;
        }
        if (kb == 4) {
#pragma unroll
            for (int i = 0; i < 16; ++i) pe[i] = (cr(i) <= i4) ? pe[i] : 0.f;
        }
        float ps = 0.f;
#pragma unroll
        for (int i = 0; i < 16; ++i) ps += pe[i];
        lsum += ps;
        v4u pw0, pw1;
        pw0.x = cvtpk(pe[0], pe[1]); pw0.y = cvtpk(pe[2], pe[3]); pw0.z = cvtpk(pe[4], pe[5]); pw0.w = cvtpk(pe[6], pe[7]);
        pw1.x = cvtpk(pe[8], pe[9]); pw1.y = cvtpk(pe[10], pe[11]); pw1.z = cvtpk(pe[12], pe[13]); pw1.w = cvtpk(pe[14], pe[15]);
        const bf16x8 pa0 = __builtin_bit_cast(bf16x8, pw0), pa1 = __builtin_bit_cast(bf16x8, pw1);
        LAS const unsigned char* vb = L + VOFF + (wave + kb) * 4096 + laneoff;
#pragma unroll
        for (int d0 = 0; d0 < 2; ++d0) {
#if ATT_VEARLY
            const s16x4 a_lo = vq_[d0][0], a_hi = vq_[d0][1], b_lo = vq_[d0][2], b_hi = vq_[d0][3]; (void)vb;
#else
            const s16x4 a_lo = vtr(vb + d0 * 1024), a_hi = vtr(vb + d0 * 1024 + 512), b_lo = vtr(vb + 2048 + d0 * 1024), b_hi = vtr(vb + 2048 + d0 * 1024 + 512);
#endif
            const bf16x8 v0 = (bf16x8){a_lo[0], a_lo[1], a_lo[2], a_lo[3], a_hi[0], a_hi[1], a_hi[2], a_hi[3]};
            const bf16x8 v1 = (bf16x8){b_lo[0], b_lo[1], b_lo[2], b_lo[3], b_hi[0], b_hi[1], b_hi[2], b_hi[3]};
            if (d0 == 0) { o0 = __builtin_amdgcn_mfma_f32_32x32x16_bf16(pa0, v0, o0, 0, 0, 0); o0 = __builtin_amdgcn_mfma_f32_32x32x16_bf16(pa1, v1, o0, 0, 0, 0); }
            else         { o1 = __builtin_amdgcn_mfma_f32_32x32x16_bf16(pa0, v0, o1, 0, 0, 0); o1 = __builtin_amdgcn_mfma_f32_32x32x16_bf16(pa1, v1, o1, 0, 0, 0); }
        }
    }
    }
#endif
    lsum += lane_xor<32>(lsum);
    if (hi == 0) LPb[(size_t)(p.b * SEQ + pq) * NHEAD + p.h] = lsum;
    LAS unsigned short* stg = (LAS unsigned short*)ostage;
    if constexpr (!O2K) {
#pragma unroll
    for (int i = 0; i < 16; ++i) { const int q = cr(i) + 4 * hi;
        stg[q * 64 + r32] = (unsigned short)(cvtpk(o0[i], o0[i]) & 0xffffu); stg[q * 64 + 32 + r32] = (unsigned short)(cvtpk(o1[i], o1[i]) & 0xffffu); }
    LDS_WAIT(); asm volatile("" ::: "memory");
#pragma unroll
    for (int it = 0; it < 4; ++it) { const int row = it * 8 + (lane >> 3), ch = lane & 7;
        const v4u v = *(LAS const v4u*)(stg + row * 64 + ch * 8);
        *(GAS v4u*)(OPb + (size_t)(p.b * SEQ + r + d * (l0 + row)) * ATTW + p.h * HD + ch * 8) = v; }
    LDS_WAIT(); asm volatile("" ::: "memory");
    } else {
#pragma unroll
    for (int d0 = 0; d0 < 2; ++d0) {
#pragma unroll
        for (int i = 0; i < 16; ++i) { const int q = cr(i) + 4 * hi; const float ov = d0 ? o1[i] : o0[i]; stg[q * 32 + r32] = (unsigned short)(cvtpk(ov, ov) & 0xffffu); }
        LDS_WAIT(); asm volatile("" ::: "memory");
#pragma unroll
        for (int it = 0; it < 2; ++it) { const int row = it * 16 + (lane >> 2), ch = lane & 3;
            const v4u v = *(LAS const v4u*)(stg + row * 32 + ch * 8);
            *(GAS v4u*)(OPb + (size_t)(p.b * SEQ + r + d * (l0 + row)) * ATTW + p.h * HD + d0 * 32 + ch * 8) = v; }
        LDS_WAIT(); asm volatile("" ::: "memory");
    }
    }
}
}

#ifndef DUP_MASK
#define DUP_MASK 0
#endif
#ifndef ATT_PIPE
#define ATT_PIPE 0
#endif
#ifndef ATT_SPLIT
#define ATT_SPLIT 0
#endif
#ifndef ATT_DMA
#define ATT_DMA 0
#endif
#ifndef ATT_SERIAL
#define ATT_SERIAL 0
#endif
#ifndef ATT_REGSTAGE
#define ATT_REGSTAGE 0
#endif
#ifndef ATT_O2K
#define ATT_O2K 0
#endif
#define PG8_CALL(EPI, SCHED) pg8::gemm_phase<EPI, SCHED, true, PG8_SP2>(L, g, S, E, wave)
#ifndef ATT_BIAS_ADD
#define ATT_BIAS_ADD 0
#endif
#ifndef AUXA_P8
#define AUXA_P8 0
#endif
#ifndef PANEL_SEAM
#define PANEL_SEAM 0
#endif
#ifndef ATT_STAGGER
#define ATT_STAGGER 0
#endif
#ifndef CONV_UNROLL
#define CONV_UNROLL 1
#endif
#ifndef MERGE_UNROLL
#define MERGE_UNROLL 8
#endif
#ifndef MIX_EARLY
#define MIX_EARLY 1
#endif
#ifndef PP_IN_P8
#define PP_IN_P8 1
#endif
#ifndef P0_STATIC_ROWS
#define P0_STATIC_ROWS MROWS
#endif
#ifndef ATT_PRIO
#define ATT_PRIO 1
#endif
#ifndef WGM_P1
#define WGM_P1 4
#endif
#ifndef WGM_P4
#define WGM_P4 4
#endif
#ifndef WGM_P6
#define WGM_P6 4
#endif
#ifndef WGM_P8
#define WGM_P8 4
#endif
#ifndef WGM_P10
#define WGM_P10 4
#endif
#ifndef PROBE_AMP
#define PROBE_AMP 4
#endif
#ifndef PROBE_BLK
#define PROBE_BLK 0
#endif
#ifdef PROBE_EPI
#define PROBE_EPI_SET(n) if ((n) == PROBE_EPI) g.tacc = (unsigned*)(ws_ + WS_CTL) + 8;
#else
#define PROBE_EPI_SET(n)
#endif
#ifndef PG8_SP2
#define PG8_SP2 true
#endif
struct Args { const float* in[20]; float* out; unsigned char* ws; };
enum { I_X = 0, I_P, I_GMIX, I_WIN, I_CONVW, I_CONVB, I_QG, I_KG, I_GOC, I_GOA, I_WOUT, I_GFFN, I_WGATE, I_WUP, I_FCW, I_FCB, I_WDOWN, I_GPLE, I_WPG, I_WPP };

#define PHASE_PTRS KARG_DECL unsigned char* const ws_ = ARG_WS(); float* const out = ARG_OUT(); (void)out; \
    bf16* const WIN = (bf16*)(ws_ + WS_WIN); bf16* const WOUT = (bf16*)(ws_ + WS_WOUT); bf16* const WGU = (bf16*)(ws_ + WS_WGU); bf16* const WDN = (bf16*)(ws_ + WS_WDN); bf16* const WPG = (bf16*)(ws_ + WS_WPG); bf16* const WPP = (bf16*)(ws_ + WS_WPP); \
    bf16* const HB = (bf16*)(ws_ + WS_H); bf16* const PB = (bf16*)(ws_ + WS_PB); bf16* const ZC = (bf16*)(ws_ + WS_ZC); bf16* const QB = (bf16*)(ws_ + WS_Q); bf16* const KB = (bf16*)(ws_ + WS_K); bf16* const VB = (bf16*)(ws_ + WS_V); \
    bf16* const OP = (bf16*)(ws_ + WS_OP); float* const LP = (float*)(ws_ + WS_LP); bf16* const YB = (bf16*)(ws_ + WS_Y); bf16* const UB = (bf16*)(ws_ + WS_U); float* const TOPG = (float*)(ws_ + WS_TOPG); float* const BOTG = (float*)(ws_ + WS_BOTG); float* const TOPU = (float*)(ws_ + WS_TOPU); (void)TOPG; (void)BOTG; (void)TOPU; bf16* const PP = (bf16*)(ws_ + WS_PP); float* const SSB = (float*)(ws_ + WS_SS); (void)SSB; bf16* const X2B = (bf16*)(ws_ + WS_X2); (void)X2B; unsigned char* const X2F8 = ws_ + WS_X2F8; (void)X2F8; \
    (void)WIN; (void)WOUT; (void)WGU; (void)WDN; (void)WPG; (void)WPP; (void)HB; (void)PB; (void)ZC; (void)QB; (void)KB; (void)VB; (void)OP; (void)LP; (void)YB; (void)UB; (void)PP;
#define CAS __attribute__((address_space(4)))
#define ARG_IN(i) (*(const float* const CAS*)(ka_ + 8 * (i)))
#define ARG_OUT() (*(float* const CAS*)(ka_ + 8 * 20))
#define ARG_WS() (*(unsigned char* const CAS*)(ka_ + 8 * 21))
#define KARG_DECL const CAS unsigned char* ka_ = (const CAS unsigned char*)__builtin_amdgcn_kernarg_segment_ptr(); asm volatile("" : "+s"(ka_));
__device__ __forceinline__ void phase_stagger(int g, int ng, unsigned ticks) {
    if (g > 0) { const unsigned long long t0 = __builtin_amdgcn_s_memrealtime(); const unsigned long long wait = (unsigned long long)ticks * (unsigned)g / (unsigned)ng;
        while (__builtin_amdgcn_s_memrealtime() - t0 < wait) __builtin_amdgcn_s_sleep(16); }
}
#ifndef STAG6
#define STAG6 1000
#endif
#ifndef STAG6_NG
#define STAG6_NG 2
#endif
__device__ __forceinline__ void phase0(LAS unsigned char* L, const int, const int wave, const int G, const int bx, const int vcu, const int gw, const int NGW) {
    int tix_ = REG_DIET ? 64 * wave + hw_lane() : (int)threadIdx.x; if (REG_DIET) asm volatile("" : "+v"(tix_)); const int lane = tix_ & 63;
    { PHASE_PTRS
    {
        LAS float* scr = (LAS float*)(L + wave * 16384);
        constexpr int I_IN = 16 * 96, I_OUT = 16 * 32, I_GT = 16 * 88, I_DN = 44 * 32, I_PG = 16 * 32, I_PPJ = 4 * 32;
        constexpr int NITEMS = I_IN + I_OUT + 2 * I_GT + I_DN + I_PG + I_PPJ;
        for (int it = wave * G + vcu; it < NITEMS; it += NGW) {
            int r = it;
            if (r < I_IN) { const int kb = r / 96, n0 = 32 * (r % 96);
                if (P1_F8 && n0 >= 1536) p0_transpose_item_f8(ARG_IN(I_WIN), DM, INCOLS, ws_ + WS_W8IN, map_in_row(n0) - 1536, scr, 64 * kb, n0, lane, nullptr, W8_SCALE);
                else p0_transpose_item(ARG_IN(I_WIN), DM, INCOLS, WIN, map_in_row(n0), scr, 64 * kb, n0, lane);
                continue; } r -= I_IN;
            if (r < I_OUT) { const int kb = r / 32, n0 = 32 * (r % 32); p0_transpose_item(ARG_IN(I_WOUT), DM, DM, WOUT, n0, scr, 64 * kb, n0, lane); continue; } r -= I_OUT;
            if (r < I_GT) { const int kb = r / 88, n0 = 32 * (r % 88); p0_transpose_item(ARG_IN(I_WGATE), DM, DFF, WGU, 256 * (n0 >> 7) + (n0 & 127), scr, 64 * kb, n0, lane, ARG_IN(I_GFFN)); continue; } r -= I_GT;
            if (r < I_GT) { const int kb = r / 88, n0 = 32 * (r % 88); p0_transpose_item(ARG_IN(I_WUP), DM, DFF, WGU, 256 * (n0 >> 7) + 128 + (n0 & 127), scr, 64 * kb, n0, lane, ARG_IN(I_GFFN)); continue; } r -= I_GT;
            if (r < I_DN) { const int kb = r / 32, n0 = 32 * (r % 32); p0_transpose_item(ARG_IN(I_WDOWN), DFF, DM, WDN, n0, scr, 64 * kb, n0, lane); continue; } r -= I_DN;
            if (r < I_PG) { const int kb = r / 32, n0 = 32 * (r % 32); if (P10_F8) p0_transpose_item_f8(ARG_IN(I_WPG), DM, DM, (unsigned char*)WPG, n0, scr, 64 * kb, n0, lane, ARG_IN(I_GPLE), W8_SCALE); else p0_transpose_item(ARG_IN(I_WPG), DM, DM, WPG, n0, scr, 64 * kb, n0, lane, ARG_IN(I_GPLE)); continue; } r -= I_PG;
            { const int kb = r / 32, n0 = 32 * (r % 32); p0_transpose_item(ARG_IN(I_WPP), PLED, DM, WPP, n0, scr, 64 * kb, n0, lane); }
        }
        rms_rows(ARG_IN(I_X), ARG_IN(I_GMIX), HB, P1_F8 ? ws_ + WS_H8 : nullptr, gw, NGW, lane, P0_STATIC_ROWS, (P0_STATIC_ROWS < MROWS) ? (unsigned*)(ws_ + WS_CTL) + CW_Q0 : nullptr);
        for (int m = gw * 8; m < MROWS; m += NGW * 8) {
            f32x4 v[8];
#pragma unroll
            for (int r = 0; r < 8; ++r) v[r] = P0_LD((const GAS f32x4*)(ARG_IN(I_P) + (size_t)(m + r) * PLED) + lane);
#pragma unroll
            for (int r = 0; r < 8; ++r) ((GAS unsigned long long*)(PB + (size_t)(m + r) * PLED))[lane] = (unsigned long long)cvtpk(v[r].x, v[r].y) | ((unsigned long long)cvtpk(v[r].z, v[r].w) << 32);
        }
    }
    }
}
__device__ __forceinline__ void phase1(LAS unsigned char* L, const int, const int wave, const int G, const int bx, const int vcu, const int gw, const int NGW) {
    int tix_ = REG_DIET ? 64 * wave + hw_lane() : (int)threadIdx.x; if (REG_DIET) asm volatile("" : "+v"(tix_)); const int lane = tix_ & 63;
    { PHASE_PTRS
    {
#if P1_F8
        int kdim_ = DM / 2; asm volatile("" : "+s"(kdim_)); pg8::Gemm g{(const bf16*)(ws_ + WS_H8), (const bf16*)(ws_ + WS_W8IN), MROWS, INCOLS / 2, kdim_}; PROBE_EPI_SET(1) pg8::StaticOrder S; S.init(MROWS, INCOLS / 2, G, bx, WGM_P1);
        pg8::EpiInProj<2> E{ZC, QB, KB, VB, ARG_IN(I_QG), ARG_IN(I_KG), 0.125f * LOG2E, EPS, W8_SCALE};
        pg8::gemm_phase<pg8::EpiInProj<2>, pg8::StaticOrder, true, PG8_SP2, 0, 0, 0, true>(L, g, S, E, wave);
#else
        int kdim_ = DM; asm volatile("" : "+s"(kdim_)); pg8::Gemm g{HB, WIN, MROWS, INCOLS, kdim_}; PROBE_EPI_SET(1) pg8::StaticOrder S; S.init(MROWS, INCOLS, G, bx, WGM_P1);
        pg8::EpiInProj<0> E{ZC, QB, KB, VB, ARG_IN(I_QG), ARG_IN(I_KG), 0.125f * LOG2E, EPS, 1.0f};
        PG8_CALL(pg8::EpiInProj<0>, pg8::StaticOrder);
#endif
    }
    }
#if P1_F8
    { PHASE_PTRS
        int kdim_ = DM; asm volatile("" : "+s"(kdim_)); pg8::Gemm g{HB, WIN, MROWS, INCOLS / 2, kdim_}; pg8::StaticOrder S; S.init(MROWS, INCOLS / 2, G, bx, WGM_P1);
        pg8::EpiInProj<1> E{ZC, QB, KB, VB, ARG_IN(I_QG), ARG_IN(I_KG), 0.125f * LOG2E, EPS, 1.0f};
        PG8_CALL(pg8::EpiInProj<1>, pg8::StaticOrder);
    }
#endif
}
__device__ __forceinline__ void mixer_conv_part(const int lane, const int gw, const int NGW) {
    PHASE_PTRS
    const int c = 8 * lane;
    float cw0[8], cw1[8], cw2[8], cbv[8], gc[8];
    load8f(ARG_IN(I_CONVW) + c, cw0); load8f(ARG_IN(I_CONVW) + CONVW + c, cw1); load8f(ARG_IN(I_CONVW) + 2 * CONVW + c, cw2);
    load8f(ARG_IN(I_CONVB) + c, cbv); load8f(ARG_IN(I_GOC) + c, gc);
    for (int ch = gw; ch < MROWS / 16; ch += NGW) {
        const int m0 = ch * 16;
        float u1[8], u2[8];
        if ((m0 & (SEQ - 1)) == 0) {
#pragma unroll
            for (int j = 0; j < 8; ++j) { u1[j] = 0.f; u2[j] = 0.f; }
        } else {
            float a[8], bb[8];
            unpack8(MIX_LD((const GAS v4u*)(ZC + (size_t)(m0 - 1) * 1536 + 512 + c)), a); unpack8(MIX_LD((const GAS v4u*)(ZC + (size_t)(m0 - 1) * 1536 + 1024 + c)), bb);
#pragma unroll
            for (int j = 0; j < 8; ++j) u1[j] = a[j] * bb[j];
            unpack8(MIX_LD((const GAS v4u*)(ZC + (size_t)(m0 - 2) * 1536 + 512 + c)), a); unpack8(MIX_LD((const GAS v4u*)(ZC + (size_t)(m0 - 2) * 1536 + 1024 + c)), bb);
#pragma unroll
            for (int j = 0; j < 8; ++j) u2[j] = a[j] * bb[j];
        }
#pragma unroll CONV_UNROLL
        for (int tt = 0; tt < 16; ++tt) {
            const size_t m = (size_t)(m0 + tt);
            float zb[8], zc[8], zx[8], y[8];
            unpack8(MIX_LD((const GAS v4u*)(ZC + m * 1536 + c)), zb); unpack8(MIX_LD((const GAS v4u*)(ZC + m * 1536 + 512 + c)), zc); unpack8(MIX_LD((const GAS v4u*)(ZC + m * 1536 + 1024 + c)), zx);
            float ss = 0.f;
#pragma unroll
            for (int j = 0; j < 8; ++j) { const float u0 = zc[j] * zx[j]; y[j] = zb[j] * (cw0[j] * u2[j] + cw1[j] * u1[j] + cw2[j] * u0 + cbv[j]); ss += y[j] * y[j]; u2[j] = u1[j]; u1[j] = u0; }
            const float rc = __builtin_amdgcn_rsqf(wave_sum(ss) * (1.f / CONVW) + EPS);
#pragma unroll
            for (int j = 0; j < 8; ++j) y[j] = y[j] * rc * gc[j];
            *(GAS v4u*)(YB + m * DM + c) = pack8f(y);
        }
    }
}
__device__ __forceinline__ void mixer_merge_part(const int lane, const int gw, const int NGW) {
    PHASE_PTRS
    const int c = 8 * lane;
    float ga[8];
    load8f(ARG_IN(I_GOA) + c, ga);
    for (int ch = gw; ch < MROWS / 16; ch += NGW) {
        const int m0 = ch * 16;
#pragma unroll 1
        for (int tb = 0; tb < 16; tb += MERGE_TB) {
            v4u r1[MERGE_TB], r2[MERGE_TB], r3[MERGE_TB]; float l1[MERGE_TB], l2[MERGE_TB], l3[MERGE_TB];
#pragma unroll
            for (int t = 0; t < MERGE_TB; ++t) { const size_t m = (size_t)(m0 + tb + t);
                r1[t] = MIX_LD((const GAS v4u*)(OP + m * ATTW + c)); r2[t] = MIX_LD((const GAS v4u*)(OP + ((size_t)MROWS + m) * ATTW + c)); r3[t] = MIX_LD((const GAS v4u*)(OP + ((size_t)2 * MROWS + m) * ATTW + c));
                l1[t] = LP[m * NHEAD + (lane >> 3)]; l2[t] = LP[((size_t)MROWS + m) * NHEAD + (lane >> 3)]; l3[t] = LP[((size_t)2 * MROWS + m) * NHEAD + (lane >> 3)]; }
            asm volatile("" ::: "memory");
#pragma unroll
            for (int t = 0; t < MERGE_TB; ++t) { const size_t m = (size_t)(m0 + tb + t);
                float o1[8], o2[8], o3[8], y[8];
                unpack8(r1[t], o1); unpack8(r2[t], o2); unpack8(r3[t], o3);
                const float lt = l1[t] + l2[t] + l3[t];
                const float rl = 1.0f / lt; float sa = 0.f;
#pragma unroll
                for (int j = 0; j < 8; ++j) { y[j] = (o1[j] + o2[j] + o3[j]) * rl; sa += y[j] * y[j]; }
                const float ra = __builtin_amdgcn_rsqf(wave_sum(sa) * (1.f / ATTW) + EPS);
#pragma unroll
                for (int j = 0; j < 8; ++j) y[j] = y[j] * ra * ga[j];
                *(GAS v4u*)(YB + m * DM + CONVW + c) = pack8f(y);
            }
        }
    }
}
__device__ __forceinline__ void phase2(LAS unsigned char* L, const int, const int wave, const int G, const int bx, const int vcu, const int gw, const int NGW) {
    int tix_ = REG_DIET ? 64 * wave + hw_lane() : (int)threadIdx.x; if (REG_DIET) asm volatile("" : "+v"(tix_)); const int lane = tix_ & 63;
    { PHASE_PTRS
    {
#if MIX_EARLY
        mixer_conv_part(lane, gw, NGW);
#endif
        const float mq = wave_max(fabsf(ARG_IN(I_QG)[lane])), mk = wave_max(fabsf(ARG_IN(I_KG)[lane]));
        const float negM = -8.0f * mq * mk * LOG2E;
        const int nper = 3072 / G, tid = tix_;
#define ATT_UNIT(i) ((G == 256) ? ((4 * (vcu >> 5) + (i) / 3) * 96 + ((i) % 3) * 32 + (vcu & 31)) : (vcu * nper + (i)))
#if ATT_SPLIT
        {
            const int g = wave >> 2, w4 = wave & 3;
            LAS unsigned char* IMG = L + g * 65536; LAS unsigned char* OST = L + 131072 + 4096 + wave * 2048;
            constexpr int VO = 32768;
            bf16x8 qf[4];
#define ATT_HU(j) att::UnitP pu_ = att::unit_params(ATT_UNIT(j)); pu_.lq0 += 128 * g;
            { ATT_HU(0) const bf16* q0 = att::q_frag_ptr(QB, pu_, w4, lane);
#pragma unroll
              for (int s = 0; s < 4; ++s) qf[s] = *(const GAS bf16x8*)(q0 + 16 * s);
#if ATT_REGSTAGE
              if (g == 0) { att::StageT<8> st_; att::stage_load<8, 256>(st_, QB, KB, VB, pu_, w4 * 64 + lane, w4, lane); att::stage_write<8, 256, VO>(st_, IMG, w4 * 64 + lane); }
#else
              if (g == 0) att::stage_dma<VO>(IMG, KB, VB, pu_, w4, lane);
#endif
            }
            asm volatile("s_waitcnt vmcnt(0) lgkmcnt(0)" ::: "memory"); __builtin_amdgcn_s_barrier(); asm volatile("" ::: "memory");
            for (int j = 0; j < nper; ++j) {
#pragma unroll
                for (int ph = 0; ph < 2; ++ph) {
#if ATT_SERIAL
                    if (g != ph) { const int jw = j + ph; if (jw < nper) { ATT_HU(jw) att::stage_dma<VO>(IMG, KB, VB, pu_, w4, lane); } asm volatile("s_waitcnt vmcnt(0)" ::: "memory"); }
                    __builtin_amdgcn_s_barrier(); asm volatile("" ::: "memory");
#endif
                    if (g == ph) {
                        const bf16* qnext = nullptr; if (j + 1 < nper) { ATT_HU(j + 1) qnext = att::q_frag_ptr(QB, pu_, w4, lane); }
                        ATT_HU(j)
                        __builtin_amdgcn_s_setprio(1);
                        att::compute_tile<VO, true>(IMG, OST, qf, qnext, pu_, OP + (size_t)pu_.branch * MROWS * ATTW, LP + (size_t)pu_.branch * MROWS * NHEAD, negM, w4, lane);
                        __builtin_amdgcn_s_setprio(0);
                        asm volatile("s_waitcnt lgkmcnt(0)" ::: "memory");
                    } else {
#if !ATT_SERIAL
                        const int jw = j + ph;
#if ATT_REGSTAGE
                        if (jw < nper) { ATT_HU(jw) att::StageT<8> st_; att::stage_load<8, 256>(st_, QB, KB, VB, pu_, w4 * 64 + lane, w4, lane); att::stage_write<8, 256, VO>(st_, IMG, w4 * 64 + lane); }
                        asm volatile("s_waitcnt vmcnt(0) lgkmcnt(0)" ::: "memory");
#else
                        if (jw < nper) { ATT_HU(jw) att::stage_dma<VO>(IMG, KB, VB, pu_, w4, lane); }
                        asm volatile("s_waitcnt vmcnt(0)" ::: "memory");
#endif
#endif
                    }
                    __builtin_amdgcn_s_barrier(); asm volatile("" ::: "memory");
                }
            }
#undef ATT_HU
        }
#else
#if ATT_PRIO == 1
        if (wave >= 4) __builtin_amdgcn_s_setprio(1);
#endif
        att::Stage st;
        { const att::UnitP p0 = att::unit_params(ATT_UNIT(0)); att::stage_load<6, 512>(st, QB, KB, VB, p0, tid, wave, lane); }
        bf16x8 qf[4];
        { const att::UnitP p0 = att::unit_params(ATT_UNIT(0)); const bf16* q0 = att::q_frag_ptr(QB, p0, wave, lane);
#pragma unroll
          for (int s = 0; s < 4; ++s) qf[s] = *(const GAS bf16x8*)(q0 + 16 * s); }
        for (int i = 0; i < nper; ++i) {
#if defined(PROBE_ATT) && PROBE_ATT == 2
            const unsigned long long tw0_ = __builtin_amdgcn_s_memrealtime();
#endif
#if ATT_DMA
            { const att::UnitP pd_ = att::unit_params(ATT_UNIT(i)); att::stage_dma<att::V_OFF, 6>(L, KB, VB, pd_, wave, lane); asm volatile("s_waitcnt vmcnt(0)" ::: "memory"); }
#else
            att::stage_write<6, 512, att::V_OFF>(st, L, tid);
#endif
            asm volatile("s_waitcnt lgkmcnt(0)" ::: "memory"); __builtin_amdgcn_s_barrier(); asm volatile("" ::: "memory");
#if defined(PROBE_ATT) && PROBE_ATT == 2
            if (bx == PROBE_BLK && tid == 0) __hip_atomic_fetch_add((unsigned*)(ws_ + WS_CTL) + 8, (unsigned)(__builtin_amdgcn_s_memrealtime() - tw0_), __ATOMIC_RELAXED, __HIP_MEMORY_SCOPE_AGENT);
#endif
            const bf16* qnext = nullptr;
#if defined(PROBE_ATT) && PROBE_ATT == 4
            const unsigned long long tl0_ = __builtin_amdgcn_s_memrealtime();
#endif
            __builtin_amdgcn_s_waitcnt(0x0F70);
            if (i + 1 < nper) { const att::UnitP pn = att::unit_params(ATT_UNIT(i + 1)); att::stage_load<6, 512>(st, QB, KB, VB, pn, tid, wave, lane); qnext = att::q_frag_ptr(QB, pn, wave, lane); }
            const att::UnitP p = att::unit_params(ATT_UNIT(i));
#if defined(PROBE_ATT) && PROBE_ATT == 4
            if (bx == PROBE_BLK && tid == 0) __hip_atomic_fetch_add((unsigned*)(ws_ + WS_CTL) + 8, (unsigned)(__builtin_amdgcn_s_memrealtime() - tl0_), __ATOMIC_RELAXED, __HIP_MEMORY_SCOPE_AGENT);
#endif
#if defined(PROBE_ATT) && PROBE_ATT == 1
            const unsigned long long ta0_ = __builtin_amdgcn_s_memrealtime();
#endif
#if ATT_STAGGER
            if (wave >= 4) __builtin_amdgcn_s_sleep(ATT_STAGGER);
#endif
            att::compute_tile<att::V_OFF, (ATT_O2K != 0)>(L, (ATT_O2K == 2) ? L + 131072 + 4096 + wave * 2048 : L + att::O_OFF + wave * 4096, qf, qnext, p, OP + (size_t)p.branch * MROWS * ATTW, LP + (size_t)p.branch * MROWS * NHEAD, negM, wave, lane);
#if defined(PROBE_ATT) && PROBE_ATT == 1
            if (bx == PROBE_BLK && tid == 0) __hip_atomic_fetch_add((unsigned*)(ws_ + WS_CTL) + 8, (unsigned)(__builtin_amdgcn_s_memrealtime() - ta0_), __ATOMIC_RELAXED, __HIP_MEMORY_SCOPE_AGENT);
#endif
#if defined(PROBE_ATT) && PROBE_ATT == 3
            const unsigned long long te0_ = __builtin_amdgcn_s_memrealtime();
#endif
            asm volatile("s_waitcnt lgkmcnt(0)" ::: "memory"); __builtin_amdgcn_s_barrier(); asm volatile("" ::: "memory");
#if defined(PROBE_ATT) && PROBE_ATT == 3
            if (bx == PROBE_BLK && tid == 0) __hip_atomic_fetch_add((unsigned*)(ws_ + WS_CTL) + 8, (unsigned)(__builtin_amdgcn_s_memrealtime() - te0_), __ATOMIC_RELAXED, __HIP_MEMORY_SCOPE_AGENT);
#endif
        }
#if ATT_PRIO == 1
        __builtin_amdgcn_s_setprio(0);
#endif
#endif
    }
    }
}
__device__ __forceinline__ void phase3(LAS unsigned char* L, const int, const int wave, const int G, const int bx, const int vcu, const int gw, const int NGW) {
    int tix_ = REG_DIET ? 64 * wave + hw_lane() : (int)threadIdx.x; if (REG_DIET) asm volatile("" : "+v"(tix_)); const int lane = tix_ & 63;
#if !MIX_EARLY
    mixer_conv_part(lane, gw, NGW);
#endif
    mixer_merge_part(lane, gw, NGW);
#if PANEL_SEAM
    if (G == 256) {
        asm volatile("s_waitcnt vmcnt(0)" ::: "memory"); __syncthreads();
        if (tix_ == 0) { KARG_DECL
            __builtin_amdgcn_fence(__ATOMIC_RELEASE, "agent"); asm volatile("s_waitcnt vmcnt(0)" ::: "memory");
            __hip_atomic_fetch_add((unsigned*)(ARG_WS() + WS_CTL) + CW_PAN + 16 * (vcu >> 1), 8u, __ATOMIC_RELAXED, __HIP_MEMORY_SCOPE_AGENT); }
    }
#endif
}
__device__ __forceinline__ void phase4(LAS unsigned char* L, const int, const int wave, const int G, const int bx, const int vcu, const int gw, const int NGW) {
    int tix_ = REG_DIET ? 64 * wave + hw_lane() : (int)threadIdx.x; if (REG_DIET) asm volatile("" : "+v"(tix_)); const int lane = tix_ & 63;
    for (int s_ = 0; s_ < (PP_IN_P8 ? 1 : 2); ++s_) {
        if (s_ == 0) { PHASE_PTRS
            int kdim_ = DM; asm volatile("" : "+s"(kdim_)); pg8::Gemm g{YB, WOUT, MROWS, DM, kdim_}; PROBE_EPI_SET(4)
            pg8::EpiResNorm<false> E{ARG_IN(I_X), HB, SSB, DM, (LAS float*)(L + XCH_OFF)};
#if PANEL_SEAM
            if (G == 256) { pg8::PanelOrder S; S.init(MROWS, DM, G, bx, WGM_P4); S.ready = (const unsigned*)(ws_ + WS_CTL) + CW_PAN; S.need = 16u;
                PG8_CALL(pg8::EpiResNorm<false>, pg8::PanelOrder); }
            else
#endif
            { pg8::StaticOrder S; S.init(MROWS, DM, G, bx, WGM_P4);
              PG8_CALL(pg8::EpiResNorm<false>, pg8::StaticOrder); }
        } else { PHASE_PTRS
            int kdim_ = PLED; asm volatile("" : "+s"(kdim_)); pg8::Gemm g{PB, WPP, MROWS, DM, kdim_}; PROBE_EPI_SET(4) pg8::StaticOrder S; S.init(MROWS, DM, G, bx, WGM_P4);
            pg8::EpiBf16 E{PP, DM};
            PG8_CALL(pg8::EpiBf16, pg8::StaticOrder);
        }
    }
}
__device__ __forceinline__ void phase6(LAS unsigned char* L, const int, const int wave, const int G, const int bx, const int vcu, const int gw, const int NGW) {
    int tix_ = REG_DIET ? 64 * wave + hw_lane() : (int)threadIdx.x; if (REG_DIET) asm volatile("" : "+v"(tix_)); const int lane = tix_ & 63;
    { PHASE_PTRS
    {
        int kdim_ = DM; asm volatile("" : "+s"(kdim_)); pg8::Gemm g{HB, WGU, MROWS, 2 * DFF, kdim_}; PROBE_EPI_SET(6) pg8::StaticOrder S; S.init(MROWS, 2 * DFF, G, bx, WGM_P6);
        pg8::EpiGUAct E{UB, DFF, SSB, EPS, ARG_IN(I_FCW), ARG_IN(I_FCB), TOPG, BOTG, TOPU, (LAS float*)(L + XCH_OFF)};
#ifdef PROBE_SS
        E.tacc = (unsigned*)(ws_ + WS_CTL) + 8;
#endif
        PG8_CALL(pg8::EpiGUAct, pg8::StaticOrder);
    }
    }
}
__device__ __forceinline__ void ffn_fix_rows(const float* fcw, const float* fcb, const float* TOPG, const float* BOTG, const float* TOPU, bf16* UB, int pm, int c) {
    float w0[8], w1[8], w2[8], bv[8], g0[8], g1[8], gm1[8], gm2[8], u0[8], u1[8], a0[8], a1[8];
    load8f(fcw + c, w0); load8f(fcw + DFF + c, w1); load8f(fcw + 2 * DFF + c, w2); load8f(fcb + c, bv);
    load8f(TOPG + (size_t)(pm * 2) * DFF + c, g0); load8f(TOPG + (size_t)(pm * 2 + 1) * DFF + c, g1);
    load8f(BOTG + (size_t)(pm * 2 - 2) * DFF + c, gm2); load8f(BOTG + (size_t)(pm * 2 - 1) * DFF + c, gm1);
    load8f(TOPU + (size_t)(pm * 2) * DFF + c, u0); load8f(TOPU + (size_t)(pm * 2 + 1) * DFF + c, u1);
#pragma unroll
    for (int j = 0; j < 8; ++j) {
        const float p0 = w0[j] * gm2[j] + w1[j] * gm1[j] + w2[j] * g0[j] + bv[j], p1 = w0[j] * gm1[j] + w1[j] * g0[j] + w2[j] * g1[j] + bv[j];
        a0[j] = p0 * __builtin_amdgcn_rcpf(1.0f + __builtin_amdgcn_exp2f(-LOG2E * p0)) * (u0[j] * -LOG2E);
        a1[j] = p1 * __builtin_amdgcn_rcpf(1.0f + __builtin_amdgcn_exp2f(-LOG2E * p1)) * (u1[j] * -LOG2E);
    }
    *(GAS v4u*)(UB + (size_t)(pm * 256) * DFF + c) = pack8f(a0);
    *(GAS v4u*)(UB + (size_t)(pm * 256 + 1) * DFF + c) = pack8f(a1);
}
__device__ __forceinline__ void phase8(LAS unsigned char* L, const int, const int wave, const int G, const int bx, const int vcu, const int gw, const int NGW) {
    int tix_ = REG_DIET ? 64 * wave + hw_lane() : (int)threadIdx.x; if (REG_DIET) asm volatile("" : "+v"(tix_)); const int lane = tix_ & 63;
    { PHASE_PTRS
    {
        int kdim_ = DFF; asm volatile("" : "+s"(kdim_)); pg8::Gemm g{UB, WDN, MROWS, DM, kdim_}; PROBE_EPI_SET(8) pg8::StaticOrder S; S.init(MROWS, DM, G, bx, WGM_P8);
        { const int tid = tix_; pg8::Unit fu; int prev = -1;
          for (int i = 0; S.next(i, fu); ++i) { if (fu.pm != prev && (fu.pm & 31) != 0 && 8 * tid < DFF) ffn_fix_rows(ARG_IN(I_FCW), ARG_IN(I_FCB), TOPG, BOTG, TOPU, UB, fu.pm, 8 * tid); prev = fu.pm; }
          asm volatile("s_waitcnt vmcnt(0)" ::: "memory"); __syncthreads(); }
        pg8::EpiResNorm<true, P10_F8 != 0> E{HB, X2B, SSB, DM, (LAS float*)(L + XCH_OFF), X2F8};
        pg8::gemm_phase<pg8::EpiResNorm<true, P10_F8 != 0>, pg8::StaticOrder, true, PG8_SP2>(L, g, S, E, wave);
    }
    }
#if PP_IN_P8
    { PHASE_PTRS
        int kdim_ = PLED; asm volatile("" : "+s"(kdim_)); pg8::Gemm g{PB, WPP, MROWS, DM, kdim_}; pg8::StaticOrder S; S.init(MROWS, DM, G, bx, WGM_P8);
        pg8::EpiBf16 E{PP, DM};
        PG8_CALL(pg8::EpiBf16, pg8::StaticOrder);
    }
#endif
}
__device__ __forceinline__ void phase10(LAS unsigned char* L, const int, const int wave, const int G, const int bx, const int vcu, const int gw, const int NGW) {
    int tix_ = REG_DIET ? 64 * wave + hw_lane() : (int)threadIdx.x; if (REG_DIET) asm volatile("" : "+v"(tix_)); const int lane = tix_ & 63;
    { PHASE_PTRS
    {
        int kdim_ = P10_F8 ? DM / 2 : DM; asm volatile("" : "+s"(kdim_)); pg8::Gemm g{P10_F8 ? (const bf16*)X2F8 : X2B, WPG, MROWS, DM, kdim_}; PROBE_EPI_SET(10) pg8::StaticOrder S; S.init(MROWS, DM, G, bx, WGM_P10);
        pg8::EpiPle E{X2B, out, PP, DM, SSB, EPS, P10_F8 ? 1.0f / W8_SCALE : 1.0f};
        pg8::gemm_phase<pg8::EpiPle, pg8::StaticOrder, true, PG8_SP2, 0, 0, 0, P10_F8 != 0>(L, g, S, E, wave);
    }
    }
}

#if defined(PROBE_CLK)
#define PROBE_T0(n) unsigned long long tp0_##n = 0; if ((n) == PROBE_CLK) tp0_##n = __builtin_amdgcn_s_memtime();
#define PROBE_T1(n) if ((n) == PROBE_CLK && bx == PROBE_BLK && tid == 0) { __hip_atomic_fetch_add((unsigned*)(ctl + 8), (unsigned)((__builtin_amdgcn_s_memtime() - tp0_##n) / 25), __ATOMIC_RELAXED, __HIP_MEMORY_SCOPE_AGENT); }
#elif defined(PROBE_PHASE)
#define PROBE_T0(n) unsigned long long tp0_##n = 0; if ((n) == PROBE_PHASE) tp0_##n = __builtin_amdgcn_s_memrealtime();
#define PROBE_T1(n) if ((n) == PROBE_PHASE && bx == PROBE_BLK && tid == 0) { __hip_atomic_fetch_add((unsigned*)(ctl + 8), (unsigned)(__builtin_amdgcn_s_memrealtime() - tp0_##n), __ATOMIC_RELAXED, __HIP_MEMORY_SCOPE_AGENT); }
#else
#define PROBE_T0(n)
#define PROBE_T1(n)
#endif
#ifdef PROBE_BAR
#define XBAR() do { const unsigned long long tb0_ = __builtin_amdgcn_s_memrealtime(); xcd_barrier(bar); ++nbar_; if ((PROBE_BAR == 99 || nbar_ == PROBE_BAR) && bx == PROBE_BLK && tid == 0) __hip_atomic_fetch_add((unsigned*)(ctl + 8), (unsigned)(__builtin_amdgcn_s_memrealtime() - tb0_), __ATOMIC_RELAXED, __HIP_MEMORY_SCOPE_AGENT); } while (0)
#else
#define XBAR() xcd_barrier(bar)
#endif
__global__ void __launch_bounds__(NWAVES * 64, 2) hybrid_fwd(Args args) {
    extern __shared__ __attribute__((aligned(16))) unsigned char lds[];
    LAS unsigned char* L = (LAS unsigned char*)lds;
    volatile LAS unsigned* MISC = (volatile LAS unsigned*)(L + MISC_OFF);
    const int tid = threadIdx.x, lane = tid & 63, wave = __builtin_amdgcn_readfirstlane(tid >> 6);
    const int G = gridDim.x; const int bx = blockIdx.x;
    const int vcu = (G % 8 == 0) ? (bx % 8) * (G / 8) + bx / 8 : bx;
    const int gw = vcu * NWAVES + wave, NGW = G * NWAVES;
    gu32* ctl; { KARG_DECL ctl = (gu32*)(ARG_WS() + WS_CTL); }
    for (int u = tid; u < (LDS_BYTES - LDSCTL_OFF) / 4; u += NWAVES * 64) ((LAS unsigned*)(L + LDSCTL_OFF))[u] = 0u;
    __syncthreads();
    XcdBarrier bar = xcd_barrier_post((unsigned*)(ctl + CW_BAR), MISC + 8); bar.w = (unsigned)wave;
#ifdef PROBE_TOTAL
    const unsigned long long tt0_ = __builtin_amdgcn_s_memrealtime();
#endif
#ifdef PROBE_BAR
    int nbar_ = 0;
#endif

#ifndef SKIP_P0
    PROBE_T0(0) phase0(L, lane, wave, G, bx, vcu, gw, NGW); PROBE_T1(0)
#endif
    XBAR();
#if (DUP_MASK >> 0) & 1
    phase0(L, lane, wave, G, bx, vcu, gw, NGW);
    XBAR();
#endif
#ifdef EXTRA_BARRIERS
    { int nb_ = EXTRA_BARRIERS; asm volatile("" : "+s"(nb_)); for (int eb_ = 0; eb_ < nb_; ++eb_) xcd_barrier(bar); }
#endif

#ifndef SKIP_P1
    PROBE_T0(1) phase1(L, lane, wave, G, bx, vcu, gw, NGW); PROBE_T1(1)
#endif
    XBAR();
#if (DUP_MASK >> 1) & 1
    phase1(L, lane, wave, G, bx, vcu, gw, NGW);
    XBAR();
#endif

#ifndef SKIP_P2
    PROBE_T0(2) phase2(L, lane, wave, G, bx, vcu, gw, NGW); PROBE_T1(2)
#endif
    XBAR();
#if (DUP_MASK >> 2) & 1
    phase2(L, lane, wave, G, bx, vcu, gw, NGW);
    XBAR();
#endif

#ifndef SKIP_P3
    PROBE_T0(3) phase3(L, lane, wave, G, bx, vcu, gw, NGW); PROBE_T1(3)
#endif
#if PANEL_SEAM
    if (G != 256) XBAR();
#else
    XBAR();
#endif
#if (DUP_MASK >> 3) & 1
    phase3(L, lane, wave, G, bx, vcu, gw, NGW);
    XBAR();
#endif

#ifndef SKIP_P4
    PROBE_T0(4) phase4(L, lane, wave, G, bx, vcu, gw, NGW); PROBE_T1(4)
#endif
    XBAR();
#if (DUP_MASK >> 4) & 1
    phase4(L, lane, wave, G, bx, vcu, gw, NGW);
    XBAR();
#endif

#ifndef SKIP_P6
    PROBE_T0(6) phase6(L, lane, wave, G, bx, vcu, gw, NGW); PROBE_T1(6)
#endif
    XBAR();
#ifdef SHADOW
#ifndef SHADOW_ABL
#define SHADOW_ABL 0
#endif
    {
        { PHASE_PTRS
        int kdim_ = DM; asm volatile("" : "+s"(kdim_)); pg8::Gemm g{HB, WGU, MROWS, 2 * DFF, kdim_};
        pg8::EpiNull E{};
#if SHADOW == 1
        pg8::StaticOrder S; S.init(MROWS, 2 * DFF, G, bx, WGM_P6); pg8::gemm_phase<pg8::EpiNull, pg8::StaticOrder, true, PG8_SP2, 0, 0, SHADOW_ABL>(L, g, S, E, wave);
#else
        pg8::SameUnitOrder S; S.init(MROWS, 2 * DFF, G, bx, WGM_P6); pg8::gemm_phase<pg8::EpiNull, pg8::SameUnitOrder, true, PG8_SP2>(L, g, S, E, wave);
#endif
        }
        XBAR();
    }
#endif
#if (DUP_MASK >> 6) & 1
    phase6(L, lane, wave, G, bx, vcu, gw, NGW);
    XBAR();
#endif


#ifndef SKIP_P8
    PROBE_T0(8) phase8(L, lane, wave, G, bx, vcu, gw, NGW); PROBE_T1(8)
#endif
    XBAR();
#if (DUP_MASK >> 8) & 1
    phase8(L, lane, wave, G, bx, vcu, gw, NGW);
    XBAR();
#endif


#ifndef SKIP_P10
    PROBE_T0(10) phase10(L, lane, wave, G, bx, vcu, gw, NGW); PROBE_T1(10)
#endif
#if (DUP_MASK >> 10) & 1
    XBAR();
    phase10(L, lane, wave, G, bx, vcu, gw, NGW);
#endif
#ifdef PROBE_TOTAL
    if (bx == PROBE_BLK && tid == 0) __hip_atomic_fetch_add((unsigned*)(ctl + 8), (unsigned)(__builtin_amdgcn_s_memrealtime() - tt0_), __ATOMIC_RELAXED, __HIP_MEMORY_SCOPE_AGENT);
#endif
#if defined(PROBE_PHASE) || defined(PROBE_EPI) || defined(PROBE_BAR) || defined(PROBE_CLK) || defined(PROBE_ATT) || defined(PROBE_TOTAL)
    if (bx == PROBE_BLK && tid == 0) { const unsigned tk = __hip_atomic_load((unsigned*)(ctl + 8), __ATOMIC_RELAXED, __HIP_MEMORY_SCOPE_AGENT); const unsigned long long t0 = __builtin_amdgcn_s_memrealtime();
        while (__builtin_amdgcn_s_memrealtime() - t0 < (unsigned long long)tk * PROBE_AMP) __builtin_amdgcn_s_sleep(32); }
#endif
}

extern "C" void kernel_launch(void* const* d_in, const int* in_sizes, int n_in, void* d_out, int out_size, void* d_ws, size_t ws_size, hipStream_t stream) {
    static int grid = 0;
    if (grid == 0) {
        if (n_in != 20 || out_size != MROWS * DM || ws_size < WS_END) { fprintf(stderr, "kernel_launch: unexpected shapes (n_in %d, out %d, ws %zu); nothing launched\n", n_in, out_size, ws_size); grid = -1; return; }
        int dev = 0, cus = 0, per_cu = 0;
        if (hipGetDevice(&dev) != hipSuccess || hipDeviceGetAttribute(&cus, hipDeviceAttributeMultiprocessorCount, dev) != hipSuccess) { grid = -1; return; }
        if (hipFuncSetAttribute((const void*)hybrid_fwd, hipFuncAttributeMaxDynamicSharedMemorySize, LDS_BYTES) != hipSuccess) { fprintf(stderr, "kernel_launch: hipFuncSetAttribute failed\n"); grid = -1; return; }
        if (hipOccupancyMaxActiveBlocksPerMultiprocessor(&per_cu, (const void*)hybrid_fwd, NWAVES * 64, LDS_BYTES) != hipSuccess || per_cu < 1)
            fprintf(stderr, "kernel_launch: note: occupancy query reports %d workgroups per CU\n", per_cu);
        (void)hipGetLastError();
        grid = cus;
        if (grid != 256) fprintf(stderr, "kernel_launch: %d CUs (built for 256)\n", grid);
    }
    if (grid < 0) return;
    if (hipMemsetAsync((char*)d_ws + WS_CTL, 0, CTL_ZERO_BYTES, stream) != hipSuccess) { fprintf(stderr, "kernel_launch: hipMemsetAsync failed\n"); return; }
    Args a{};
    for (int i = 0; i < 20; ++i) a.in[i] = (const float*)d_in[i];
    a.out = (float*)d_out; a.ws = (unsigned char*)d_ws;
    hipLaunchKernelGGL(hybrid_fwd, dim3(grid), dim3(NWAVES * 64), LDS_BYTES, stream, a);
    const hipError_t le = hipPeekAtLastError();
    if (le != hipSuccess) fprintf(stderr, "kernel_launch: launch failed: %s\n", hipGetErrorName(le));
}
```
